# Optimizing an MI355X kernel written in HIP

```python
import math
import jax, jax.numpy as jnp
from jax import lax
import numpy as np

D_MODEL = 1024
BATCH = 8
SEQ = 2048
DEPTH = 1

ATTN_HEADS = 8
ATTN_KV_HEADS = 2
HEAD_DIM = 64
ATTN_WIDTH = ATTN_HEADS * HEAD_DIM
KV_WIDTH = ATTN_KV_HEADS * HEAD_DIM
WINDOW = 128
BLOCK = 128
SSM_CH_PER_GROUP = 16
SSM_WIDTH = D_MODEL - ATTN_WIDTH
SSM_GROUPS = SSM_WIDTH // SSM_CH_PER_GROUP
SSM_STATE = 64
DT_MIN = 1e-3
DT_MAX = 1e-1
MIX_WIDTH = ATTN_WIDTH + SSM_WIDTH
IN_WIDTH = ATTN_WIDTH + 2 * KV_WIDTH + SSM_WIDTH
D_FF = 2816
EPS = 1e-6
NEG_INF = -1e30
LAMBDA_RE_MAX = -1e-4

kernel_name = "hymba_swa_s5_macaron_block"


def _alibi_slopes(n_heads):
    return jnp.asarray(2.0 ** (-8.0 * (np.arange(n_heads) + 1) / n_heads), dtype=jnp.float32)


def _rmsnorm(x, g):
    x32 = x.astype(jnp.float32)
    y = x32 * lax.rsqrt(jnp.mean(x32 * x32, axis=-1, keepdims=True) + EPS)
    return (y * g.astype(jnp.float32)).astype(x.dtype)


def _swiglu(x, w_gate, w_up, w_down):
    return (jax.nn.silu(x @ w_gate) * (x @ w_up)) @ w_down


def _window_attention(q, k, v, sinks):
    b, l = q.shape[0], q.shape[1]
    nb = l // BLOCK
    gq = ATTN_HEADS // ATTN_KV_HEADS
    qb = q.reshape(b, nb, BLOCK, ATTN_KV_HEADS, gq, HEAD_DIM)

    def band(t):
        tp = jnp.pad(t, ((0, 0), (BLOCK, BLOCK), (0, 0), (0, 0)))
        tp = tp.reshape(b, nb + 2, BLOCK, ATTN_KV_HEADS, HEAD_DIM)
        return jnp.concatenate([tp[:, :-2], tp[:, 1:-1], tp[:, 2:]], axis=2)

    kw, vw = band(k), band(v)
    scores = jnp.einsum('bnqkgd,bnskd->bnkgqs', qb, kw).astype(jnp.float32) * (HEAD_DIM ** -0.5)
    qi = jnp.arange(BLOCK)[:, None]
    kj = jnp.arange(3 * BLOCK)[None, :]
    rel = kj - BLOCK - qi
    key_pos = jnp.arange(nb)[:, None, None] * BLOCK - BLOCK + kj[None]
    valid = (jnp.abs(rel) <= WINDOW)[None] & (key_pos >= 0) & (key_pos < l)
    slopes = _alibi_slopes(ATTN_HEADS).reshape(ATTN_KV_HEADS, gq)
    alibi = -slopes[:, :, None, None] * jnp.abs(rel).astype(jnp.float32)
    scores = jnp.where(valid[None, :, None, None], scores + alibi, NEG_INF)
    sink = jnp.broadcast_to(sinks.astype(jnp.float32).reshape(1, 1, ATTN_KV_HEADS, gq, 1, 1),
                            scores.shape[:-1] + (1,))
    probs = jax.nn.softmax(jnp.concatenate([scores, sink], axis=-1), axis=-1)[..., :-1]
    out = jnp.einsum('bnkgqs,bnskd->bnqkgd', probs.astype(v.dtype), vw)
    return out.reshape(b, l, ATTN_WIDTH)


def _s5_direction(u, lam_re, lam_im, log_dt, b_re, b_im, c_re, c_im, reverse):
    f32 = jnp.float32
    lr = jnp.minimum(lam_re.astype(f32), LAMBDA_RE_MAX)
    li = lam_im.astype(f32)
    dt = jnp.exp(log_dt.astype(f32))[:, None]
    mag = jnp.exp(lr * dt)
    a_re = mag * jnp.cos(li * dt)
    a_im = mag * jnp.sin(li * dt)
    den = lr * lr + li * li
    coef_re = ((a_re - 1.0) * lr + a_im * li) / den
    coef_im = (a_im * lr - (a_re - 1.0) * li) / den
    br, bi = b_re.astype(f32), b_im.astype(f32)
    bb_re = coef_re[..., None] * br - coef_im[..., None] * bi
    bb_im = coef_re[..., None] * bi + coef_im[..., None] * br
    bu_re = jnp.einsum('blgh,gph->blgp', u, bb_re)
    bu_im = jnp.einsum('blgh,gph->blgp', u, bb_im)
    ar = jnp.broadcast_to(a_re, bu_re.shape)
    ai = jnp.broadcast_to(a_im, bu_re.shape)

    def combine(e1, e2):
        ar1, ai1, xr1, xi1 = e1
        ar2, ai2, xr2, xi2 = e2
        return (ar2 * ar1 - ai2 * ai1,
                ar2 * ai1 + ai2 * ar1,
                ar2 * xr1 - ai2 * xi1 + xr2,
                ar2 * xi1 + ai2 * xr1 + xi2)

    _, _, xr, xi = lax.associative_scan(combine, (ar, ai, bu_re, bu_im), reverse=reverse, axis=1)
    return (jnp.einsum('blgp,ghp->blgh', xr, c_re.astype(f32))
            - jnp.einsum('blgp,ghp->blgh', xi, c_im.astype(f32)))


def _s5_mixer(u, lam_re, lam_im, log_dt, b_re, b_im, c_re, c_im, d_skip, glu_w, glu_b):
    b, l, _ = u.shape
    ug = u.astype(jnp.float32).reshape(b, l, SSM_GROUPS, SSM_CH_PER_GROUP)
    y = d_skip.astype(jnp.float32) * ug
    for direction in range(2):
        y = y + _s5_direction(ug, lam_re[direction], lam_im[direction], log_dt[direction],
                              b_re[direction], b_im[direction], c_re[direction], c_im[direction],
                              reverse=(direction == 1))
    y = jax.nn.gelu(y.reshape(b, l, SSM_WIDTH)).astype(u.dtype)
    return y * jax.nn.sigmoid(y @ glu_w + glu_b)


def setup_inputs(seed: int = 0) -> dict:
    key = jax.random.key(seed)
    ks = iter(jax.random.split(key, 40))
    f32 = jnp.float32

    def nrm(shape, scale):
        return jax.random.normal(next(ks), shape, f32) * scale

    def gain(shape):
        return 1.0 + 0.01 * jax.random.normal(next(ks), shape, f32)

    L, G, P, Hc = DEPTH, SSM_GROUPS, SSM_STATE, SSM_CH_PER_GROUP
    lam_im_init = jnp.pi * jnp.arange(P, dtype=f32)
    return {
        "x": jax.random.normal(next(ks), (BATCH, SEQ, D_MODEL), f32),
        "norm_ffn1": gain((L, D_MODEL)),
        "ffn1_w_gate": nrm((L, D_MODEL, D_FF), D_MODEL ** -0.5),
        "ffn1_w_up": nrm((L, D_MODEL, D_FF), D_MODEL ** -0.5),
        "ffn1_w_down": nrm((L, D_FF, D_MODEL), D_FF ** -0.5),
        "norm_mix": gain((L, D_MODEL)),
        "w_in": nrm((L, D_MODEL, IN_WIDTH), D_MODEL ** -0.5),
        "attn_sinks": nrm((L, ATTN_HEADS), 0.5),
        "ssm_lambda_re": -0.5 + nrm((L, 2, G, P), 0.01),
        "ssm_lambda_im": lam_im_init + nrm((L, 2, G, P), 0.01),
        "ssm_log_dt": jax.random.uniform(next(ks), (L, 2, G), f32,
                                         minval=math.log(DT_MIN), maxval=math.log(DT_MAX)),
        "ssm_b_re": nrm((L, 2, G, P, Hc), (2.0 * Hc) ** -0.5),
        "ssm_b_im": nrm((L, 2, G, P, Hc), (2.0 * Hc) ** -0.5),
        "ssm_c_re": nrm((L, 2, G, Hc, P), (2.0 * P) ** -0.5),
        "ssm_c_im": nrm((L, 2, G, Hc, P), (2.0 * P) ** -0.5),
        "ssm_d": 1.0 + nrm((L, G, Hc), 0.1),
        "ssm_glu_w": nrm((L, SSM_WIDTH, SSM_WIDTH), SSM_WIDTH ** -0.5),
        "ssm_glu_b": nrm((L, SSM_WIDTH), 0.01),
        "attn_out_norm": gain((L, ATTN_WIDTH)),
        "ssm_out_norm": gain((L, SSM_WIDTH)),
        "w_out": nrm((L, MIX_WIDTH, D_MODEL), MIX_WIDTH ** -0.5),
        "norm_ffn2": gain((L, D_MODEL)),
        "ffn2_w_gate": nrm((L, D_MODEL, D_FF), D_MODEL ** -0.5),
        "ffn2_w_up": nrm((L, D_MODEL, D_FF), D_MODEL ** -0.5),
        "ffn2_w_down": nrm((L, D_FF, D_MODEL), D_FF ** -0.5),
        "final_norm": gain((D_MODEL,)),
    }


def reference(x, norm_ffn1, ffn1_w_gate, ffn1_w_up, ffn1_w_down, norm_mix, w_in, attn_sinks,
              ssm_lambda_re, ssm_lambda_im, ssm_log_dt, ssm_b_re, ssm_b_im, ssm_c_re, ssm_c_im,
              ssm_d, ssm_glu_w, ssm_glu_b, attn_out_norm, ssm_out_norm, w_out,
              norm_ffn2, ffn2_w_gate, ffn2_w_up, ffn2_w_down, final_norm):
    b, l, _ = x.shape
    for layer in range(DEPTH):
        x = x + 0.5 * _swiglu(_rmsnorm(x, norm_ffn1[layer]),
                              ffn1_w_gate[layer], ffn1_w_up[layer], ffn1_w_down[layer])
        h = _rmsnorm(x, norm_mix[layer])
        proj = h @ w_in[layer]
        q, k, v, u = jnp.split(proj, [ATTN_WIDTH, ATTN_WIDTH + KV_WIDTH,
                                      ATTN_WIDTH + 2 * KV_WIDTH], axis=-1)
        attn = _window_attention(q.reshape(b, l, ATTN_HEADS, HEAD_DIM),
                                 k.reshape(b, l, ATTN_KV_HEADS, HEAD_DIM),
                                 v.reshape(b, l, ATTN_KV_HEADS, HEAD_DIM),
                                 attn_sinks[layer])
        ssm = _s5_mixer(u, ssm_lambda_re[layer], ssm_lambda_im[layer], ssm_log_dt[layer],
                        ssm_b_re[layer], ssm_b_im[layer], ssm_c_re[layer], ssm_c_im[layer],
                        ssm_d[layer], ssm_glu_w[layer], ssm_glu_b[layer])
        mixed = jnp.concatenate([_rmsnorm(attn, attn_out_norm[layer]),
                                 _rmsnorm(ssm, ssm_out_norm[layer])], axis=-1)
        x = x + mixed @ w_out[layer]
        x = x + 0.5 * _swiglu(_rmsnorm(x, norm_ffn2[layer]),
                              ffn2_w_gate[layer], ffn2_w_up[layer], ffn2_w_down[layer])
    return _rmsnorm(x, final_norm)
```

```cpp
#include <hip/hip_runtime.h>
#include <hip/hip_cooperative_groups.h>
#include <cstdio>
#include <cstdint>
namespace cg = cooperative_groups;
#define MK_MULTI 1
namespace pg8 {
#define PG8_LAS __attribute__((address_space(3)))
typedef unsigned short bf16_t;
typedef short bf16x8 __attribute__((ext_vector_type(8)));
typedef float f32x4 __attribute__((ext_vector_type(4)));
typedef unsigned u32x4 __attribute__((ext_vector_type(4)));
constexpr int BM = 256, BK = 64, HALF = 128, HTB = HALF * BK * 2  , STAGE_BYTES = 8 * HTB, NXCD = 8, WGM = 8;

__host__ __device__ __forceinline__ int lds_byte(int r, int c) { const int st = (r >> 4) * 2 + (c >> 5), rr = r & 15, cc = c & 31, ob = rr * 64 + cc * 2; return st * 1024 + (ob ^ (((ob >> 9) & 1) << 5)); }
__host__ __device__ __forceinline__ void stage_rc(int b, int& R, int& C) { const int st = b / 1024, sb = b % 1024, swz = sb ^ (((sb >> 9) & 1) << 5); R = (st >> 1) * 16 + swz / 64; C = (st & 1) * 32 + (swz % 64) / 2; }
__host__ __device__ __forceinline__ int perm32(int rho) { const int n = rho >> 4, i = rho & 15; return 8 * (i >> 2) + 4 * n + (i & 3); }

struct Unit { int pm, pn; };
struct Gemm { const bf16_t* A; const bf16_t* Bt; int M, N, K; };

struct StaticOrder {
    int nM, nN, nwg, G, c;
    __host__ __device__ void init(int M, int N, int G_, int c_) { nM = M / BM; nN = N / BM; nwg = nM * nN; G = G_; c = c_; }
    __host__ __device__ bool next(int i, Unit& u) const {
        const long L = (long)i * G + c; if (L >= nwg) return false;
        int wgid = (int)L; { const int q = nwg / NXCD, r = nwg % NXCD, xcd = wgid % NXCD, off = wgid / NXCD; wgid = (xcd < r ? xcd * (q + 1) : r * (q + 1) + (xcd - r) * q) + off; }
        const int nig = WGM * nN, gid = wgid / nig, fm = gid * WGM, gsz = (nM - fm) < WGM ? (nM - fm) : WGM;
        u.pm = fm + ((wgid % nig) % gsz); u.pn = (wgid % nig) / gsz; return true;
    }
    __device__ __forceinline__ void a_ready(const Unit&) const {}
    __device__ __forceinline__ void done(const Unit&) const {}
};

__device__ __forceinline__ unsigned cvt_pk_bf16(float lo, float hi) { unsigned r; asm volatile("v_cvt_pk_bf16_f32 %0, %1, %2" : "=v"(r) : "v"(lo), "v"(hi)); return r; }
typedef float f32x2 __attribute__((ext_vector_type(2)));
__device__ __forceinline__ f32x2 gelu_pk(f32x2 v) {
    const f32x2 av = __builtin_elementwise_abs(v), d = av * 0.2316418882f + 1.0f;
    f32x2 t; t.x = __builtin_amdgcn_rcpf(d.x); t.y = __builtin_amdgcn_rcpf(d.y);
    f32x2 q = t * 0.5307027145f + (-0.7265760135f); q = q * t + 0.7107068705f; q = q * t + (-0.142248368f); q = q * t + 0.127414796f; q = q * t;
    const f32x2 s = (v * v) * (-0.72134752044f);
    f32x2 e; e.x = __builtin_amdgcn_exp2f(s.x); e.y = __builtin_amdgcn_exp2f(s.y);
    const f32x2 m = v * (q * e), r = v - m;
    f32x2 o; o.x = v.x < 0.f ? m.x : r.x; o.y = v.y < 0.f ? m.y : r.y; return o;
}

template <int ACT  > struct EpiBf16 {
    static constexpr bool PERM = true, AFTER_DRAIN = false; static_assert(ACT == 0 || ACT == 1, "EpiBf16: ACT is 0 (none) or 1 (gelu_pk)");
    bf16_t* O; int ldc; const float* bias; int split_cols; size_t split_stride; float scale0;
    __device__ __forceinline__ void operator()(const f32x4 (&acc)[2][2][4][2], const Unit& u, int wr, int wc, int fr, int fq) const {
        const int row0 = u.pm * BM + wr * 64 + fr; int colt = u.pn * BM; bf16_t* base = O;
        float sc = 1.f; if (split_cols) { const int t = colt / split_cols; base += (size_t)t * split_stride; colt -= t * split_cols; if (t == 0) sc = scale0; }
        const int col0 = colt + wc * 32 + 8 * fq, bcol0 = u.pn * BM + wc * 32 + 8 * fq;
        f32x4 bv[2][2];
#pragma unroll
        for (int bj = 0; bj < 2; ++bj)
#pragma unroll
            for (int n = 0; n < 2; ++n) bv[bj][n] = bias ? *(const f32x4*)(bias + bcol0 + bj * HALF + 4 * n) : (f32x4){0.f, 0.f, 0.f, 0.f};
#pragma unroll
        for (int ai = 0; ai < 2; ++ai)
#pragma unroll
            for (int m = 0; m < 4; ++m) { bf16_t* rowp = base + (size_t)(row0 + ai * HALF + m * 16) * ldc + col0;
#pragma unroll
                for (int bj = 0; bj < 2; ++bj) { f32x4 v0 = acc[ai][bj][m][0] + bv[bj][0], v1 = acc[ai][bj][m][1] + bv[bj][1];
                    if (ACT == 1) { f32x2 a = gelu_pk((f32x2){v0[0], v0[1]}), b = gelu_pk((f32x2){v0[2], v0[3]}), c = gelu_pk((f32x2){v1[0], v1[1]}), d = gelu_pk((f32x2){v1[2], v1[3]});
                        v0 = (f32x4){a.x, a.y, b.x, b.y}; v1 = (f32x4){c.x, c.y, d.x, d.y}; }
                    v0 = v0 * sc; v1 = v1 * sc; u32x4 w; w.x = cvt_pk_bf16(v0[0], v0[1]); w.y = cvt_pk_bf16(v0[2], v0[3]); w.z = cvt_pk_bf16(v1[0], v1[1]); w.w = cvt_pk_bf16(v1[2], v1[3]);
                    *(u32x4*)(rowp + bj * HALF) = w; } }
    }
};
template <class Epi, class Sched, bool ALIGN_EPI = false, bool SP2 = false>
__device__ __forceinline__ void gemm_phase(PG8_LAS unsigned char* lds, const Gemm g, const Sched& S, const Epi& E) {
    const int tid = threadIdx.x, wid = __builtin_amdgcn_readfirstlane(tid >> 6), lane = tid & 63, wr = wid >> 2, wc = wid & 3, fr = lane & 15, fq = lane >> 4;
    const int K = g.K, nt = K / BK;
    unsigned voffA[2], voffB[2];
#pragma unroll
    for (int i = 0; i < 2; ++i) { int R, C; stage_rc(tid * 16 + i * 8192, R, C); const int Rb = Epi::PERM ? ((R & ~31) + perm32(R & 31)) : R;
        voffA[i] = (unsigned)(R * K + C) * 2u; voffB[i] = (unsigned)(Rb * K + C) * 2u; }
    const size_t kstep = (size_t)(BK * 2);
    const size_t hstep = (size_t)HALF * K * 2;
    const size_t tstep = 2 * hstep;
    const unsigned ldsw = (unsigned)wid * 1024u;
    const int aoff = lds_byte(wr * 64 + fr, fq * 8), boff = lds_byte(wc * 32 + fr, fq * 8);
#define PG8_SA(b, h) (((b) * 2 + (h)) * HTB)
#define PG8_SB(b, h) ((4 + (b) * 2 + (h)) * HTB)
#define PG8_STAGE(bufoff, gbase, voff) do { _Pragma("unroll") for (int _i = 0; _i < 2; ++_i) \
        __builtin_amdgcn_global_load_lds((const unsigned*)((const char*)(gbase) + (voff)[_i]), (PG8_LAS unsigned*)(lds + (bufoff) + ldsw + _i * 8192), 16, 0, 0); } while (0)
#define PG8_LDA(dst, b, h) do { _Pragma("unroll") for (int m = 0; m < 4; ++m) _Pragma("unroll") for (int k = 0; k < 2; ++k) dst[m][k] = *(const PG8_LAS bf16x8*)(lds + PG8_SA(b, h) + aoff + m * 2048 + k * 1024); } while (0)
#define PG8_LDB(dst, b, h) do { _Pragma("unroll") for (int n = 0; n < 2; ++n) _Pragma("unroll") for (int k = 0; k < 2; ++k) dst[n][k] = *(const PG8_LAS bf16x8*)(lds + PG8_SB(b, h) + boff + n * 2048 + k * 1024); } while (0)
#define PG8_MMA(ai, bj, At, Bt) do { __builtin_amdgcn_s_setprio(1); _Pragma("unroll") for (int m = 0; m < 4; ++m) _Pragma("unroll") for (int n = 0; n < 2; ++n) _Pragma("unroll") for (int k = 0; k < 2; ++k) \
        acc[ai][bj][m][n] = __builtin_amdgcn_mfma_f32_16x16x32_bf16(Bt[n][k], At[m][k], acc[ai][bj][m][n], 0, 0, 0); __builtin_amdgcn_s_setprio(0); } while (0)
#define PG8_WAIT_V(n) asm volatile("s_waitcnt vmcnt(" #n ")" ::: "memory")
#define PG8_WAIT_L(n) asm volatile("s_waitcnt lgkmcnt(" #n ")" ::: "memory")
#define PG8_BAR __builtin_amdgcn_s_barrier()
#define PG8_SCHED __builtin_amdgcn_sched_barrier(0)
    Unit cur, nxt; int ui = 0;
    if (!S.next(0, cur)) return;
    f32x4 acc[2][2][4][2];
#pragma unroll
    for (int a = 0; a < 2; ++a)
#pragma unroll
        for (int b = 0; b < 2; ++b)
#pragma unroll
            for (int m = 0; m < 4; ++m)
#pragma unroll
                for (int n = 0; n < 2; ++n) acc[a][b][m][n] = (f32x4){0.f, 0.f, 0.f, 0.f};
    bf16x8 At[4][2], B0[2][2], B1[2][2];
    const char* cA = (const char*)g.A + (size_t)cur.pm * tstep; const char* cB = (const char*)g.Bt + (size_t)cur.pn * tstep;
    S.a_ready(cur);
    if constexpr (SP2) {
        PG8_STAGE(PG8_SB(0, 0), cB, voffB); PG8_STAGE(PG8_SB(0, 1), cB + hstep, voffB); PG8_STAGE(PG8_SA(0, 0), cA, voffA); PG8_STAGE(PG8_SA(0, 1), cA + hstep, voffA);
        if (wr == 1) PG8_BAR;
        PG8_WAIT_V(2); PG8_BAR;
        PG8_STAGE(PG8_SB(1, 0), cB + kstep, voffB); PG8_STAGE(PG8_SA(1, 0), cA + kstep, voffA); PG8_STAGE(PG8_SB(1, 1), cB + hstep + kstep, voffB);
        PG8_WAIT_V(6); PG8_BAR;
    } else {
        PG8_STAGE(PG8_SB(0, 0), cB, voffB); PG8_STAGE(PG8_SA(0, 0), cA, voffA); PG8_STAGE(PG8_SB(0, 1), cB + hstep, voffB); PG8_STAGE(PG8_SA(0, 1), cA + hstep, voffA);
        if (wr == 1) PG8_BAR;
        PG8_WAIT_V(4); PG8_BAR;
        PG8_STAGE(PG8_SB(1, 0), cB + kstep, voffB); PG8_STAGE(PG8_SA(1, 0), cA + kstep, voffA); PG8_STAGE(PG8_SB(1, 1), cB + hstep + kstep, voffB);
        PG8_WAIT_V(6); PG8_BAR;
    }
    for (;;) {
        const bool has_next = S.next(ui + 1, nxt);
        const char* nA = has_next ? (const char*)g.A + (size_t)nxt.pm * tstep : cA; const char* nB = has_next ? (const char*)g.Bt + (size_t)nxt.pn * tstep : cB;
        for (int t = 0; t < nt; t += 2) {
            const bool last = (t == nt - 2);
            const char* a1 = cA + (size_t)(t + 1) * kstep;
            const char* a2 = last ? nA : cA + (size_t)(t + 2) * kstep; const char* b2 = last ? nB : cB + (size_t)(t + 2) * kstep;
            const char* a3 = a2 + kstep; const char* b3 = b2 + kstep;
            if (last && has_next) S.a_ready(nxt);
            if constexpr (SP2) {
            PG8_LDB(B0, 0, 0); PG8_LDB(B1, 0, 1); PG8_SCHED; PG8_LDA(At, 0, 0); PG8_STAGE(PG8_SA(1, 1), a1 + hstep, voffA);
            PG8_WAIT_V(8); PG8_WAIT_L(0); PG8_BAR; PG8_MMA(0, 0, At, B0); PG8_MMA(0, 1, At, B1); PG8_BAR; PG8_SCHED;
            PG8_LDA(At, 0, 1); PG8_STAGE(PG8_SB(0, 0), b2, voffB); PG8_STAGE(PG8_SB(0, 1), b2 + hstep, voffB); PG8_STAGE(PG8_SA(0, 0), a2, voffA);
            PG8_WAIT_V(8); PG8_WAIT_L(0); PG8_BAR; PG8_MMA(1, 0, At, B0); PG8_MMA(1, 1, At, B1); PG8_BAR; PG8_SCHED;
            PG8_LDB(B0, 1, 0); PG8_LDB(B1, 1, 1); PG8_SCHED; PG8_LDA(At, 1, 0); PG8_STAGE(PG8_SA(0, 1), a2 + hstep, voffA);
            PG8_WAIT_V(8); PG8_WAIT_L(0); PG8_BAR; PG8_MMA(0, 0, At, B0); PG8_MMA(0, 1, At, B1); PG8_BAR; PG8_SCHED;
            PG8_LDA(At, 1, 1); PG8_STAGE(PG8_SB(1, 0), b3, voffB); PG8_STAGE(PG8_SB(1, 1), b3 + hstep, voffB); PG8_STAGE(PG8_SA(1, 0), a3, voffA);
            PG8_WAIT_V(8); PG8_WAIT_L(0); PG8_BAR; PG8_MMA(1, 0, At, B0); PG8_MMA(1, 1, At, B1); PG8_BAR; PG8_SCHED;
            } else {
            PG8_LDB(B0, 0, 0); PG8_SCHED; PG8_LDA(At, 0, 0); PG8_STAGE(PG8_SA(1, 1), a1 + hstep, voffA);
            PG8_WAIT_L(8); PG8_BAR; PG8_WAIT_L(0); PG8_MMA(0, 0, At, B0); PG8_BAR; PG8_SCHED;
            PG8_LDB(B1, 0, 1); PG8_STAGE(PG8_SB(0, 0), b2, voffB);
            PG8_BAR; PG8_WAIT_L(0); PG8_MMA(0, 1, At, B1); PG8_BAR;
            PG8_LDA(At, 0, 1); PG8_STAGE(PG8_SA(0, 0), a2, voffA);
            PG8_BAR; PG8_WAIT_L(0); PG8_MMA(1, 0, At, B0); PG8_BAR; PG8_SCHED;
            PG8_STAGE(PG8_SB(0, 1), b2 + hstep, voffB);
            PG8_WAIT_V(6); PG8_BAR; PG8_MMA(1, 1, At, B1); PG8_BAR;
            PG8_LDB(B0, 1, 0); PG8_SCHED; PG8_LDA(At, 1, 0); PG8_STAGE(PG8_SA(0, 1), a2 + hstep, voffA);
            PG8_WAIT_L(8); PG8_BAR; PG8_WAIT_L(0); PG8_MMA(0, 0, At, B0); PG8_BAR; PG8_SCHED;
            PG8_LDB(B1, 1, 1); PG8_STAGE(PG8_SB(1, 0), b3, voffB);
            PG8_BAR; PG8_WAIT_L(0); PG8_MMA(0, 1, At, B1); PG8_BAR;
            PG8_LDA(At, 1, 1); PG8_STAGE(PG8_SA(1, 0), a3, voffA);
            PG8_BAR; PG8_WAIT_L(0); PG8_MMA(1, 0, At, B0); PG8_BAR; PG8_SCHED;
            PG8_STAGE(PG8_SB(1, 1), b3 + hstep, voffB);
            PG8_WAIT_V(6); PG8_BAR; PG8_MMA(1, 1, At, B1); PG8_BAR;
            }
        }
        if constexpr (ALIGN_EPI) { if (wr == 0) PG8_BAR; }
        if constexpr (!Epi::AFTER_DRAIN) { E(acc, cur, wr, wc, fr, fq); S.done(cur); }
        if (!has_next) break;
#pragma unroll
        for (int a = 0; a < 2; ++a)
#pragma unroll
            for (int b = 0; b < 2; ++b)
#pragma unroll
                for (int m = 0; m < 4; ++m)
#pragma unroll
                    for (int n = 0; n < 2; ++n) acc[a][b][m][n] = (f32x4){0.f, 0.f, 0.f, 0.f};
        cur = nxt; cA = nA; cB = nB; ++ui;
        if constexpr (ALIGN_EPI) { if (wr == 1) PG8_BAR; }
    }
    PG8_WAIT_V(0);
    if constexpr (!ALIGN_EPI) { if (wr == 0) PG8_BAR; }
    PG8_BAR;
    if constexpr (Epi::AFTER_DRAIN) { E.fused(acc, cur, wr, wc, fr, fq, lds, wid, lane); S.done(cur); }
#undef PG8_SA
#undef PG8_SB
#undef PG8_STAGE
#undef PG8_LDA
#undef PG8_LDB
#undef PG8_MMA
#undef PG8_WAIT_V
#undef PG8_WAIT_L
#undef PG8_BAR
#undef PG8_SCHED
}
}

#define GAS __attribute__((address_space(1)))
#define LAS __attribute__((address_space(3)))
typedef unsigned short bf16;
typedef unsigned v4u __attribute__((ext_vector_type(4)));
typedef unsigned v2u __attribute__((ext_vector_type(2)));
typedef float f32x4 __attribute__((ext_vector_type(4)));

#ifndef MK_MULTI
#define MK_MULTI 0
#endif

constexpr int BATCH = 8, SEQ = 2048, DM = 1024, M = BATCH * SEQ;
constexpr int NH = 8, HD = 64, AW = 512, SWD = 512, NG = 32, HC = 16, PS = 64, INW = 1280, FF = 2816;
constexpr float EPS = 1e-6f;
constexpr size_t MiB = 1u << 20;
constexpr size_t WS_WT1 = 2 * MiB, WS_WD1 = 14 * MiB, WS_WT2 = 20 * MiB, WS_WD2 = 32 * MiB, WS_WIN = 38 * MiB, WS_WOUT = 41 * MiB, WS_WGLU = 43 * MiB;
constexpr size_t WS_XA = 64 * MiB;
constexpr size_t WS_H = 96 * MiB;
constexpr size_t WS_QKVU = 184 * MiB;
constexpr size_t WS_ATT = 224 * MiB;
constexpr size_t WS_YG = 240 * MiB;
constexpr size_t WS_S = 96 * MiB;
constexpr size_t WS_Y = 112 * MiB;
constexpr size_t WS_Y2 = 144 * MiB;
constexpr size_t WS_MIX = 144 * MiB;
constexpr size_t WS_END = 256 * MiB;
constexpr int LDS_BYTES = 147456;

__device__ __forceinline__ unsigned f2bf(float f) { unsigned u = __builtin_bit_cast(unsigned, f); return (u + 0x7fffu + ((u >> 16) & 1u)) >> 16; }
__device__ __forceinline__ unsigned pk2(float lo, float hi) { return f2bf(lo) | (f2bf(hi) << 16); }
__device__ __forceinline__ float bflo(unsigned w) { return __builtin_bit_cast(float, w << 16); }
__device__ __forceinline__ float bfhi(unsigned w) { return __builtin_bit_cast(float, w & 0xffff0000u); }
#define LDS_WAIT() asm volatile("s_waitcnt lgkmcnt(0)" ::: "memory")
__device__ __forceinline__ float wave_sum(float v) {
#pragma unroll
    for (int o = 1; o < 64; o <<= 1) v += __shfl_xor(v, o);
    return v;
}
__device__ __forceinline__ float sigmoidf_(float x) { return __builtin_amdgcn_rcpf(1.f + __expf(-x)); }

namespace pg8 {
struct EpiSwiglu {
    static constexpr bool PERM = true, AFTER_DRAIN = false;
    bf16_t* H; int ldh;
    __device__ __forceinline__ void operator()(const f32x4 (&acc)[2][2][4][2], const Unit& u, int wr, int wc, int fr, int fq) const {
        const int row0 = u.pm * BM + wr * 64 + fr, col0 = u.pn * HALF + wc * 32 + 8 * fq;
#pragma unroll
        for (int ai = 0; ai < 2; ++ai)
#pragma unroll
            for (int m = 0; m < 4; ++m) {
                bf16_t* rowp = H + (size_t)(row0 + ai * HALF + m * 16) * ldh + col0;
                float hv[8];
#pragma unroll
                for (int n = 0; n < 2; ++n)
#pragma unroll
                    for (int i = 0; i < 4; ++i) { const float g = acc[ai][0][m][n][i], up = acc[ai][1][m][n][i]; hv[n * 4 + i] = g * __builtin_amdgcn_rcpf(1.f + __expf(-g)) * up; }
                u32x4 w; w.x = cvt_pk_bf16(hv[0], hv[1]); w.y = cvt_pk_bf16(hv[2], hv[3]); w.z = cvt_pk_bf16(hv[4], hv[5]); w.w = cvt_pk_bf16(hv[6], hv[7]);
                *(u32x4*)rowp = w;
            }
    }
};
struct EpiResid {
    static constexpr bool PERM = false, AFTER_DRAIN = false;
    const float* base; float* out; float alpha;
    __device__ __forceinline__ void operator()(const f32x4 (&acc)[2][2][4][2], const Unit& u, int wr, int wc, int fr, int fq) const {
        const int col0 = u.pn * BM + wc * 32 + 4 * fq;
#pragma unroll
        for (int ai = 0; ai < 2; ++ai)
#pragma unroll
            for (int m = 0; m < 4; ++m) {
                const size_t off = (size_t)(u.pm * BM + ai * HALF + wr * 64 + m * 16 + fr) * 1024 + col0;
#pragma unroll
                for (int bj = 0; bj < 2; ++bj)
#pragma unroll
                    for (int n = 0; n < 2; ++n) { const f32x4 b = *(const f32x4*)(base + off + bj * HALF + n * 16); *(f32x4*)(out + off + bj * HALF + n * 16) = b + acc[ai][bj][m][n] * alpha; }
            }
    }
};
struct EpiGlu {
    static constexpr bool PERM = true, AFTER_DRAIN = false;
    const bf16_t* Y; bf16_t* S; const float* bias;
    __device__ __forceinline__ void operator()(const f32x4 (&acc)[2][2][4][2], const Unit& u, int wr, int wc, int fr, int fq) const {
        const int row0 = u.pm * BM + wr * 64 + fr, col0 = u.pn * BM + wc * 32 + 8 * fq;
#pragma unroll
        for (int bj = 0; bj < 2; ++bj) {
            const f32x4 b0 = *(const f32x4*)(bias + col0 + bj * HALF), b1 = *(const f32x4*)(bias + col0 + bj * HALF + 4);
#pragma unroll
            for (int ai = 0; ai < 2; ++ai)
#pragma unroll
                for (int m = 0; m < 4; ++m) {
                    const size_t off = (size_t)(row0 + ai * HALF + m * 16) * 512 + col0 + bj * HALF;
                    const u32x4 yv = *(const u32x4*)(Y + off);
                    const f32x4 v0 = acc[ai][bj][m][0] + b0, v1 = acc[ai][bj][m][1] + b1;
                    float o[8];
                    o[0] = bflo(yv.x) * sigmoidf_(v0[0]); o[1] = bfhi(yv.x) * sigmoidf_(v0[1]); o[2] = bflo(yv.y) * sigmoidf_(v0[2]); o[3] = bfhi(yv.y) * sigmoidf_(v0[3]);
                    o[4] = bflo(yv.z) * sigmoidf_(v1[0]); o[5] = bfhi(yv.z) * sigmoidf_(v1[1]); o[6] = bflo(yv.w) * sigmoidf_(v1[2]); o[7] = bfhi(yv.w) * sigmoidf_(v1[3]);
                    u32x4 w; w.x = cvt_pk_bf16(o[0], o[1]); w.y = cvt_pk_bf16(o[2], o[3]); w.z = cvt_pk_bf16(o[4], o[5]); w.w = cvt_pk_bf16(o[6], o[7]);
                    *(u32x4*)(S + off) = w;
                }
        }
    }
};
}

template <int MODE>
__device__ __forceinline__ void p0_transpose_item(const float* W, int K, int N, bf16* WT, LAS float* scr, int item, int lane) {
    const int nblk = N / 32, kb = item / nblk, nb = item % nblk, k0 = 64 * kb, n0 = 32 * nb;
#pragma unroll 8
    for (int i = 0; i < 32; ++i) { const int kk = 2 * i + (lane >> 5); scr[kk * 33 + (lane & 31)] = W[(size_t)(k0 + kk) * N + n0 + (lane & 31)]; }
    LDS_WAIT(); asm volatile("" ::: "memory");
    const int c = lane & 7;
    const int r0 = MODE == 0 ? n0 : ((n0 >> 7) * 256 + (n0 & 127) + (MODE == 2 ? 128 : 0));
#pragma unroll
    for (int j = 0; j < 4; ++j) { const int n = (lane >> 3) + 8 * j; const LAS float* s = scr + (8 * c) * 33 + n;
        v4u o; o.x = pk2(s[0 * 33], s[1 * 33]); o.y = pk2(s[2 * 33], s[3 * 33]); o.z = pk2(s[4 * 33], s[5 * 33]); o.w = pk2(s[6 * 33], s[7 * 33]);
        *(v4u*)(WT + (size_t)(r0 + n) * K + k0 + 8 * c) = o; }
    LDS_WAIT(); asm volatile("" ::: "memory");
}

__device__ __forceinline__ void rms_row_to_bf16(const float* xrow, const float* gain, bf16* orow, int lane) {
    const f32x4* xr = (const f32x4*)xrow + lane; const f32x4* gr = (const f32x4*)gain + lane;
    f32x4 v[4]; float s = 0.f;
#pragma unroll
    for (int j = 0; j < 4; ++j) { v[j] = xr[64 * j]; s += (v[j].x * v[j].x + v[j].y * v[j].y) + (v[j].z * v[j].z + v[j].w * v[j].w); }
    const float rstd = 1.f / sqrtf(wave_sum(s) * (1.f / DM) + EPS);
    unsigned long long* o8 = (unsigned long long*)orow + lane;
#pragma unroll
    for (int j = 0; j < 4; ++j) { const f32x4 g = gr[64 * j];
        o8[64 * j] = (unsigned long long)pk2(v[j].x * rstd * g.x, v[j].y * rstd * g.y) | ((unsigned long long)pk2(v[j].z * rstd * g.z, v[j].w * rstd * g.w) << 32); }
}
__device__ __forceinline__ void rms_row_f32(float* xrow, const float* gain, int lane) {
    f32x4* xr = (f32x4*)xrow + lane; const f32x4* gr = (const f32x4*)gain + lane;
    f32x4 v[4]; float s = 0.f;
#pragma unroll
    for (int j = 0; j < 4; ++j) { v[j] = xr[64 * j]; s += (v[j].x * v[j].x + v[j].y * v[j].y) + (v[j].z * v[j].z + v[j].w * v[j].w); }
    const float rstd = 1.f / sqrtf(wave_sum(s) * (1.f / DM) + EPS);
#pragma unroll
    for (int j = 0; j < 4; ++j) { const f32x4 g = gr[64 * j]; xr[64 * j] = v[j] * rstd * g; }
}
__device__ __forceinline__ void mix_row(const bf16* arow, const bf16* srow, const float* ga, const float* gs, bf16* orow, int lane) {
    const v4u a = *((const v4u*)arow + lane), s = *((const v4u*)srow + lane);
    float av[8] = {bflo(a.x), bfhi(a.x), bflo(a.y), bfhi(a.y), bflo(a.z), bfhi(a.z), bflo(a.w), bfhi(a.w)};
    float sv[8] = {bflo(s.x), bfhi(s.x), bflo(s.y), bfhi(s.y), bflo(s.z), bfhi(s.z), bflo(s.w), bfhi(s.w)};
    float sa = 0.f, ss = 0.f;
#pragma unroll
    for (int i = 0; i < 8; ++i) { sa += av[i] * av[i]; ss += sv[i] * sv[i]; }
    const float ra = 1.f / sqrtf(wave_sum(sa) * (1.f / 512.f) + EPS), rs = 1.f / sqrtf(wave_sum(ss) * (1.f / 512.f) + EPS);
    const f32x4 ga0 = *((const f32x4*)ga + 2 * lane), ga1 = *((const f32x4*)ga + 2 * lane + 1), gs0 = *((const f32x4*)gs + 2 * lane), gs1 = *((const f32x4*)gs + 2 * lane + 1);
    v4u oa, os;
    oa.x = pk2(av[0] * ra * ga0.x, av[1] * ra * ga0.y); oa.y = pk2(av[2] * ra * ga0.z, av[3] * ra * ga0.w); oa.z = pk2(av[4] * ra * ga1.x, av[5] * ra * ga1.y); oa.w = pk2(av[6] * ra * ga1.z, av[7] * ra * ga1.w);
    os.x = pk2(sv[0] * rs * gs0.x, sv[1] * rs * gs0.y); os.y = pk2(sv[2] * rs * gs0.z, sv[3] * rs * gs0.w); os.z = pk2(sv[4] * rs * gs1.x, sv[5] * rs * gs1.y); os.w = pk2(sv[6] * rs * gs1.z, sv[7] * rs * gs1.w);
    *((v4u*)orow + lane) = oa; *((v4u*)(orow + 512) + lane) = os;
}

__device__ __forceinline__ void attn_naive(LAS unsigned char* lds, const bf16* QKVU, bf16* ATT, const float* sinks, int G, int bid) {
    const int tid = threadIdx.x, lane = tid & 63, w = tid >> 6;
    LAS bf16* Ks = (LAS bf16*)lds; LAS bf16* Vs = Ks + 384 * 64;
    for (int unit = bid; unit < 256; unit += G) {
        const int kh = unit & 1, qb = (unit >> 1) & 15, b = unit >> 5, kp0 = qb * 128 - 128;
        __syncthreads();
        for (int c = tid; c < 3072; c += 512) { const int r = c >> 3, ch = c & 7, kp = kp0 + r; v4u kv = (v4u){0u, 0u, 0u, 0u}, vv = kv;
            if (kp >= 0 && kp < SEQ) { const bf16* src = QKVU + (size_t)(b * SEQ + kp) * INW; kv = *(const v4u*)(src + 512 + kh * 64 + ch * 8); vv = *(const v4u*)(src + 640 + kh * 64 + ch * 8); }
            *(LAS v4u*)(Ks + r * 64 + ch * 8) = kv; *(LAS v4u*)(Vs + r * 64 + ch * 8) = vv; }
        __syncthreads();
        const int g = w >> 1, qa = (w & 1) * 64, qi = qa + lane, t = qb * 128 + qi, h = kh * 4 + g;
        const float slope = exp2f(-(float)(h + 1));
        float q[64], acc[64];
        { const bf16* qp = QKVU + (size_t)(b * SEQ + t) * INW + h * 64;
#pragma unroll
          for (int c = 0; c < 8; ++c) { const v4u qq = *(const v4u*)(qp + c * 8);
              q[c * 8 + 0] = bflo(qq.x) * 0.125f; q[c * 8 + 1] = bfhi(qq.x) * 0.125f; q[c * 8 + 2] = bflo(qq.y) * 0.125f; q[c * 8 + 3] = bfhi(qq.y) * 0.125f;
              q[c * 8 + 4] = bflo(qq.z) * 0.125f; q[c * 8 + 5] = bfhi(qq.z) * 0.125f; q[c * 8 + 6] = bflo(qq.w) * 0.125f; q[c * 8 + 7] = bfhi(qq.w) * 0.125f; } }
#pragma unroll
        for (int d = 0; d < 64; ++d) acc[d] = 0.f;
        float mx = sinks[h], l = 1.f;
        for (int jj = qa; jj < qa + 320; ++jj) {
            float s = 0.f;
#pragma unroll
            for (int c = 0; c < 8; ++c) { const v4u kk = *(const LAS v4u*)(Ks + jj * 64 + c * 8);
                s += q[c * 8 + 0] * bflo(kk.x) + q[c * 8 + 1] * bfhi(kk.x) + q[c * 8 + 2] * bflo(kk.y) + q[c * 8 + 3] * bfhi(kk.y)
                   + q[c * 8 + 4] * bflo(kk.z) + q[c * 8 + 5] * bfhi(kk.z) + q[c * 8 + 6] * bflo(kk.w) + q[c * 8 + 7] * bfhi(kk.w); }
            const int rel = jj - 128 - qi, kp = kp0 + jj;
            const bool valid = (rel >= -128) && (rel <= 128) && (kp >= 0) && (kp < SEQ);
            s = valid ? s - slope * fabsf((float)rel) : -1e30f;
            const float mn = fmaxf(mx, s), corr = __expf(mx - mn), p = __expf(s - mn);
            l = l * corr + p; mx = mn;
#pragma unroll
            for (int c = 0; c < 8; ++c) { const v4u vv = *(const LAS v4u*)(Vs + jj * 64 + c * 8);
                acc[c * 8 + 0] = acc[c * 8 + 0] * corr + p * bflo(vv.x); acc[c * 8 + 1] = acc[c * 8 + 1] * corr + p * bfhi(vv.x);
                acc[c * 8 + 2] = acc[c * 8 + 2] * corr + p * bflo(vv.y); acc[c * 8 + 3] = acc[c * 8 + 3] * corr + p * bfhi(vv.y);
                acc[c * 8 + 4] = acc[c * 8 + 4] * corr + p * bflo(vv.z); acc[c * 8 + 5] = acc[c * 8 + 5] * corr + p * bfhi(vv.z);
                acc[c * 8 + 6] = acc[c * 8 + 6] * corr + p * bflo(vv.w); acc[c * 8 + 7] = acc[c * 8 + 7] * corr + p * bfhi(vv.w); }
        }
        const float inv = 1.f / l;
        bf16* op = ATT + (size_t)(b * SEQ + t) * AW + h * 64;
#pragma unroll
        for (int c = 0; c < 8; ++c) { v4u o; o.x = pk2(acc[c * 8 + 0] * inv, acc[c * 8 + 1] * inv); o.y = pk2(acc[c * 8 + 2] * inv, acc[c * 8 + 3] * inv);
            o.z = pk2(acc[c * 8 + 4] * inv, acc[c * 8 + 5] * inv); o.w = pk2(acc[c * 8 + 6] * inv, acc[c * 8 + 7] * inv); *(v4u*)(op + c * 8) = o; }
    }
}

struct SsmP { const float *lam_re, *lam_im, *log_dt, *b_re, *b_im, *c_re, *c_im, *dskip; };
__device__ __forceinline__ float gelu_tanh(float x) { const float z = 1.5957691216f * (x + 0.044715f * x * x * x); return x * __builtin_amdgcn_rcpf(1.f + __expf(-z)); }
__device__ __forceinline__ void ssm_naive(LAS unsigned char* lds, const bf16* QKVU, float* Y, float* Y2, bf16* YG, const SsmP P, int G, int bid) {
    const int tid = threadIdx.x, lane = tid & 63, w = tid >> 6;
    for (int unit = bid; unit < 256; unit += G) {
        const int b = unit >> 5, g = unit & 31;
        __syncthreads();
        if (w < 2) {
            const int d = w, dg = d * NG + g;
            LAS float* XR = (LAS float*)(lds + w * 49152); LAS float* XI = XR + 64 * 65; LAS float* U = XI + 64 * 65; LAS float* Cre = U + 64 * 16; LAS float* Cim = Cre + 16 * 64;
            const float lr = fminf(P.lam_re[dg * PS + lane], -1e-4f), li = P.lam_im[dg * PS + lane], dt = expf(P.log_dt[dg]);
            const float mag = expf(lr * dt), a_re = mag * cosf(li * dt), a_im = mag * sinf(li * dt), den = lr * lr + li * li;
            const float cr = ((a_re - 1.f) * lr + a_im * li) / den, ci = (a_im * lr - (a_re - 1.f) * li) / den;
            float bbr[16], bbi[16];
#pragma unroll
            for (int h = 0; h < 16; ++h) { const float br = P.b_re[(size_t)(dg * PS + lane) * HC + h], bi = P.b_im[(size_t)(dg * PS + lane) * HC + h]; bbr[h] = cr * br - ci * bi; bbi[h] = cr * bi + ci * br; }
#pragma unroll
            for (int i = 0; i < 16; ++i) { Cre[i * 64 + lane] = P.c_re[(size_t)dg * HC * PS + i * 64 + lane]; Cim[i * 64 + lane] = P.c_im[(size_t)dg * HC * PS + i * 64 + lane]; }
            float dsk[16];
#pragma unroll
            for (int h = 0; h < 16; ++h) dsk[h] = P.dskip[g * HC + h];
            float xr = 0.f, xi = 0.f;
            for (int cc = 0; cc < 32; ++cc) {
                const int c = d ? 31 - cc : cc, t0 = c * 64;
                { const bf16* src = QKVU + (size_t)(b * SEQ + t0 + lane) * INW + 768 + g * 16; const v4u u0 = *(const v4u*)src, u1 = *(const v4u*)(src + 8);
                  LDS_WAIT(); asm volatile("" ::: "memory");
                  *(LAS f32x4*)(U + lane * 16 + 0) = (f32x4){bflo(u0.x), bfhi(u0.x), bflo(u0.y), bfhi(u0.y)}; *(LAS f32x4*)(U + lane * 16 + 4) = (f32x4){bflo(u0.z), bfhi(u0.z), bflo(u0.w), bfhi(u0.w)};
                  *(LAS f32x4*)(U + lane * 16 + 8) = (f32x4){bflo(u1.x), bfhi(u1.x), bflo(u1.y), bfhi(u1.y)}; *(LAS f32x4*)(U + lane * 16 + 12) = (f32x4){bflo(u1.z), bfhi(u1.z), bflo(u1.w), bfhi(u1.w)}; }
                LDS_WAIT(); asm volatile("" ::: "memory");
                for (int s = 0; s < 64; ++s) {
                    const int tt = d ? 63 - s : s;
                    const f32x4 ua = *(const LAS f32x4*)(U + tt * 16), ub = *(const LAS f32x4*)(U + tt * 16 + 4), uc = *(const LAS f32x4*)(U + tt * 16 + 8), ud = *(const LAS f32x4*)(U + tt * 16 + 12);
                    const float uu[16] = {ua.x, ua.y, ua.z, ua.w, ub.x, ub.y, ub.z, ub.w, uc.x, uc.y, uc.z, uc.w, ud.x, ud.y, ud.z, ud.w};
                    float bur = 0.f, bui = 0.f;
#pragma unroll
                    for (int h = 0; h < 16; ++h) { bur += bbr[h] * uu[h]; bui += bbi[h] * uu[h]; }
                    const float nxr = a_re * xr - a_im * xi + bur, nxi = a_re * xi + a_im * xr + bui; xr = nxr; xi = nxi;
                    XR[tt * 65 + lane] = xr; XI[tt * 65 + lane] = xi;
                }
                LDS_WAIT(); asm volatile("" ::: "memory");
                float acc[16];
#pragma unroll
                for (int h = 0; h < 16; ++h) acc[h] = 0.f;
                for (int p = 0; p < 64; ++p) { const float r = XR[lane * 65 + p], im = XI[lane * 65 + p];
#pragma unroll
                    for (int h = 0; h < 16; ++h) acc[h] += Cre[h * 64 + p] * r - Cim[h * 64 + p] * im; }
                if (d == 0) {
#pragma unroll
                    for (int h = 0; h < 16; ++h) acc[h] += dsk[h] * U[lane * 16 + h];
                }
                float* dst = (d ? Y2 : Y) + (size_t)(b * SEQ + t0 + lane) * SWD + g * 16;
#pragma unroll
                for (int h4 = 0; h4 < 4; ++h4) *(f32x4*)(dst + h4 * 4) = (f32x4){acc[h4 * 4], acc[h4 * 4 + 1], acc[h4 * 4 + 2], acc[h4 * 4 + 3]};
            }
        }
        __threadfence_block();
        __syncthreads();
        for (int i = tid; i < 8192; i += 512) { const int t = i >> 2, hq = (i & 3) * 4; const size_t off = (size_t)(b * SEQ + t) * SWD + g * 16 + hq;
            const f32x4 v = *(const f32x4*)(Y + off) + *(const f32x4*)(Y2 + off);
            v2u o; o.x = pk2(gelu_tanh(v.x), gelu_tanh(v.y)); o.y = pk2(gelu_tanh(v.z), gelu_tanh(v.w)); *(v2u*)(YG + off) = o; }
    }
}

struct Args { const float* in[26]; float* out; unsigned char* ws; int ph_lo, ph_hi; };
constexpr int N_PHASES = 14;
__global__ void __launch_bounds__(512, 2) mk_fwd(Args args) {
    extern __shared__ __attribute__((aligned(16))) unsigned char lds_raw[];
    LAS unsigned char* lds = (LAS unsigned char*)lds_raw;
    cg::grid_group grid = cg::this_grid();
    const int tid = threadIdx.x, lane = tid & 63, wave = __builtin_amdgcn_readfirstlane(tid >> 6);
    const int G = gridDim.x, bid = blockIdx.x;
    const int gw = bid * 8 + wave, NGW = G * 8;
    unsigned char* ws = args.ws;
    const float* x = args.in[0];
    float* X = args.out;
    bf16* WT1 = (bf16*)(ws + WS_WT1); bf16* WD1 = (bf16*)(ws + WS_WD1); bf16* WT2 = (bf16*)(ws + WS_WT2); bf16* WD2 = (bf16*)(ws + WS_WD2);
    bf16* WIN = (bf16*)(ws + WS_WIN); bf16* WOUT = (bf16*)(ws + WS_WOUT); bf16* WGLU = (bf16*)(ws + WS_WGLU);
    bf16* XA = (bf16*)(ws + WS_XA); bf16* HB = (bf16*)(ws + WS_H); bf16* QKVU = (bf16*)(ws + WS_QKVU); bf16* ATT = (bf16*)(ws + WS_ATT); bf16* YG = (bf16*)(ws + WS_YG);
    bf16* SB = (bf16*)(ws + WS_S); float* Y = (float*)(ws + WS_Y); float* Y2 = (float*)(ws + WS_Y2); bf16* MIX = (bf16*)(ws + WS_MIX);
    const int lo = args.ph_lo, hi = args.ph_hi;
#define IN(k) (lo <= (k) && (k) < hi)
#define SEAM(k) do { if (IN(k) && IN((k) + 1)) grid.sync(); } while (0)

    if (IN(0)) {
        LAS float* scr = (LAS float*)(lds + wave * 16384);
        constexpr int I_UP = (DM / 64) * (FF / 32), I_DN = (FF / 64) * (DM / 32), I_IN = (DM / 64) * (INW / 32), I_GLU = (SWD / 64) * (SWD / 32), I_OUT = (DM / 64) * (DM / 32);
        constexpr int NITEMS = 6 * I_UP + I_IN + I_GLU + I_OUT; static_assert(I_UP == I_DN, "");
        for (int it = gw; it < NITEMS; it += NGW) {
            int r = it;
            if (r < I_UP) { p0_transpose_item<1>(args.in[2], DM, FF, WT1, scr, r, lane); continue; } r -= I_UP;
            if (r < I_UP) { p0_transpose_item<2>(args.in[3], DM, FF, WT1, scr, r, lane); continue; } r -= I_UP;
            if (r < I_DN) { p0_transpose_item<0>(args.in[4], FF, DM, WD1, scr, r, lane); continue; } r -= I_DN;
            if (r < I_UP) { p0_transpose_item<1>(args.in[22], DM, FF, WT2, scr, r, lane); continue; } r -= I_UP;
            if (r < I_UP) { p0_transpose_item<2>(args.in[23], DM, FF, WT2, scr, r, lane); continue; } r -= I_UP;
            if (r < I_DN) { p0_transpose_item<0>(args.in[24], FF, DM, WD2, scr, r, lane); continue; } r -= I_DN;
            if (r < I_IN) { p0_transpose_item<0>(args.in[6], DM, INW, WIN, scr, r, lane); continue; } r -= I_IN;
            if (r < I_GLU) { p0_transpose_item<0>(args.in[16], SWD, SWD, WGLU, scr, r, lane); continue; } r -= I_GLU;
            p0_transpose_item<0>(args.in[20], DM, DM, WOUT, scr, r, lane);
        }
        for (int m = gw; m < M; m += NGW) rms_row_to_bf16(x + (size_t)m * DM, args.in[1], XA + (size_t)m * DM, lane);
    }
    SEAM(0);
    if (IN(1)) { pg8::Gemm g{XA, WT1, M, 2 * FF, DM}; pg8::StaticOrder S; S.init(M, 2 * FF, G, bid); pg8::EpiSwiglu E{HB, FF};
        pg8::gemm_phase<pg8::EpiSwiglu, pg8::StaticOrder, true, true>(lds, g, S, E); }
    SEAM(1);
    if (IN(2)) { pg8::Gemm g{HB, WD1, M, DM, FF}; pg8::StaticOrder S; S.init(M, DM, G, bid); pg8::EpiResid E{x, X, 0.5f};
        pg8::gemm_phase<pg8::EpiResid, pg8::StaticOrder, true, true>(lds, g, S, E); }
    SEAM(2);
    if (IN(3)) { for (int m = gw; m < M; m += NGW) rms_row_to_bf16(X + (size_t)m * DM, args.in[5], XA + (size_t)m * DM, lane); }
    SEAM(3);
    if (IN(4)) { pg8::Gemm g{XA, WIN, M, INW, DM}; pg8::StaticOrder S; S.init(M, INW, G, bid); pg8::EpiBf16<0> E{QKVU, INW, nullptr, 0, 0, 1.f};
        pg8::gemm_phase<pg8::EpiBf16<0>, pg8::StaticOrder, true, true>(lds, g, S, E); }
    SEAM(4);
    if (IN(5)) attn_naive(lds, QKVU, ATT, args.in[7], G, bid);
    SEAM(5);
    if (IN(6)) { const SsmP P{args.in[8], args.in[9], args.in[10], args.in[11], args.in[12], args.in[13], args.in[14], args.in[15]}; ssm_naive(lds, QKVU, Y, Y2, YG, P, G, bid); }
    SEAM(6);
    if (IN(7)) { pg8::Gemm g{YG, WGLU, M, SWD, SWD}; pg8::StaticOrder S; S.init(M, SWD, G, bid); pg8::EpiGlu E{YG, SB, args.in[17]};
        pg8::gemm_phase<pg8::EpiGlu, pg8::StaticOrder, true, true>(lds, g, S, E); }
    SEAM(7);
    if (IN(8)) { for (int m = gw; m < M; m += NGW) mix_row(ATT + (size_t)m * AW, SB + (size_t)m * SWD, args.in[18], args.in[19], MIX + (size_t)m * DM, lane); }
    SEAM(8);
    if (IN(9)) { pg8::Gemm g{MIX, WOUT, M, DM, DM}; pg8::StaticOrder S; S.init(M, DM, G, bid); pg8::EpiResid E{X, X, 1.0f};
        pg8::gemm_phase<pg8::EpiResid, pg8::StaticOrder, true, true>(lds, g, S, E); }
    SEAM(9);
    if (IN(10)) { for (int m = gw; m < M; m += NGW) rms_row_to_bf16(X + (size_t)m * DM, args.in[21], XA + (size_t)m * DM, lane); }
    SEAM(10);
    if (IN(11)) { pg8::Gemm g{XA, WT2, M, 2 * FF, DM}; pg8::StaticOrder S; S.init(M, 2 * FF, G, bid); pg8::EpiSwiglu E{HB, FF};
        pg8::gemm_phase<pg8::EpiSwiglu, pg8::StaticOrder, true, true>(lds, g, S, E); }
    SEAM(11);
    if (IN(12)) { pg8::Gemm g{HB, WD2, M, DM, FF}; pg8::StaticOrder S; S.init(M, DM, G, bid); pg8::EpiResid E{X, X, 0.5f};
        pg8::gemm_phase<pg8::EpiResid, pg8::StaticOrder, true, true>(lds, g, S, E); }
    SEAM(12);
    if (IN(13)) { for (int m = gw; m < M; m += NGW) rms_row_f32(X + (size_t)m * DM, args.in[25], lane); }
#undef IN
#undef SEAM
}

extern "C" void kernel_launch(void* const* d_in, const int* in_sizes, int n_in, void* d_out, int out_size, void* d_ws, size_t ws_size, hipStream_t stream) {
    static int grid = 0;
    if (grid == 0) {
        if (n_in != 26 || in_sizes[0] != M * DM || out_size != M * DM || ws_size < WS_END) { fprintf(stderr, "kernel_launch: unexpected shapes n_in %d in0 %d out %d ws %zu\n", n_in, n_in > 0 ? in_sizes[0] : -1, out_size, ws_size); grid = -1; return; }
        int dev = 0, cus = 0, per_cu = 0;
        (void)hipGetDevice(&dev); (void)hipDeviceGetAttribute(&cus, hipDeviceAttributeMultiprocessorCount, dev);
        if (hipFuncSetAttribute((const void*)mk_fwd, hipFuncAttributeMaxDynamicSharedMemorySize, LDS_BYTES) != hipSuccess) { fprintf(stderr, "kernel_launch: hipFuncSetAttribute failed\n"); grid = -1; return; }
        if (hipOccupancyMaxActiveBlocksPerMultiprocessor(&per_cu, (const void*)mk_fwd, 512, LDS_BYTES) != hipSuccess || per_cu < 1) { fprintf(stderr, "kernel_launch: occupancy query says %d\n", per_cu); per_cu = 1; }
        (void)hipGetLastError();
        grid = cus * per_cu;
        fprintf(stderr, "kernel_launch: grid %d (cus %d per_cu %d)\n", grid, cus, per_cu);
    }
    if (grid < 0) return;
    Args a{};
    for (int i = 0; i < 26; ++i) a.in[i] = (const float*)d_in[i];
    a.out = (float*)d_out; a.ws = (unsigned char*)d_ws;
#if MK_MULTI
    for (int ph = 0; ph < N_PHASES; ++ph) { a.ph_lo = ph; a.ph_hi = ph + 1; hipLaunchKernelGGL(mk_fwd, dim3(grid), dim3(512), LDS_BYTES, stream, a); }
#else
    a.ph_lo = 0; a.ph_hi = N_PHASES;
    void* kargs[] = {&a};
    hipError_t e = hipLaunchCooperativeKernel((const void*)mk_fwd, dim3(grid), dim3(512), kargs, LDS_BYTES, stream);
    if (e != hipSuccess) fprintf(stderr, "cooperative launch failed: %s (grid %d)\n", hipGetErrorString(e), grid);
#endif
}
```

```cpp
#include <hip/hip_runtime.h>
#include <hip/hip_cooperative_groups.h>
#include <cstdio>
#include <cstdint>
namespace cg = cooperative_groups;
#define MK_MULTI 0
namespace pg8 {
#define PG8_LAS __attribute__((address_space(3)))
typedef unsigned short bf16_t;
typedef short bf16x8 __attribute__((ext_vector_type(8)));
typedef float f32x4 __attribute__((ext_vector_type(4)));
typedef unsigned u32x4 __attribute__((ext_vector_type(4)));
constexpr int BM = 256, BK = 64, HALF = 128, HTB = HALF * BK * 2  , STAGE_BYTES = 8 * HTB, NXCD = 8, WGM = 8;

__host__ __device__ __forceinline__ int lds_byte(int r, int c) { const int st = (r >> 4) * 2 + (c >> 5), rr = r & 15, cc = c & 31, ob = rr * 64 + cc * 2; return st * 1024 + (ob ^ (((ob >> 9) & 1) << 5)); }
__host__ __device__ __forceinline__ void stage_rc(int b, int& R, int& C) { const int st = b / 1024, sb = b % 1024, swz = sb ^ (((sb >> 9) & 1) << 5); R = (st >> 1) * 16 + swz / 64; C = (st & 1) * 32 + (swz % 64) / 2; }
__host__ __device__ __forceinline__ int perm32(int rho) { const int n = rho >> 4, i = rho & 15; return 8 * (i >> 2) + 4 * n + (i & 3); }

struct Unit { int pm, pn; };
struct Gemm { const bf16_t* A; const bf16_t* Bt; int M, N, K; };

struct StaticOrder {
    int nM, nN, nwg, G, c;
    __host__ __device__ void init(int M, int N, int G_, int c_) { nM = M / BM; nN = N / BM; nwg = nM * nN; G = G_; c = c_; }
    __host__ __device__ bool next(int i, Unit& u) const {
        const long L = (long)i * G + c; if (L >= nwg) return false;
        int wgid = (int)L; { const int q = nwg / NXCD, r = nwg % NXCD, xcd = wgid % NXCD, off = wgid / NXCD; wgid = (xcd < r ? xcd * (q + 1) : r * (q + 1) + (xcd - r) * q) + off; }
        const int nig = WGM * nN, gid = wgid / nig, fm = gid * WGM, gsz = (nM - fm) < WGM ? (nM - fm) : WGM;
        u.pm = fm + ((wgid % nig) % gsz); u.pn = (wgid % nig) / gsz; return true;
    }
    __device__ __forceinline__ void a_ready(const Unit&) const {}
    __device__ __forceinline__ void done(const Unit&) const {}
};

__device__ __forceinline__ unsigned cvt_pk_bf16(float lo, float hi) { unsigned r; asm volatile("v_cvt_pk_bf16_f32 %0, %1, %2" : "=v"(r) : "v"(lo), "v"(hi)); return r; }
typedef float f32x2 __attribute__((ext_vector_type(2)));
__device__ __forceinline__ f32x2 gelu_pk(f32x2 v) {
    const f32x2 av = __builtin_elementwise_abs(v), d = av * 0.2316418882f + 1.0f;
    f32x2 t; t.x = __builtin_amdgcn_rcpf(d.x); t.y = __builtin_amdgcn_rcpf(d.y);
    f32x2 q = t * 0.5307027145f + (-0.7265760135f); q = q * t + 0.7107068705f; q = q * t + (-0.142248368f); q = q * t + 0.127414796f; q = q * t;
    const f32x2 s = (v * v) * (-0.72134752044f);
    f32x2 e; e.x = __builtin_amdgcn_exp2f(s.x); e.y = __builtin_amdgcn_exp2f(s.y);
    const f32x2 m = v * (q * e), r = v - m;
    f32x2 o; o.x = v.x < 0.f ? m.x : r.x; o.y = v.y < 0.f ? m.y : r.y; return o;
}

template <int ACT  > struct EpiBf16 {
    static constexpr bool PERM = true, AFTER_DRAIN = false; static_assert(ACT == 0 || ACT == 1, "EpiBf16: ACT is 0 (none) or 1 (gelu_pk)");
    bf16_t* O; int ldc; const float* bias; int split_cols; size_t split_stride; float scale0;
    __device__ __forceinline__ void operator()(const f32x4 (&acc)[2][2][4][2], const Unit& u, int wr, int wc, int fr, int fq) const {
        const int row0 = u.pm * BM + wr * 64 + fr; int colt = u.pn * BM; bf16_t* base = O;
        float sc = 1.f; if (split_cols) { const int t = colt / split_cols; base += (size_t)t * split_stride; colt -= t * split_cols; if (t == 0) sc = scale0; }
        const int col0 = colt + wc * 32 + 8 * fq, bcol0 = u.pn * BM + wc * 32 + 8 * fq;
        f32x4 bv[2][2];
#pragma unroll
        for (int bj = 0; bj < 2; ++bj)
#pragma unroll
            for (int n = 0; n < 2; ++n) bv[bj][n] = bias ? *(const f32x4*)(bias + bcol0 + bj * HALF + 4 * n) : (f32x4){0.f, 0.f, 0.f, 0.f};
#pragma unroll
        for (int ai = 0; ai < 2; ++ai)
#pragma unroll
            for (int m = 0; m < 4; ++m) { bf16_t* rowp = base + (size_t)(row0 + ai * HALF + m * 16) * ldc + col0;
#pragma unroll
                for (int bj = 0; bj < 2; ++bj) { f32x4 v0 = acc[ai][bj][m][0] + bv[bj][0], v1 = acc[ai][bj][m][1] + bv[bj][1];
                    if (ACT == 1) { f32x2 a = gelu_pk((f32x2){v0[0], v0[1]}), b = gelu_pk((f32x2){v0[2], v0[3]}), c = gelu_pk((f32x2){v1[0], v1[1]}), d = gelu_pk((f32x2){v1[2], v1[3]});
                        v0 = (f32x4){a.x, a.y, b.x, b.y}; v1 = (f32x4){c.x, c.y, d.x, d.y}; }
                    v0 = v0 * sc; v1 = v1 * sc; u32x4 w; w.x = cvt_pk_bf16(v0[0], v0[1]); w.y = cvt_pk_bf16(v0[2], v0[3]); w.z = cvt_pk_bf16(v1[0], v1[1]); w.w = cvt_pk_bf16(v1[2], v1[3]);
                    *(u32x4*)(rowp + bj * HALF) = w; } }
    }
};
template <class Epi, class Sched, bool ALIGN_EPI = false, bool SP2 = false>
__device__ __forceinline__ void gemm_phase(PG8_LAS unsigned char* lds, const Gemm g, const Sched& S, const Epi& E) {
    const int tid = threadIdx.x, wid = __builtin_amdgcn_readfirstlane(tid >> 6), lane = tid & 63, wr = wid >> 2, wc = wid & 3, fr = lane & 15, fq = lane >> 4;
    const int K = g.K, nt = K / BK;
    unsigned voffA[2], voffB[2];
#pragma unroll
    for (int i = 0; i < 2; ++i) { int R, C; stage_rc(tid * 16 + i * 8192, R, C); const int Rb = Epi::PERM ? ((R & ~31) + perm32(R & 31)) : R;
        voffA[i] = (unsigned)(R * K + C) * 2u; voffB[i] = (unsigned)(Rb * K + C) * 2u; }
    const size_t kstep = (size_t)(BK * 2);
    const size_t hstep = (size_t)HALF * K * 2;
    const size_t tstep = 2 * hstep;
    const unsigned ldsw = (unsigned)wid * 1024u;
    const int aoff = lds_byte(wr * 64 + fr, fq * 8), boff = lds_byte(wc * 32 + fr, fq * 8);
#define PG8_SA(b, h) (((b) * 2 + (h)) * HTB)
#define PG8_SB(b, h) ((4 + (b) * 2 + (h)) * HTB)
#define PG8_STAGE(bufoff, gbase, voff) do { _Pragma("unroll") for (int _i = 0; _i < 2; ++_i) \
        __builtin_amdgcn_global_load_lds((const unsigned*)((const char*)(gbase) + (voff)[_i]), (PG8_LAS unsigned*)(lds + (bufoff) + ldsw + _i * 8192), 16, 0, 0); } while (0)
#define PG8_LDA(dst, b, h) do { _Pragma("unroll") for (int m = 0; m < 4; ++m) _Pragma("unroll") for (int k = 0; k < 2; ++k) dst[m][k] = *(const PG8_LAS bf16x8*)(lds + PG8_SA(b, h) + aoff + m * 2048 + k * 1024); } while (0)
#define PG8_LDB(dst, b, h) do { _Pragma("unroll") for (int n = 0; n < 2; ++n) _Pragma("unroll") for (int k = 0; k < 2; ++k) dst[n][k] = *(const PG8_LAS bf16x8*)(lds + PG8_SB(b, h) + boff + n * 2048 + k * 1024); } while (0)
#define PG8_MMA(ai, bj, At, Bt) do { __builtin_amdgcn_s_setprio(1); _Pragma("unroll") for (int m = 0; m < 4; ++m) _Pragma("unroll") for (int n = 0; n < 2; ++n) _Pragma("unroll") for (int k = 0; k < 2; ++k) \
        acc[ai][bj][m][n] = __builtin_amdgcn_mfma_f32_16x16x32_bf16(Bt[n][k], At[m][k], acc[ai][bj][m][n], 0, 0, 0); __builtin_amdgcn_s_setprio(0); } while (0)
#define PG8_WAIT_V(n) asm volatile("s_waitcnt vmcnt(" #n ")" ::: "memory")
#define PG8_WAIT_L(n) asm volatile("s_waitcnt lgkmcnt(" #n ")" ::: "memory")
#define PG8_BAR __builtin_amdgcn_s_barrier()
#define PG8_SCHED __builtin_amdgcn_sched_barrier(0)
    Unit cur, nxt; int ui = 0;
    if (!S.next(0, cur)) return;
    f32x4 acc[2][2][4][2];
#pragma unroll
    for (int a = 0; a < 2; ++a)
#pragma unroll
        for (int b = 0; b < 2; ++b)
#pragma unroll
            for (int m = 0; m < 4; ++m)
#pragma unroll
                for (int n = 0; n < 2; ++n) acc[a][b][m][n] = (f32x4){0.f, 0.f, 0.f, 0.f};
    bf16x8 At[4][2], B0[2][2], B1[2][2];
    const char* cA = (const char*)g.A + (size_t)cur.pm * tstep; const char* cB = (const char*)g.Bt + (size_t)cur.pn * tstep;
    S.a_ready(cur);
    if constexpr (SP2) {
        PG8_STAGE(PG8_SB(0, 0), cB, voffB); PG8_STAGE(PG8_SB(0, 1), cB + hstep, voffB); PG8_STAGE(PG8_SA(0, 0), cA, voffA); PG8_STAGE(PG8_SA(0, 1), cA + hstep, voffA);
        if (wr == 1) PG8_BAR;
        PG8_WAIT_V(2); PG8_BAR;
        PG8_STAGE(PG8_SB(1, 0), cB + kstep, voffB); PG8_STAGE(PG8_SA(1, 0), cA + kstep, voffA); PG8_STAGE(PG8_SB(1, 1), cB + hstep + kstep, voffB);
        PG8_WAIT_V(6); PG8_BAR;
    } else {
        PG8_STAGE(PG8_SB(0, 0), cB, voffB); PG8_STAGE(PG8_SA(0, 0), cA, voffA); PG8_STAGE(PG8_SB(0, 1), cB + hstep, voffB); PG8_STAGE(PG8_SA(0, 1), cA + hstep, voffA);
        if (wr == 1) PG8_BAR;
        PG8_WAIT_V(4); PG8_BAR;
        PG8_STAGE(PG8_SB(1, 0), cB + kstep, voffB); PG8_STAGE(PG8_SA(1, 0), cA + kstep, voffA); PG8_STAGE(PG8_SB(1, 1), cB + hstep + kstep, voffB);
        PG8_WAIT_V(6); PG8_BAR;
    }
    for (;;) {
        const bool has_next = S.next(ui + 1, nxt);
        const char* nA = has_next ? (const char*)g.A + (size_t)nxt.pm * tstep : cA; const char* nB = has_next ? (const char*)g.Bt + (size_t)nxt.pn * tstep : cB;
        for (int t = 0; t < nt; t += 2) {
            const bool last = (t == nt - 2);
            const char* a1 = cA + (size_t)(t + 1) * kstep;
            const char* a2 = last ? nA : cA + (size_t)(t + 2) * kstep; const char* b2 = last ? nB : cB + (size_t)(t + 2) * kstep;
            const char* a3 = a2 + kstep; const char* b3 = b2 + kstep;
            if (last && has_next) S.a_ready(nxt);
            if constexpr (SP2) {
            PG8_LDB(B0, 0, 0); PG8_LDB(B1, 0, 1); PG8_SCHED; PG8_LDA(At, 0, 0); PG8_STAGE(PG8_SA(1, 1), a1 + hstep, voffA);
            PG8_WAIT_V(8); PG8_WAIT_L(0); PG8_BAR; PG8_MMA(0, 0, At, B0); PG8_MMA(0, 1, At, B1); PG8_BAR; PG8_SCHED;
            PG8_LDA(At, 0, 1); PG8_STAGE(PG8_SB(0, 0), b2, voffB); PG8_STAGE(PG8_SB(0, 1), b2 + hstep, voffB); PG8_STAGE(PG8_SA(0, 0), a2, voffA);
            PG8_WAIT_V(8); PG8_WAIT_L(0); PG8_BAR; PG8_MMA(1, 0, At, B0); PG8_MMA(1, 1, At, B1); PG8_BAR; PG8_SCHED;
            PG8_LDB(B0, 1, 0); PG8_LDB(B1, 1, 1); PG8_SCHED; PG8_LDA(At, 1, 0); PG8_STAGE(PG8_SA(0, 1), a2 + hstep, voffA);
            PG8_WAIT_V(8); PG8_WAIT_L(0); PG8_BAR; PG8_MMA(0, 0, At, B0); PG8_MMA(0, 1, At, B1); PG8_BAR; PG8_SCHED;
            PG8_LDA(At, 1, 1); PG8_STAGE(PG8_SB(1, 0), b3, voffB); PG8_STAGE(PG8_SB(1, 1), b3 + hstep, voffB); PG8_STAGE(PG8_SA(1, 0), a3, voffA);
            PG8_WAIT_V(8); PG8_WAIT_L(0); PG8_BAR; PG8_MMA(1, 0, At, B0); PG8_MMA(1, 1, At, B1); PG8_BAR; PG8_SCHED;
            } else {
            PG8_LDB(B0, 0, 0); PG8_SCHED; PG8_LDA(At, 0, 0); PG8_STAGE(PG8_SA(1, 1), a1 + hstep, voffA);
            PG8_WAIT_L(8); PG8_BAR; PG8_WAIT_L(0); PG8_MMA(0, 0, At, B0); PG8_BAR; PG8_SCHED;
            PG8_LDB(B1, 0, 1); PG8_STAGE(PG8_SB(0, 0), b2, voffB);
            PG8_BAR; PG8_WAIT_L(0); PG8_MMA(0, 1, At, B1); PG8_BAR;
            PG8_LDA(At, 0, 1); PG8_STAGE(PG8_SA(0, 0), a2, voffA);
            PG8_BAR; PG8_WAIT_L(0); PG8_MMA(1, 0, At, B0); PG8_BAR; PG8_SCHED;
            PG8_STAGE(PG8_SB(0, 1), b2 + hstep, voffB);
            PG8_WAIT_V(6); PG8_BAR; PG8_MMA(1, 1, At, B1); PG8_BAR;
            PG8_LDB(B0, 1, 0); PG8_SCHED; PG8_LDA(At, 1, 0); PG8_STAGE(PG8_SA(0, 1), a2 + hstep, voffA);
            PG8_WAIT_L(8); PG8_BAR; PG8_WAIT_L(0); PG8_MMA(0, 0, At, B0); PG8_BAR; PG8_SCHED;
            PG8_LDB(B1, 1, 1); PG8_STAGE(PG8_SB(1, 0), b3, voffB);
            PG8_BAR; PG8_WAIT_L(0); PG8_MMA(0, 1, At, B1); PG8_BAR;
            PG8_LDA(At, 1, 1); PG8_STAGE(PG8_SA(1, 0), a3, voffA);
            PG8_BAR; PG8_WAIT_L(0); PG8_MMA(1, 0, At, B0); PG8_BAR; PG8_SCHED;
            PG8_STAGE(PG8_SB(1, 1), b3 + hstep, voffB);
            PG8_WAIT_V(6); PG8_BAR; PG8_MMA(1, 1, At, B1); PG8_BAR;
            }
        }
        if constexpr (ALIGN_EPI) { if (wr == 0) PG8_BAR; }
        if constexpr (!Epi::AFTER_DRAIN) { E(acc, cur, wr, wc, fr, fq); S.done(cur); }
        if (!has_next) break;
#pragma unroll
        for (int a = 0; a < 2; ++a)
#pragma unroll
            for (int b = 0; b < 2; ++b)
#pragma unroll
                for (int m = 0; m < 4; ++m)
#pragma unroll
                    for (int n = 0; n < 2; ++n) acc[a][b][m][n] = (f32x4){0.f, 0.f, 0.f, 0.f};
        cur = nxt; cA = nA; cB = nB; ++ui;
        if constexpr (ALIGN_EPI) { if (wr == 1) PG8_BAR; }
    }
    PG8_WAIT_V(0);
    if constexpr (!ALIGN_EPI) { if (wr == 0) PG8_BAR; }
    PG8_BAR;
    if constexpr (Epi::AFTER_DRAIN) { E.fused(acc, cur, wr, wc, fr, fq, lds, wid, lane); S.done(cur); }
#undef PG8_SA
#undef PG8_SB
#undef PG8_STAGE
#undef PG8_LDA
#undef PG8_LDB
#undef PG8_MMA
#undef PG8_WAIT_V
#undef PG8_WAIT_L
#undef PG8_BAR
#undef PG8_SCHED
}
}

#define GAS __attribute__((address_space(1)))
#define LAS __attribute__((address_space(3)))
typedef unsigned short bf16;
typedef unsigned v4u __attribute__((ext_vector_type(4)));
typedef unsigned v2u __attribute__((ext_vector_type(2)));
typedef float f32x4 __attribute__((ext_vector_type(4)));

#ifndef MK_MULTI
#define MK_MULTI 0
#endif

constexpr int BATCH = 8, SEQ = 2048, DM = 1024, M = BATCH * SEQ;
constexpr int NH = 8, HD = 64, AW = 512, SWD = 512, NG = 32, HC = 16, PS = 64, INW = 1280, FF = 2816;
constexpr float EPS = 1e-6f;
constexpr size_t MiB = 1u << 20;
constexpr size_t WS_WT1 = 2 * MiB, WS_WD1 = 14 * MiB, WS_WT2 = 20 * MiB, WS_WD2 = 32 * MiB, WS_WIN = 38 * MiB, WS_WOUT = 41 * MiB, WS_WGLU = 43 * MiB;
constexpr size_t WS_XA = 64 * MiB;
constexpr size_t WS_H = 96 * MiB;
constexpr size_t WS_QKVU = 184 * MiB;
constexpr size_t WS_ATT = 224 * MiB;
constexpr size_t WS_YG = 240 * MiB;
constexpr size_t WS_S = 96 * MiB;
constexpr size_t WS_Y = 112 * MiB;
constexpr size_t WS_Y2 = 144 * MiB;
constexpr size_t WS_MIX = 144 * MiB;
constexpr size_t WS_END = 256 * MiB;
constexpr int LDS_BYTES = 147456;

__device__ __forceinline__ unsigned f2bf(float f) { unsigned u = __builtin_bit_cast(unsigned, f); return (u + 0x7fffu + ((u >> 16) & 1u)) >> 16; }
__device__ __forceinline__ unsigned pk2(float lo, float hi) { return f2bf(lo) | (f2bf(hi) << 16); }
__device__ __forceinline__ float bflo(unsigned w) { return __builtin_bit_cast(float, w << 16); }
__device__ __forceinline__ float bfhi(unsigned w) { return __builtin_bit_cast(float, w & 0xffff0000u); }
#define LDS_WAIT() asm volatile("s_waitcnt lgkmcnt(0)" ::: "memory")
__device__ __forceinline__ float wave_sum(float v) {
#pragma unroll
    for (int o = 1; o < 64; o <<= 1) v += __shfl_xor(v, o);
    return v;
}
__device__ __forceinline__ float sigmoidf_(float x) { return __builtin_amdgcn_rcpf(1.f + __expf(-x)); }

namespace pg8 {
struct EpiSwiglu {
    static constexpr bool PERM = true, AFTER_DRAIN = false;
    bf16_t* H; int ldh;
    __device__ __forceinline__ void operator()(const f32x4 (&acc)[2][2][4][2], const Unit& u, int wr, int wc, int fr, int fq) const {
        const int row0 = u.pm * BM + wr * 64 + fr, col0 = u.pn * HALF + wc * 32 + 8 * fq;
#pragma unroll
        for (int ai = 0; ai < 2; ++ai)
#pragma unroll
            for (int m = 0; m < 4; ++m) {
                bf16_t* rowp = H + (size_t)(row0 + ai * HALF + m * 16) * ldh + col0;
                float hv[8];
#pragma unroll
                for (int n = 0; n < 2; ++n)
#pragma unroll
                    for (int i = 0; i < 4; ++i) { const float g = acc[ai][0][m][n][i], up = acc[ai][1][m][n][i]; hv[n * 4 + i] = g * __builtin_amdgcn_rcpf(1.f + __expf(-g)) * up; }
                u32x4 w; w.x = cvt_pk_bf16(hv[0], hv[1]); w.y = cvt_pk_bf16(hv[2], hv[3]); w.z = cvt_pk_bf16(hv[4], hv[5]); w.w = cvt_pk_bf16(hv[6], hv[7]);
                *(u32x4*)rowp = w;
            }
    }
};
struct EpiResid {
    static constexpr bool PERM = false, AFTER_DRAIN = false;
    const float* base; float* out; float alpha;
    __device__ __forceinline__ void operator()(const f32x4 (&acc)[2][2][4][2], const Unit& u, int wr, int wc, int fr, int fq) const {
        const int col0 = u.pn * BM + wc * 32 + 4 * fq;
#pragma unroll
        for (int ai = 0; ai < 2; ++ai)
#pragma unroll
            for (int m = 0; m < 4; ++m) {
                const size_t off = (size_t)(u.pm * BM + ai * HALF + wr * 64 + m * 16 + fr) * 1024 + col0;
#pragma unroll
                for (int bj = 0; bj < 2; ++bj)
#pragma unroll
                    for (int n = 0; n < 2; ++n) { const f32x4 b = *(const f32x4*)(base + off + bj * HALF + n * 16); *(f32x4*)(out + off + bj * HALF + n * 16) = b + acc[ai][bj][m][n] * alpha; }
            }
    }
};
struct EpiGlu {
    static constexpr bool PERM = true, AFTER_DRAIN = false;
    const bf16_t* Y; bf16_t* S; const float* bias;
    __device__ __forceinline__ void operator()(const f32x4 (&acc)[2][2][4][2], const Unit& u, int wr, int wc, int fr, int fq) const {
        const int row0 = u.pm * BM + wr * 64 + fr, col0 = u.pn * BM + wc * 32 + 8 * fq;
#pragma unroll
        for (int bj = 0; bj < 2; ++bj) {
            const f32x4 b0 = *(const f32x4*)(bias + col0 + bj * HALF), b1 = *(const f32x4*)(bias + col0 + bj * HALF + 4);
#pragma unroll
            for (int ai = 0; ai < 2; ++ai)
#pragma unroll
                for (int m = 0; m < 4; ++m) {
                    const size_t off = (size_t)(row0 + ai * HALF + m * 16) * 512 + col0 + bj * HALF;
                    const u32x4 yv = *(const u32x4*)(Y + off);
                    const f32x4 v0 = acc[ai][bj][m][0] + b0, v1 = acc[ai][bj][m][1] + b1;
                    float o[8];
                    o[0] = bflo(yv.x) * sigmoidf_(v0[0]); o[1] = bfhi(yv.x) * sigmoidf_(v0[1]); o[2] = bflo(yv.y) * sigmoidf_(v0[2]); o[3] = bfhi(yv.y) * sigmoidf_(v0[3]);
                    o[4] = bflo(yv.z) * sigmoidf_(v1[0]); o[5] = bfhi(yv.z) * sigmoidf_(v1[1]); o[6] = bflo(yv.w) * sigmoidf_(v1[2]); o[7] = bfhi(yv.w) * sigmoidf_(v1[3]);
                    u32x4 w; w.x = cvt_pk_bf16(o[0], o[1]); w.y = cvt_pk_bf16(o[2], o[3]); w.z = cvt_pk_bf16(o[4], o[5]); w.w = cvt_pk_bf16(o[6], o[7]);
                    *(u32x4*)(S + off) = w;
                }
        }
    }
};
}

template <int MODE>
__device__ __forceinline__ void p0_transpose_item(const float* W, int K, int N, bf16* WT, LAS float* scr, int item, int lane) {
    const int nblk = N / 32, kb = item / nblk, nb = item % nblk, k0 = 64 * kb, n0 = 32 * nb;
#pragma unroll 8
    for (int i = 0; i < 32; ++i) { const int kk = 2 * i + (lane >> 5); scr[kk * 33 + (lane & 31)] = W[(size_t)(k0 + kk) * N + n0 + (lane & 31)]; }
    LDS_WAIT(); asm volatile("" ::: "memory");
    const int c = lane & 7;
    const int r0 = MODE == 0 ? n0 : ((n0 >> 7) * 256 + (n0 & 127) + (MODE == 2 ? 128 : 0));
#pragma unroll
    for (int j = 0; j < 4; ++j) { const int n = (lane >> 3) + 8 * j; const LAS float* s = scr + (8 * c) * 33 + n;
        v4u o; o.x = pk2(s[0 * 33], s[1 * 33]); o.y = pk2(s[2 * 33], s[3 * 33]); o.z = pk2(s[4 * 33], s[5 * 33]); o.w = pk2(s[6 * 33], s[7 * 33]);
        *(v4u*)(WT + (size_t)(r0 + n) * K + k0 + 8 * c) = o; }
    LDS_WAIT(); asm volatile("" ::: "memory");
}

__device__ __forceinline__ void rms_row_to_bf16(const float* xrow, const float* gain, bf16* orow, int lane) {
    const f32x4* xr = (const f32x4*)xrow + lane; const f32x4* gr = (const f32x4*)gain + lane;
    f32x4 v[4]; float s = 0.f;
#pragma unroll
    for (int j = 0; j < 4; ++j) { v[j] = xr[64 * j]; s += (v[j].x * v[j].x + v[j].y * v[j].y) + (v[j].z * v[j].z + v[j].w * v[j].w); }
    const float rstd = 1.f / sqrtf(wave_sum(s) * (1.f / DM) + EPS);
    unsigned long long* o8 = (unsigned long long*)orow + lane;
#pragma unroll
    for (int j = 0; j < 4; ++j) { const f32x4 g = gr[64 * j];
        o8[64 * j] = (unsigned long long)pk2(v[j].x * rstd * g.x, v[j].y * rstd * g.y) | ((unsigned long long)pk2(v[j].z * rstd * g.z, v[j].w * rstd * g.w) << 32); }
}
__device__ __forceinline__ void rms_row_f32(float* xrow, const float* gain, int lane) {
    f32x4* xr = (f32x4*)xrow + lane; const f32x4* gr = (const f32x4*)gain + lane;
    f32x4 v[4]; float s = 0.f;
#pragma unroll
    for (int j = 0; j < 4; ++j) { v[j] = xr[64 * j]; s += (v[j].x * v[j].x + v[j].y * v[j].y) + (v[j].z * v[j].z + v[j].w * v[j].w); }
    const float rstd = 1.f / sqrtf(wave_sum(s) * (1.f / DM) + EPS);
#pragma unroll
    for (int j = 0; j < 4; ++j) { const f32x4 g = gr[64 * j]; xr[64 * j] = v[j] * rstd * g; }
}
__device__ __forceinline__ void mix_row(const bf16* arow, const bf16* srow, const float* ga, const float* gs, bf16* orow, int lane) {
    const v4u a = *((const v4u*)arow + lane), s = *((const v4u*)srow + lane);
    float av[8] = {bflo(a.x), bfhi(a.x), bflo(a.y), bfhi(a.y), bflo(a.z), bfhi(a.z), bflo(a.w), bfhi(a.w)};
    float sv[8] = {bflo(s.x), bfhi(s.x), bflo(s.y), bfhi(s.y), bflo(s.z), bfhi(s.z), bflo(s.w), bfhi(s.w)};
    float sa = 0.f, ss = 0.f;
#pragma unroll
    for (int i = 0; i < 8; ++i) { sa += av[i] * av[i]; ss += sv[i] * sv[i]; }
    const float ra = 1.f / sqrtf(wave_sum(sa) * (1.f / 512.f) + EPS), rs = 1.f / sqrtf(wave_sum(ss) * (1.f / 512.f) + EPS);
    const f32x4 ga0 = *((const f32x4*)ga + 2 * lane), ga1 = *((const f32x4*)ga + 2 * lane + 1), gs0 = *((const f32x4*)gs + 2 * lane), gs1 = *((const f32x4*)gs + 2 * lane + 1);
    v4u oa, os;
    oa.x = pk2(av[0] * ra * ga0.x, av[1] * ra * ga0.y); oa.y = pk2(av[2] * ra * ga0.z, av[3] * ra * ga0.w); oa.z = pk2(av[4] * ra * ga1.x, av[5] * ra * ga1.y); oa.w = pk2(av[6] * ra * ga1.z, av[7] * ra * ga1.w);
    os.x = pk2(sv[0] * rs * gs0.x, sv[1] * rs * gs0.y); os.y = pk2(sv[2] * rs * gs0.z, sv[3] * rs * gs0.w); os.z = pk2(sv[4] * rs * gs1.x, sv[5] * rs * gs1.y); os.w = pk2(sv[6] * rs * gs1.z, sv[7] * rs * gs1.w);
    *((v4u*)orow + lane) = oa; *((v4u*)(orow + 512) + lane) = os;
}

__device__ __forceinline__ void attn_naive(LAS unsigned char* lds, const bf16* QKVU, bf16* ATT, const float* sinks, int G, int bid) {
    const int tid = threadIdx.x, lane = tid & 63, w = tid >> 6;
    LAS bf16* Ks = (LAS bf16*)lds; LAS bf16* Vs = Ks + 384 * 64;
    for (int unit = bid; unit < 256; unit += G) {
        const int kh = unit & 1, qb = (unit >> 1) & 15, b = unit >> 5, kp0 = qb * 128 - 128;
        __syncthreads();
        for (int c = tid; c < 3072; c += 512) { const int r = c >> 3, ch = c & 7, kp = kp0 + r; v4u kv = (v4u){0u, 0u, 0u, 0u}, vv = kv;
            if (kp >= 0 && kp < SEQ) { const bf16* src = QKVU + (size_t)(b * SEQ + kp) * INW; kv = *(const v4u*)(src + 512 + kh * 64 + ch * 8); vv = *(const v4u*)(src + 640 + kh * 64 + ch * 8); }
            *(LAS v4u*)(Ks + r * 64 + ch * 8) = kv; *(LAS v4u*)(Vs + r * 64 + ch * 8) = vv; }
        __syncthreads();
        const int g = w >> 1, qa = (w & 1) * 64, qi = qa + lane, t = qb * 128 + qi, h = kh * 4 + g;
        const float slope = exp2f(-(float)(h + 1));
        float q[64], acc[64];
        { const bf16* qp = QKVU + (size_t)(b * SEQ + t) * INW + h * 64;
#pragma unroll
          for (int c = 0; c < 8; ++c) { const v4u qq = *(const v4u*)(qp + c * 8);
              q[c * 8 + 0] = bflo(qq.x) * 0.125f; q[c * 8 + 1] = bfhi(qq.x) * 0.125f; q[c * 8 + 2] = bflo(qq.y) * 0.125f; q[c * 8 + 3] = bfhi(qq.y) * 0.125f;
              q[c * 8 + 4] = bflo(qq.z) * 0.125f; q[c * 8 + 5] = bfhi(qq.z) * 0.125f; q[c * 8 + 6] = bflo(qq.w) * 0.125f; q[c * 8 + 7] = bfhi(qq.w) * 0.125f; } }
#pragma unroll
        for (int d = 0; d < 64; ++d) acc[d] = 0.f;
        float mx = sinks[h], l = 1.f;
        for (int jj = qa; jj < qa + 320; ++jj) {
            float s = 0.f;
#pragma unroll
            for (int c = 0; c < 8; ++c) { const v4u kk = *(const LAS v4u*)(Ks + jj * 64 + c * 8);
                s += q[c * 8 + 0] * bflo(kk.x) + q[c * 8 + 1] * bfhi(kk.x) + q[c * 8 + 2] * bflo(kk.y) + q[c * 8 + 3] * bfhi(kk.y)
                   + q[c * 8 + 4] * bflo(kk.z) + q[c * 8 + 5] * bfhi(kk.z) + q[c * 8 + 6] * bflo(kk.w) + q[c * 8 + 7] * bfhi(kk.w); }
            const int rel = jj - 128 - qi, kp = kp0 + jj;
            const bool valid = (rel >= -128) && (rel <= 128) && (kp >= 0) && (kp < SEQ);
            s = valid ? s - slope * fabsf((float)rel) : -1e30f;
            const float mn = fmaxf(mx, s), corr = __expf(mx - mn), p = __expf(s - mn);
            l = l * corr + p; mx = mn;
#pragma unroll
            for (int c = 0; c < 8; ++c) { const v4u vv = *(const LAS v4u*)(Vs + jj * 64 + c * 8);
                acc[c * 8 + 0] = acc[c * 8 + 0] * corr + p * bflo(vv.x); acc[c * 8 + 1] = acc[c * 8 + 1] * corr + p * bfhi(vv.x);
                acc[c * 8 + 2] = acc[c * 8 + 2] * corr + p * bflo(vv.y); acc[c * 8 + 3] = acc[c * 8 + 3] * corr + p * bfhi(vv.y);
                acc[c * 8 + 4] = acc[c * 8 + 4] * corr + p * bflo(vv.z); acc[c * 8 + 5] = acc[c * 8 + 5] * corr + p * bfhi(vv.z);
                acc[c * 8 + 6] = acc[c * 8 + 6] * corr + p * bflo(vv.w); acc[c * 8 + 7] = acc[c * 8 + 7] * corr + p * bfhi(vv.w); }
        }
        const float inv = 1.f / l;
        bf16* op = ATT + (size_t)(b * SEQ + t) * AW + h * 64;
#pragma unroll
        for (int c = 0; c < 8; ++c) { v4u o; o.x = pk2(acc[c * 8 + 0] * inv, acc[c * 8 + 1] * inv); o.y = pk2(acc[c * 8 + 2] * inv, acc[c * 8 + 3] * inv);
            o.z = pk2(acc[c * 8 + 4] * inv, acc[c * 8 + 5] * inv); o.w = pk2(acc[c * 8 + 6] * inv, acc[c * 8 + 7] * inv); *(v4u*)(op + c * 8) = o; }
    }
}

struct SsmP { const float *lam_re, *lam_im, *log_dt, *b_re, *b_im, *c_re, *c_im, *dskip; };
__device__ __forceinline__ float gelu_tanh(float x) { const float z = 1.5957691216f * (x + 0.044715f * x * x * x); return x * __builtin_amdgcn_rcpf(1.f + __expf(-z)); }
__device__ __forceinline__ void ssm_naive(LAS unsigned char* lds, const bf16* QKVU, float* Y, float* Y2, bf16* YG, const SsmP P, int G, int bid) {
    const int tid = threadIdx.x, lane = tid & 63, w = tid >> 6;
    for (int unit = bid; unit < 256; unit += G) {
        const int b = unit >> 5, g = unit & 31;
        __syncthreads();
        if (w < 2) {
            const int d = w, dg = d * NG + g;
            LAS float* XR = (LAS float*)(lds + w * 49152); LAS float* XI = XR + 64 * 65; LAS float* U = XI + 64 * 65; LAS float* Cre = U + 64 * 16; LAS float* Cim = Cre + 16 * 64;
            const float lr = fminf(P.lam_re[dg * PS + lane], -1e-4f), li = P.lam_im[dg * PS + lane], dt = expf(P.log_dt[dg]);
            const float mag = expf(lr * dt), a_re = mag * cosf(li * dt), a_im = mag * sinf(li * dt), den = lr * lr + li * li;
            const float cr = ((a_re - 1.f) * lr + a_im * li) / den, ci = (a_im * lr - (a_re - 1.f) * li) / den;
            float bbr[16], bbi[16];
#pragma unroll
            for (int h = 0; h < 16; ++h) { const float br = P.b_re[(size_t)(dg * PS + lane) * HC + h], bi = P.b_im[(size_t)(dg * PS + lane) * HC + h]; bbr[h] = cr * br - ci * bi; bbi[h] = cr * bi + ci * br; }
#pragma unroll
            for (int i = 0; i < 16; ++i) { Cre[i * 64 + lane] = P.c_re[(size_t)dg * HC * PS + i * 64 + lane]; Cim[i * 64 + lane] = P.c_im[(size_t)dg * HC * PS + i * 64 + lane]; }
            float dsk[16];
#pragma unroll
            for (int h = 0; h < 16; ++h) dsk[h] = P.dskip[g * HC + h];
            float xr = 0.f, xi = 0.f;
            for (int cc = 0; cc < 32; ++cc) {
                const int c = d ? 31 - cc : cc, t0 = c * 64;
                { const bf16* src = QKVU + (size_t)(b * SEQ + t0 + lane) * INW + 768 + g * 16; const v4u u0 = *(const v4u*)src, u1 = *(const v4u*)(src + 8);
                  LDS_WAIT(); asm volatile("" ::: "memory");
                  *(LAS f32x4*)(U + lane * 16 + 0) = (f32x4){bflo(u0.x), bfhi(u0.x), bflo(u0.y), bfhi(u0.y)}; *(LAS f32x4*)(U + lane * 16 + 4) = (f32x4){bflo(u0.z), bfhi(u0.z), bflo(u0.w), bfhi(u0.w)};
                  *(LAS f32x4*)(U + lane * 16 + 8) = (f32x4){bflo(u1.x), bfhi(u1.x), bflo(u1.y), bfhi(u1.y)}; *(LAS f32x4*)(U + lane * 16 + 12) = (f32x4){bflo(u1.z), bfhi(u1.z), bflo(u1.w), bfhi(u1.w)}; }
                LDS_WAIT(); asm volatile("" ::: "memory");
                for (int s = 0; s < 64; ++s) {
                    const int tt = d ? 63 - s : s;
                    const f32x4 ua = *(const LAS f32x4*)(U + tt * 16), ub = *(const LAS f32x4*)(U + tt * 16 + 4), uc = *(const LAS f32x4*)(U + tt * 16 + 8), ud = *(const LAS f32x4*)(U + tt * 16 + 12);
                    const float uu[16] = {ua.x, ua.y, ua.z, ua.w, ub.x, ub.y, ub.z, ub.w, uc.x, uc.y, uc.z, uc.w, ud.x, ud.y, ud.z, ud.w};
                    float bur = 0.f, bui = 0.f;
#pragma unroll
                    for (int h = 0; h < 16; ++h) { bur += bbr[h] * uu[h]; bui += bbi[h] * uu[h]; }
                    const float nxr = a_re * xr - a_im * xi + bur, nxi = a_re * xi + a_im * xr + bui; xr = nxr; xi = nxi;
                    XR[tt * 65 + lane] = xr; XI[tt * 65 + lane] = xi;
                }
                LDS_WAIT(); asm volatile("" ::: "memory");
                float acc[16];
#pragma unroll
                for (int h = 0; h < 16; ++h) acc[h] = 0.f;
                for (int p = 0; p < 64; ++p) { const float r = XR[lane * 65 + p], im = XI[lane * 65 + p];
#pragma unroll
                    for (int h = 0; h < 16; ++h) acc[h] += Cre[h * 64 + p] * r - Cim[h * 64 + p] * im; }
                if (d == 0) {
#pragma unroll
                    for (int h = 0; h < 16; ++h) acc[h] += dsk[h] * U[lane * 16 + h];
                }
                float* dst = (d ? Y2 : Y) + (size_t)(b * SEQ + t0 + lane) * SWD + g * 16;
#pragma unroll
                for (int h4 = 0; h4 < 4; ++h4) *(f32x4*)(dst + h4 * 4) = (f32x4){acc[h4 * 4], acc[h4 * 4 + 1], acc[h4 * 4 + 2], acc[h4 * 4 + 3]};
            }
        }
        __threadfence_block();
        __syncthreads();
        for (int i = tid; i < 8192; i += 512) { const int t = i >> 2, hq = (i & 3) * 4; const size_t off = (size_t)(b * SEQ + t) * SWD + g * 16 + hq;
            const f32x4 v = *(const f32x4*)(Y + off) + *(const f32x4*)(Y2 + off);
            v2u o; o.x = pk2(gelu_tanh(v.x), gelu_tanh(v.y)); o.y = pk2(gelu_tanh(v.z), gelu_tanh(v.w)); *(v2u*)(YG + off) = o; }
    }
}

struct Args { const float* in[26]; float* out; unsigned char* ws; int ph_lo, ph_hi; };
constexpr int N_PHASES = 14;
__global__ void __launch_bounds__(512, 2) mk_fwd(Args args) {
    extern __shared__ __attribute__((aligned(16))) unsigned char lds_raw[];
    LAS unsigned char* lds = (LAS unsigned char*)lds_raw;
    cg::grid_group grid = cg::this_grid();
    const int tid = threadIdx.x, lane = tid & 63, wave = __builtin_amdgcn_readfirstlane(tid >> 6);
    const int G = gridDim.x, bid = blockIdx.x;
    const int gw = bid * 8 + wave, NGW = G * 8;
    unsigned char* ws = args.ws;
    const float* x = args.in[0];
    float* X = args.out;
    bf16* WT1 = (bf16*)(ws + WS_WT1); bf16* WD1 = (bf16*)(ws + WS_WD1); bf16* WT2 = (bf16*)(ws + WS_WT2); bf16* WD2 = (bf16*)(ws + WS_WD2);
    bf16* WIN = (bf16*)(ws + WS_WIN); bf16* WOUT = (bf16*)(ws + WS_WOUT); bf16* WGLU = (bf16*)(ws + WS_WGLU);
    bf16* XA = (bf16*)(ws + WS_XA); bf16* HB = (bf16*)(ws + WS_H); bf16* QKVU = (bf16*)(ws + WS_QKVU); bf16* ATT = (bf16*)(ws + WS_ATT); bf16* YG = (bf16*)(ws + WS_YG);
    bf16* SB = (bf16*)(ws + WS_S); float* Y = (float*)(ws + WS_Y); float* Y2 = (float*)(ws + WS_Y2); bf16* MIX = (bf16*)(ws + WS_MIX);
    const int lo = args.ph_lo, hi = args.ph_hi;
#define IN(k) (lo <= (k) && (k) < hi)
#define SEAM(k) do { if (IN(k) && IN((k) + 1)) grid.sync(); } while (0)

    if (IN(0)) {
        LAS float* scr = (LAS float*)(lds + wave * 16384);
        constexpr int I_UP = (DM / 64) * (FF / 32), I_DN = (FF / 64) * (DM / 32), I_IN = (DM / 64) * (INW / 32), I_GLU = (SWD / 64) * (SWD / 32), I_OUT = (DM / 64) * (DM / 32);
        constexpr int NITEMS = 6 * I_UP + I_IN + I_GLU + I_OUT; static_assert(I_UP == I_DN, "");
        for (int it = gw; it < NITEMS; it += NGW) {
            int r = it;
            if (r < I_UP) { p0_transpose_item<1>(args.in[2], DM, FF, WT1, scr, r, lane); continue; } r -= I_UP;
            if (r < I_UP) { p0_transpose_item<2>(args.in[3], DM, FF, WT1, scr, r, lane); continue; } r -= I_UP;
            if (r < I_DN) { p0_transpose_item<0>(args.in[4], FF, DM, WD1, scr, r, lane); continue; } r -= I_DN;
            if (r < I_UP) { p0_transpose_item<1>(args.in[22], DM, FF, WT2, scr, r, lane); continue; } r -= I_UP;
            if (r < I_UP) { p0_transpose_item<2>(args.in[23], DM, FF, WT2, scr, r, lane); continue; } r -= I_UP;
            if (r < I_DN) { p0_transpose_item<0>(args.in[24], FF, DM, WD2, scr, r, lane); continue; } r -= I_DN;
            if (r < I_IN) { p0_transpose_item<0>(args.in[6], DM, INW, WIN, scr, r, lane); continue; } r -= I_IN;
            if (r < I_GLU) { p0_transpose_item<0>(args.in[16], SWD, SWD, WGLU, scr, r, lane); continue; } r -= I_GLU;
            p0_transpose_item<0>(args.in[20], DM, DM, WOUT, scr, r, lane);
        }
        for (int m = gw; m < M; m += NGW) rms_row_to_bf16(x + (size_t)m * DM, args.in[1], XA + (size_t)m * DM, lane);
    }
    SEAM(0);
    if (IN(1)) { pg8::Gemm g{XA, WT1, M, 2 * FF, DM}; pg8::StaticOrder S; S.init(M, 2 * FF, G, bid); pg8::EpiSwiglu E{HB, FF};
        pg8::gemm_phase<pg8::EpiSwiglu, pg8::StaticOrder, true, true>(lds, g, S, E); }
    SEAM(1);
    if (IN(2)) { pg8::Gemm g{HB, WD1, M, DM, FF}; pg8::StaticOrder S; S.init(M, DM, G, bid); pg8::EpiResid E{x, X, 0.5f};
        pg8::gemm_phase<pg8::EpiResid, pg8::StaticOrder, true, true>(lds, g, S, E); }
    SEAM(2);
    if (IN(3)) { for (int m = gw; m < M; m += NGW) rms_row_to_bf16(X + (size_t)m * DM, args.in[5], XA + (size_t)m * DM, lane); }
    SEAM(3);
    if (IN(4)) { pg8::Gemm g{XA, WIN, M, INW, DM}; pg8::StaticOrder S; S.init(M, INW, G, bid); pg8::EpiBf16<0> E{QKVU, INW, nullptr, 0, 0, 1.f};
        pg8::gemm_phase<pg8::EpiBf16<0>, pg8::StaticOrder, true, true>(lds, g, S, E); }
    SEAM(4);
    if (IN(5)) attn_naive(lds, QKVU, ATT, args.in[7], G, bid);
    SEAM(5);
    if (IN(6)) { const SsmP P{args.in[8], args.in[9], args.in[10], args.in[11], args.in[12], args.in[13], args.in[14], args.in[15]}; ssm_naive(lds, QKVU, Y, Y2, YG, P, G, bid); }
    SEAM(6);
    if (IN(7)) { pg8::Gemm g{YG, WGLU, M, SWD, SWD}; pg8::StaticOrder S; S.init(M, SWD, G, bid); pg8::EpiGlu E{YG, SB, args.in[17]};
        pg8::gemm_phase<pg8::EpiGlu, pg8::StaticOrder, true, true>(lds, g, S, E); }
    SEAM(7);
    if (IN(8)) { for (int m = gw; m < M; m += NGW) mix_row(ATT + (size_t)m * AW, SB + (size_t)m * SWD, args.in[18], args.in[19], MIX + (size_t)m * DM, lane); }
    SEAM(8);
    if (IN(9)) { pg8::Gemm g{MIX, WOUT, M, DM, DM}; pg8::StaticOrder S; S.init(M, DM, G, bid); pg8::EpiResid E{X, X, 1.0f};
        pg8::gemm_phase<pg8::EpiResid, pg8::StaticOrder, true, true>(lds, g, S, E); }
    SEAM(9);
    if (IN(10)) { for (int m = gw; m < M; m += NGW) rms_row_to_bf16(X + (size_t)m * DM, args.in[21], XA + (size_t)m * DM, lane); }
    SEAM(10);
    if (IN(11)) { pg8::Gemm g{XA, WT2, M, 2 * FF, DM}; pg8::StaticOrder S; S.init(M, 2 * FF, G, bid); pg8::EpiSwiglu E{HB, FF};
        pg8::gemm_phase<pg8::EpiSwiglu, pg8::StaticOrder, true, true>(lds, g, S, E); }
    SEAM(11);
    if (IN(12)) { pg8::Gemm g{HB, WD2, M, DM, FF}; pg8::StaticOrder S; S.init(M, DM, G, bid); pg8::EpiResid E{X, X, 0.5f};
        pg8::gemm_phase<pg8::EpiResid, pg8::StaticOrder, true, true>(lds, g, S, E); }
    SEAM(12);
    if (IN(13)) { for (int m = gw; m < M; m += NGW) rms_row_f32(X + (size_t)m * DM, args.in[25], lane); }
#undef IN
#undef SEAM
}

extern "C" void kernel_launch(void* const* d_in, const int* in_sizes, int n_in, void* d_out, int out_size, void* d_ws, size_t ws_size, hipStream_t stream) {
    static int grid = 0;
    if (grid == 0) {
        if (n_in != 26 || in_sizes[0] != M * DM || out_size != M * DM || ws_size < WS_END) { fprintf(stderr, "kernel_launch: unexpected shapes n_in %d in0 %d out %d ws %zu\n", n_in, n_in > 0 ? in_sizes[0] : -1, out_size, ws_size); grid = -1; return; }
        int dev = 0, cus = 0, per_cu = 0;
        (void)hipGetDevice(&dev); (void)hipDeviceGetAttribute(&cus, hipDeviceAttributeMultiprocessorCount, dev);
        if (hipFuncSetAttribute((const void*)mk_fwd, hipFuncAttributeMaxDynamicSharedMemorySize, LDS_BYTES) != hipSuccess) { fprintf(stderr, "kernel_launch: hipFuncSetAttribute failed\n"); grid = -1; return; }
        if (hipOccupancyMaxActiveBlocksPerMultiprocessor(&per_cu, (const void*)mk_fwd, 512, LDS_BYTES) != hipSuccess || per_cu < 1) { fprintf(stderr, "kernel_launch: occupancy query says %d\n", per_cu); per_cu = 1; }
        (void)hipGetLastError();
        grid = cus * per_cu;
        fprintf(stderr, "kernel_launch: grid %d (cus %d per_cu %d)\n", grid, cus, per_cu);
    }
    if (grid < 0) return;
    Args a{};
    for (int i = 0; i < 26; ++i) a.in[i] = (const float*)d_in[i];
    a.out = (float*)d_out; a.ws = (unsigned char*)d_ws;
#if MK_MULTI
    for (int ph = 0; ph < N_PHASES; ++ph) { a.ph_lo = ph; a.ph_hi = ph + 1; hipLaunchKernelGGL(mk_fwd, dim3(grid), dim3(512), LDS_BYTES, stream, a); }
#else
    a.ph_lo = 0; a.ph_hi = N_PHASES;
    void* kargs[] = {&a};
    hipError_t e = hipLaunchCooperativeKernel((const void*)mk_fwd, dim3(grid), dim3(512), kargs, LDS_BYTES, stream);
    if (e != hipSuccess) fprintf(stderr, "cooperative launch failed: %s (grid %d)\n", hipGetErrorString(e), grid);
#endif
}
```

```cpp
#include <hip/hip_runtime.h>
#include <hip/hip_cooperative_groups.h>
#include <cstdio>
#include <cstdint>
namespace cg = cooperative_groups;
#define MK_MULTI 0
namespace pg8 {
#define PG8_LAS __attribute__((address_space(3)))
typedef unsigned short bf16_t;
typedef short bf16x8 __attribute__((ext_vector_type(8)));
typedef float f32x4 __attribute__((ext_vector_type(4)));
typedef unsigned u32x4 __attribute__((ext_vector_type(4)));
constexpr int BM = 256, BK = 64, HALF = 128, HTB = HALF * BK * 2  , STAGE_BYTES = 8 * HTB, NXCD = 8, WGM = 8;

__host__ __device__ __forceinline__ int lds_byte(int r, int c) { const int st = (r >> 4) * 2 + (c >> 5), rr = r & 15, cc = c & 31, ob = rr * 64 + cc * 2; return st * 1024 + (ob ^ (((ob >> 9) & 1) << 5)); }
__host__ __device__ __forceinline__ void stage_rc(int b, int& R, int& C) { const int st = b / 1024, sb = b % 1024, swz = sb ^ (((sb >> 9) & 1) << 5); R = (st >> 1) * 16 + swz / 64; C = (st & 1) * 32 + (swz % 64) / 2; }
__host__ __device__ __forceinline__ int perm32(int rho) { const int n = rho >> 4, i = rho & 15; return 8 * (i >> 2) + 4 * n + (i & 3); }

struct Unit { int pm, pn; };
struct Gemm { const bf16_t* A; const bf16_t* Bt; int M, N, K, lda, ldb; };

struct StaticOrder {
    int nM, nN, nwg, G, c;
    __host__ __device__ void init(int M, int N, int G_, int c_) { nM = M / BM; nN = N / BM; nwg = nM * nN; G = G_; c = c_; }
    __host__ __device__ bool next(int i, Unit& u) const {
        const long L = (long)i * G + c; if (L >= nwg) return false;
        int wgid = (int)L; { const int q = nwg / NXCD, r = nwg % NXCD, xcd = wgid % NXCD, off = wgid / NXCD; wgid = (xcd < r ? xcd * (q + 1) : r * (q + 1) + (xcd - r) * q) + off; }
        const int nig = WGM * nN, gid = wgid / nig, fm = gid * WGM, gsz = (nM - fm) < WGM ? (nM - fm) : WGM;
        u.pm = fm + ((wgid % nig) % gsz); u.pn = (wgid % nig) / gsz; return true;
    }
    __device__ __forceinline__ void a_ready(const Unit&) const {}
    __device__ __forceinline__ void done(const Unit&) const {}
};

__device__ __forceinline__ unsigned cvt_pk_bf16(float lo, float hi) { unsigned r; asm volatile("v_cvt_pk_bf16_f32 %0, %1, %2" : "=v"(r) : "v"(lo), "v"(hi)); return r; }
typedef float f32x2 __attribute__((ext_vector_type(2)));
__device__ __forceinline__ f32x2 gelu_pk(f32x2 v) {
    const f32x2 av = __builtin_elementwise_abs(v), d = av * 0.2316418882f + 1.0f;
    f32x2 t; t.x = __builtin_amdgcn_rcpf(d.x); t.y = __builtin_amdgcn_rcpf(d.y);
    f32x2 q = t * 0.5307027145f + (-0.7265760135f); q = q * t + 0.7107068705f; q = q * t + (-0.142248368f); q = q * t + 0.127414796f; q = q * t;
    const f32x2 s = (v * v) * (-0.72134752044f);
    f32x2 e; e.x = __builtin_amdgcn_exp2f(s.x); e.y = __builtin_amdgcn_exp2f(s.y);
    const f32x2 m = v * (q * e), r = v - m;
    f32x2 o; o.x = v.x < 0.f ? m.x : r.x; o.y = v.y < 0.f ? m.y : r.y; return o;
}

template <int ACT  > struct EpiBf16 {
    static constexpr bool PERM = true, AFTER_DRAIN = false; static_assert(ACT == 0 || ACT == 1, "EpiBf16: ACT is 0 (none) or 1 (gelu_pk)");
    bf16_t* O; int ldc; const float* bias; int split_cols; size_t split_stride; float scale0;
    __device__ __forceinline__ void operator()(const f32x4 (&acc)[2][2][4][2], const Unit& u, int wr, int wc, int fr, int fq) const {
        const int row0 = u.pm * BM + wr * 64 + fr; int colt = u.pn * BM; bf16_t* base = O;
        float sc = 1.f; if (split_cols) { const int t = colt / split_cols; base += (size_t)t * split_stride; colt -= t * split_cols; if (t == 0) sc = scale0; }
        const int col0 = colt + wc * 32 + 8 * fq, bcol0 = u.pn * BM + wc * 32 + 8 * fq;
        f32x4 bv[2][2];
#pragma unroll
        for (int bj = 0; bj < 2; ++bj)
#pragma unroll
            for (int n = 0; n < 2; ++n) bv[bj][n] = bias ? *(const f32x4*)(bias + bcol0 + bj * HALF + 4 * n) : (f32x4){0.f, 0.f, 0.f, 0.f};
#pragma unroll
        for (int ai = 0; ai < 2; ++ai)
#pragma unroll
            for (int m = 0; m < 4; ++m) { bf16_t* rowp = base + (size_t)(row0 + ai * HALF + m * 16) * ldc + col0;
#pragma unroll
                for (int bj = 0; bj < 2; ++bj) { f32x4 v0 = acc[ai][bj][m][0] + bv[bj][0], v1 = acc[ai][bj][m][1] + bv[bj][1];
                    if (ACT == 1) { f32x2 a = gelu_pk((f32x2){v0[0], v0[1]}), b = gelu_pk((f32x2){v0[2], v0[3]}), c = gelu_pk((f32x2){v1[0], v1[1]}), d = gelu_pk((f32x2){v1[2], v1[3]});
                        v0 = (f32x4){a.x, a.y, b.x, b.y}; v1 = (f32x4){c.x, c.y, d.x, d.y}; }
                    v0 = v0 * sc; v1 = v1 * sc; u32x4 w; w.x = cvt_pk_bf16(v0[0], v0[1]); w.y = cvt_pk_bf16(v0[2], v0[3]); w.z = cvt_pk_bf16(v1[0], v1[1]); w.w = cvt_pk_bf16(v1[2], v1[3]);
                    *(u32x4*)(rowp + bj * HALF) = w; } }
    }
};
template <class Epi, class Sched, bool ALIGN_EPI = false, bool SP2 = false>
__device__ __forceinline__ void gemm_phase(PG8_LAS unsigned char* lds, const Gemm g, const Sched& S, const Epi& E) {
    const int tid = threadIdx.x, wid = __builtin_amdgcn_readfirstlane(tid >> 6), lane = tid & 63, wr = wid >> 2, wc = wid & 3, fr = lane & 15, fq = lane >> 4;
    const int K = g.K, nt = K / BK;
    unsigned voffA[2], voffB[2];
#pragma unroll
    for (int i = 0; i < 2; ++i) { int R, C; stage_rc(tid * 16 + i * 8192, R, C); const int Rb = Epi::PERM ? ((R & ~31) + perm32(R & 31)) : R;
        voffA[i] = (unsigned)(R * g.lda + C) * 2u; voffB[i] = (unsigned)(Rb * g.ldb + C) * 2u; }
    const size_t kstep = (size_t)(BK * 2);
    const size_t hstepA = (size_t)HALF * g.lda * 2, hstepB = (size_t)HALF * g.ldb * 2;
    const size_t tstepA = 2 * hstepA, tstepB = 2 * hstepB;
    const unsigned ldsw = (unsigned)wid * 1024u;
    const int aoff = lds_byte(wr * 64 + fr, fq * 8), boff = lds_byte(wc * 32 + fr, fq * 8);
#define PG8_SA(b, h) (((b) * 2 + (h)) * HTB)
#define PG8_SB(b, h) ((4 + (b) * 2 + (h)) * HTB)
#define PG8_STAGE(bufoff, gbase, voff) do { _Pragma("unroll") for (int _i = 0; _i < 2; ++_i) \
        __builtin_amdgcn_global_load_lds((const unsigned*)((const char*)(gbase) + (voff)[_i]), (PG8_LAS unsigned*)(lds + (bufoff) + ldsw + _i * 8192), 16, 0, 0); } while (0)
#define PG8_LDA(dst, b, h) do { _Pragma("unroll") for (int m = 0; m < 4; ++m) _Pragma("unroll") for (int k = 0; k < 2; ++k) dst[m][k] = *(const PG8_LAS bf16x8*)(lds + PG8_SA(b, h) + aoff + m * 2048 + k * 1024); } while (0)
#define PG8_LDB(dst, b, h) do { _Pragma("unroll") for (int n = 0; n < 2; ++n) _Pragma("unroll") for (int k = 0; k < 2; ++k) dst[n][k] = *(const PG8_LAS bf16x8*)(lds + PG8_SB(b, h) + boff + n * 2048 + k * 1024); } while (0)
#define PG8_MMA(ai, bj, At, Bt) do { __builtin_amdgcn_s_setprio(1); _Pragma("unroll") for (int m = 0; m < 4; ++m) _Pragma("unroll") for (int n = 0; n < 2; ++n) _Pragma("unroll") for (int k = 0; k < 2; ++k) \
        acc[ai][bj][m][n] = __builtin_amdgcn_mfma_f32_16x16x32_bf16(Bt[n][k], At[m][k], acc[ai][bj][m][n], 0, 0, 0); __builtin_amdgcn_s_setprio(0); } while (0)
#define PG8_WAIT_V(n) asm volatile("s_waitcnt vmcnt(" #n ")" ::: "memory")
#define PG8_WAIT_L(n) asm volatile("s_waitcnt lgkmcnt(" #n ")" ::: "memory")
#define PG8_BAR __builtin_amdgcn_s_barrier()
#define PG8_SCHED __builtin_amdgcn_sched_barrier(0)
    Unit cur, nxt; int ui = 0;
    if (!S.next(0, cur)) return;
    f32x4 acc[2][2][4][2];
#pragma unroll
    for (int a = 0; a < 2; ++a)
#pragma unroll
        for (int b = 0; b < 2; ++b)
#pragma unroll
            for (int m = 0; m < 4; ++m)
#pragma unroll
                for (int n = 0; n < 2; ++n) acc[a][b][m][n] = (f32x4){0.f, 0.f, 0.f, 0.f};
    bf16x8 At[4][2], B0[2][2], B1[2][2];
    const char* cA = (const char*)g.A + (size_t)cur.pm * tstepA; const char* cB = (const char*)g.Bt + (size_t)cur.pn * tstepB;
    S.a_ready(cur);
    if constexpr (SP2) {
        PG8_STAGE(PG8_SB(0, 0), cB, voffB); PG8_STAGE(PG8_SB(0, 1), cB + hstepB, voffB); PG8_STAGE(PG8_SA(0, 0), cA, voffA); PG8_STAGE(PG8_SA(0, 1), cA + hstepA, voffA);
        if (wr == 1) PG8_BAR;
        PG8_WAIT_V(2); PG8_BAR;
        PG8_STAGE(PG8_SB(1, 0), cB + kstep, voffB); PG8_STAGE(PG8_SA(1, 0), cA + kstep, voffA); PG8_STAGE(PG8_SB(1, 1), cB + hstepB + kstep, voffB);
        PG8_WAIT_V(6); PG8_BAR;
    } else {
        PG8_STAGE(PG8_SB(0, 0), cB, voffB); PG8_STAGE(PG8_SA(0, 0), cA, voffA); PG8_STAGE(PG8_SB(0, 1), cB + hstepB, voffB); PG8_STAGE(PG8_SA(0, 1), cA + hstepA, voffA);
        if (wr == 1) PG8_BAR;
        PG8_WAIT_V(4); PG8_BAR;
        PG8_STAGE(PG8_SB(1, 0), cB + kstep, voffB); PG8_STAGE(PG8_SA(1, 0), cA + kstep, voffA); PG8_STAGE(PG8_SB(1, 1), cB + hstepB + kstep, voffB);
        PG8_WAIT_V(6); PG8_BAR;
    }
    for (;;) {
        const bool has_next = S.next(ui + 1, nxt);
        const char* nA = has_next ? (const char*)g.A + (size_t)nxt.pm * tstepA : cA; const char* nB = has_next ? (const char*)g.Bt + (size_t)nxt.pn * tstepB : cB;
        for (int t = 0; t < nt; t += 2) {
            const bool last = (t == nt - 2);
            const char* a1 = cA + (size_t)(t + 1) * kstep;
            const char* a2 = last ? nA : cA + (size_t)(t + 2) * kstep; const char* b2 = last ? nB : cB + (size_t)(t + 2) * kstep;
            const char* a3 = a2 + kstep; const char* b3 = b2 + kstep;
            if (last && has_next) S.a_ready(nxt);
            if constexpr (SP2) {
            PG8_LDB(B0, 0, 0); PG8_LDB(B1, 0, 1); PG8_SCHED; PG8_LDA(At, 0, 0); PG8_STAGE(PG8_SA(1, 1), a1 + hstepA, voffA);
            PG8_WAIT_V(8); PG8_WAIT_L(0); PG8_BAR; PG8_MMA(0, 0, At, B0); PG8_MMA(0, 1, At, B1); PG8_BAR; PG8_SCHED;
            PG8_LDA(At, 0, 1); PG8_STAGE(PG8_SB(0, 0), b2, voffB); PG8_STAGE(PG8_SB(0, 1), b2 + hstepB, voffB); PG8_STAGE(PG8_SA(0, 0), a2, voffA);
            PG8_WAIT_V(8); PG8_WAIT_L(0); PG8_BAR; PG8_MMA(1, 0, At, B0); PG8_MMA(1, 1, At, B1); PG8_BAR; PG8_SCHED;
            PG8_LDB(B0, 1, 0); PG8_LDB(B1, 1, 1); PG8_SCHED; PG8_LDA(At, 1, 0); PG8_STAGE(PG8_SA(0, 1), a2 + hstepA, voffA);
            PG8_WAIT_V(8); PG8_WAIT_L(0); PG8_BAR; PG8_MMA(0, 0, At, B0); PG8_MMA(0, 1, At, B1); PG8_BAR; PG8_SCHED;
            PG8_LDA(At, 1, 1); PG8_STAGE(PG8_SB(1, 0), b3, voffB); PG8_STAGE(PG8_SB(1, 1), b3 + hstepB, voffB); PG8_STAGE(PG8_SA(1, 0), a3, voffA);
            PG8_WAIT_V(8); PG8_WAIT_L(0); PG8_BAR; PG8_MMA(1, 0, At, B0); PG8_MMA(1, 1, At, B1); PG8_BAR; PG8_SCHED;
            } else {
            PG8_LDB(B0, 0, 0); PG8_SCHED; PG8_LDA(At, 0, 0); PG8_STAGE(PG8_SA(1, 1), a1 + hstepA, voffA);
            PG8_WAIT_L(8); PG8_BAR; PG8_WAIT_L(0); PG8_MMA(0, 0, At, B0); PG8_BAR; PG8_SCHED;
            PG8_LDB(B1, 0, 1); PG8_STAGE(PG8_SB(0, 0), b2, voffB);
            PG8_BAR; PG8_WAIT_L(0); PG8_MMA(0, 1, At, B1); PG8_BAR;
            PG8_LDA(At, 0, 1); PG8_STAGE(PG8_SA(0, 0), a2, voffA);
            PG8_BAR; PG8_WAIT_L(0); PG8_MMA(1, 0, At, B0); PG8_BAR; PG8_SCHED;
            PG8_STAGE(PG8_SB(0, 1), b2 + hstepB, voffB);
            PG8_WAIT_V(6); PG8_BAR; PG8_MMA(1, 1, At, B1); PG8_BAR;
            PG8_LDB(B0, 1, 0); PG8_SCHED; PG8_LDA(At, 1, 0); PG8_STAGE(PG8_SA(0, 1), a2 + hstepA, voffA);
            PG8_WAIT_L(8); PG8_BAR; PG8_WAIT_L(0); PG8_MMA(0, 0, At, B0); PG8_BAR; PG8_SCHED;
            PG8_LDB(B1, 1, 1); PG8_STAGE(PG8_SB(1, 0), b3, voffB);
            PG8_BAR; PG8_WAIT_L(0); PG8_MMA(0, 1, At, B1); PG8_BAR;
            PG8_LDA(At, 1, 1); PG8_STAGE(PG8_SA(1, 0), a3, voffA);
            PG8_BAR; PG8_WAIT_L(0); PG8_MMA(1, 0, At, B0); PG8_BAR; PG8_SCHED;
            PG8_STAGE(PG8_SB(1, 1), b3 + hstepB, voffB);
            PG8_WAIT_V(6); PG8_BAR; PG8_MMA(1, 1, At, B1); PG8_BAR;
            }
        }
        if constexpr (ALIGN_EPI) { if (wr == 0) PG8_BAR; }
        if constexpr (!Epi::AFTER_DRAIN) { E(acc, cur, wr, wc, fr, fq); S.done(cur); }
        if (!has_next) break;
#pragma unroll
        for (int a = 0; a < 2; ++a)
#pragma unroll
            for (int b = 0; b < 2; ++b)
#pragma unroll
                for (int m = 0; m < 4; ++m)
#pragma unroll
                    for (int n = 0; n < 2; ++n) acc[a][b][m][n] = (f32x4){0.f, 0.f, 0.f, 0.f};
        cur = nxt; cA = nA; cB = nB; ++ui;
        if constexpr (ALIGN_EPI) { if (wr == 1) PG8_BAR; }
    }
    PG8_WAIT_V(0);
    if constexpr (!ALIGN_EPI) { if (wr == 0) PG8_BAR; }
    PG8_BAR;
    if constexpr (Epi::AFTER_DRAIN) { E.fused(acc, cur, wr, wc, fr, fq, lds, wid, lane); S.done(cur); }
#undef PG8_SA
#undef PG8_SB
#undef PG8_STAGE
#undef PG8_LDA
#undef PG8_LDB
#undef PG8_MMA
#undef PG8_WAIT_V
#undef PG8_WAIT_L
#undef PG8_BAR
#undef PG8_SCHED
}
}

#define GAS __attribute__((address_space(1)))
#define LAS __attribute__((address_space(3)))
typedef unsigned short bf16;
typedef unsigned v4u __attribute__((ext_vector_type(4)));
typedef unsigned v2u __attribute__((ext_vector_type(2)));
typedef float f32x4 __attribute__((ext_vector_type(4)));

#ifndef MK_MULTI
#define MK_MULTI 0
#endif

constexpr int BATCH = 8, SEQ = 2048, DM = 1024, M = BATCH * SEQ;
constexpr int NH = 8, HD = 64, AW = 512, SWD = 512, NG = 32, HC = 16, PS = 64, INW = 1280, FF = 2816;
constexpr float EPS = 1e-6f;
constexpr size_t MiB = 1u << 20;
constexpr size_t WS_WT1 = 2 * MiB, WS_WD1 = 14 * MiB, WS_WT2 = 20 * MiB, WS_WD2 = 32 * MiB, WS_WIN = 38 * MiB, WS_WOUT = 41 * MiB, WS_WGLU = 43 * MiB;
constexpr size_t WS_MATS = 44 * MiB;
constexpr size_t WS_XA = 64 * MiB;
constexpr size_t WS_H = 96 * MiB;
constexpr size_t WS_S = 96 * MiB;
constexpr size_t WS_SST = 96 * MiB;
constexpr size_t WS_MIX = 112 * MiB;
constexpr size_t WS_MATY = 144 * MiB;
constexpr size_t WS_UA = 168 * MiB;
constexpr size_t WS_QKV = 192 * MiB;
constexpr size_t WS_ATT = 216 * MiB;
constexpr size_t WS_YG = 232 * MiB;
constexpr size_t WS_END = 256 * MiB;
constexpr int TC = 32, NC = SEQ / TC, KY = 16 * TC + 256, KS = 16 * TC;
constexpr int LDS_BYTES = 147456;

__device__ __forceinline__ unsigned f2bf(float f) { unsigned u = __builtin_bit_cast(unsigned, f); return (u + 0x7fffu + ((u >> 16) & 1u)) >> 16; }
__device__ __forceinline__ unsigned pk2(float lo, float hi) { return f2bf(lo) | (f2bf(hi) << 16); }
__device__ __forceinline__ float bflo(unsigned w) { return __builtin_bit_cast(float, w << 16); }
__device__ __forceinline__ float bfhi(unsigned w) { return __builtin_bit_cast(float, w & 0xffff0000u); }
#define LDS_WAIT() asm volatile("s_waitcnt lgkmcnt(0)" ::: "memory")
__device__ __forceinline__ float wave_sum(float v) {
#pragma unroll
    for (int o = 1; o < 64; o <<= 1) v += __shfl_xor(v, o);
    return v;
}
__device__ __forceinline__ float sigmoidf_(float x) { return __builtin_amdgcn_rcpf(1.f + __expf(-x)); }

namespace pg8 {
struct EpiSwiglu {
    static constexpr bool PERM = true, AFTER_DRAIN = false;
    bf16_t* H; int ldh;
    __device__ __forceinline__ void operator()(const f32x4 (&acc)[2][2][4][2], const Unit& u, int wr, int wc, int fr, int fq) const {
        const int row0 = u.pm * BM + wr * 64 + fr, col0 = u.pn * HALF + wc * 32 + 8 * fq;
#pragma unroll
        for (int ai = 0; ai < 2; ++ai)
#pragma unroll
            for (int m = 0; m < 4; ++m) {
                bf16_t* rowp = H + (size_t)(row0 + ai * HALF + m * 16) * ldh + col0;
                float hv[8];
#pragma unroll
                for (int n = 0; n < 2; ++n)
#pragma unroll
                    for (int i = 0; i < 4; ++i) { const float g = acc[ai][0][m][n][i], up = acc[ai][1][m][n][i]; hv[n * 4 + i] = g * __builtin_amdgcn_rcpf(1.f + __expf(-g)) * up; }
                u32x4 w; w.x = cvt_pk_bf16(hv[0], hv[1]); w.y = cvt_pk_bf16(hv[2], hv[3]); w.z = cvt_pk_bf16(hv[4], hv[5]); w.w = cvt_pk_bf16(hv[6], hv[7]);
                *(u32x4*)rowp = w;
            }
    }
};
struct EpiResid {
    static constexpr bool PERM = false, AFTER_DRAIN = false;
    const float* base; float* out; float alpha;
    __device__ __forceinline__ void operator()(const f32x4 (&acc)[2][2][4][2], const Unit& u, int wr, int wc, int fr, int fq) const {
        const int col0 = u.pn * BM + wc * 32 + 4 * fq;
#pragma unroll
        for (int ai = 0; ai < 2; ++ai)
#pragma unroll
            for (int m = 0; m < 4; ++m) {
                const size_t off = (size_t)(u.pm * BM + ai * HALF + wr * 64 + m * 16 + fr) * 1024 + col0;
#pragma unroll
                for (int bj = 0; bj < 2; ++bj)
#pragma unroll
                    for (int n = 0; n < 2; ++n) { const f32x4 b = *(const f32x4*)(base + off + bj * HALF + n * 16); *(f32x4*)(out + off + bj * HALF + n * 16) = b + acc[ai][bj][m][n] * alpha; }
            }
    }
};
struct EpiGlu {
    static constexpr bool PERM = true, AFTER_DRAIN = false;
    const bf16_t* Y; bf16_t* S; const float* bias;
    __device__ __forceinline__ void operator()(const f32x4 (&acc)[2][2][4][2], const Unit& u, int wr, int wc, int fr, int fq) const {
        const int row0 = u.pm * BM + wr * 64 + fr, col0 = u.pn * BM + wc * 32 + 8 * fq;
#pragma unroll
        for (int bj = 0; bj < 2; ++bj) {
            const f32x4 b0 = *(const f32x4*)(bias + col0 + bj * HALF), b1 = *(const f32x4*)(bias + col0 + bj * HALF + 4);
#pragma unroll
            for (int ai = 0; ai < 2; ++ai)
#pragma unroll
                for (int m = 0; m < 4; ++m) {
                    const size_t off = (size_t)(row0 + ai * HALF + m * 16) * 512 + col0 + bj * HALF;
                    const u32x4 yv = *(const u32x4*)(Y + off);
                    const f32x4 v0 = acc[ai][bj][m][0] + b0, v1 = acc[ai][bj][m][1] + b1;
                    float o[8];
                    o[0] = bflo(yv.x) * sigmoidf_(v0[0]); o[1] = bfhi(yv.x) * sigmoidf_(v0[1]); o[2] = bflo(yv.y) * sigmoidf_(v0[2]); o[3] = bfhi(yv.y) * sigmoidf_(v0[3]);
                    o[4] = bflo(yv.z) * sigmoidf_(v1[0]); o[5] = bfhi(yv.z) * sigmoidf_(v1[1]); o[6] = bflo(yv.w) * sigmoidf_(v1[2]); o[7] = bfhi(yv.w) * sigmoidf_(v1[3]);
                    u32x4 w; w.x = cvt_pk_bf16(o[0], o[1]); w.y = cvt_pk_bf16(o[2], o[3]); w.z = cvt_pk_bf16(o[4], o[5]); w.w = cvt_pk_bf16(o[6], o[7]);
                    *(u32x4*)(S + off) = w;
                }
        }
    }
};
}

template <int MODE>
__device__ __forceinline__ void p0_transpose_item(const float* W, int K, int N, bf16* WT, LAS float* scr, int item, int lane) {
    const int nblk = N / 32, kb = item / nblk, nb = item % nblk, k0 = 64 * kb, n0 = 32 * nb;
#pragma unroll 8
    for (int i = 0; i < 32; ++i) { const int kk = 2 * i + (lane >> 5); scr[kk * 33 + (lane & 31)] = W[(size_t)(k0 + kk) * N + n0 + (lane & 31)]; }
    LDS_WAIT(); asm volatile("" ::: "memory");
    const int c = lane & 7;
    const int r0 = MODE == 0 ? n0 : ((n0 >> 7) * 256 + (n0 & 127) + (MODE == 2 ? 128 : 0));
#pragma unroll
    for (int j = 0; j < 4; ++j) { const int n = (lane >> 3) + 8 * j; const LAS float* s = scr + (8 * c) * 33 + n;
        v4u o; o.x = pk2(s[0 * 33], s[1 * 33]); o.y = pk2(s[2 * 33], s[3 * 33]); o.z = pk2(s[4 * 33], s[5 * 33]); o.w = pk2(s[6 * 33], s[7 * 33]);
        *(v4u*)(WT + (size_t)(r0 + n) * K + k0 + 8 * c) = o; }
    LDS_WAIT(); asm volatile("" ::: "memory");
}

__device__ __forceinline__ void rms_row_to_bf16(const float* xrow, const float* gain, bf16* orow, int lane) {
    const f32x4* xr = (const f32x4*)xrow + lane; const f32x4* gr = (const f32x4*)gain + lane;
    f32x4 v[4]; float s = 0.f;
#pragma unroll
    for (int j = 0; j < 4; ++j) { v[j] = xr[64 * j]; s += (v[j].x * v[j].x + v[j].y * v[j].y) + (v[j].z * v[j].z + v[j].w * v[j].w); }
    const float rstd = 1.f / sqrtf(wave_sum(s) * (1.f / DM) + EPS);
    unsigned long long* o8 = (unsigned long long*)orow + lane;
#pragma unroll
    for (int j = 0; j < 4; ++j) { const f32x4 g = gr[64 * j];
        o8[64 * j] = (unsigned long long)pk2(v[j].x * rstd * g.x, v[j].y * rstd * g.y) | ((unsigned long long)pk2(v[j].z * rstd * g.z, v[j].w * rstd * g.w) << 32); }
}
__device__ __forceinline__ void rms_row_f32(float* xrow, const float* gain, int lane) {
    f32x4* xr = (f32x4*)xrow + lane; const f32x4* gr = (const f32x4*)gain + lane;
    f32x4 v[4]; float s = 0.f;
#pragma unroll
    for (int j = 0; j < 4; ++j) { v[j] = xr[64 * j]; s += (v[j].x * v[j].x + v[j].y * v[j].y) + (v[j].z * v[j].z + v[j].w * v[j].w); }
    const float rstd = 1.f / sqrtf(wave_sum(s) * (1.f / DM) + EPS);
#pragma unroll
    for (int j = 0; j < 4; ++j) { const f32x4 g = gr[64 * j]; xr[64 * j] = v[j] * rstd * g; }
}
__device__ __forceinline__ void mix_row(const bf16* arow, const bf16* srow, const float* ga, const float* gs, bf16* orow, int lane) {
    const v4u a = *((const v4u*)arow + lane), s = *((const v4u*)srow + lane);
    float av[8] = {bflo(a.x), bfhi(a.x), bflo(a.y), bfhi(a.y), bflo(a.z), bfhi(a.z), bflo(a.w), bfhi(a.w)};
    float sv[8] = {bflo(s.x), bfhi(s.x), bflo(s.y), bfhi(s.y), bflo(s.z), bfhi(s.z), bflo(s.w), bfhi(s.w)};
    float sa = 0.f, ss = 0.f;
#pragma unroll
    for (int i = 0; i < 8; ++i) { sa += av[i] * av[i]; ss += sv[i] * sv[i]; }
    const float ra = 1.f / sqrtf(wave_sum(sa) * (1.f / 512.f) + EPS), rs = 1.f / sqrtf(wave_sum(ss) * (1.f / 512.f) + EPS);
    const f32x4 ga0 = *((const f32x4*)ga + 2 * lane), ga1 = *((const f32x4*)ga + 2 * lane + 1), gs0 = *((const f32x4*)gs + 2 * lane), gs1 = *((const f32x4*)gs + 2 * lane + 1);
    v4u oa, os;
    oa.x = pk2(av[0] * ra * ga0.x, av[1] * ra * ga0.y); oa.y = pk2(av[2] * ra * ga0.z, av[3] * ra * ga0.w); oa.z = pk2(av[4] * ra * ga1.x, av[5] * ra * ga1.y); oa.w = pk2(av[6] * ra * ga1.z, av[7] * ra * ga1.w);
    os.x = pk2(sv[0] * rs * gs0.x, sv[1] * rs * gs0.y); os.y = pk2(sv[2] * rs * gs0.z, sv[3] * rs * gs0.w); os.z = pk2(sv[4] * rs * gs1.x, sv[5] * rs * gs1.y); os.w = pk2(sv[6] * rs * gs1.z, sv[7] * rs * gs1.w);
    *((v4u*)orow + lane) = oa; *((v4u*)(orow + 512) + lane) = os;
}

__device__ __forceinline__ void attn_naive(LAS unsigned char* lds, const bf16* QKVU  , bf16* ATT, const float* sinks, int G, int bid) {
    const int tid = threadIdx.x, lane = tid & 63, w = tid >> 6;
    LAS bf16* Ks = (LAS bf16*)lds; LAS bf16* Vs = Ks + 384 * 64;
    for (int unit = bid; unit < 256; unit += G) {
        const int kh = unit & 1, qb = (unit >> 1) & 15, b = unit >> 5, kp0 = qb * 128 - 128;
        __syncthreads();
        for (int c = tid; c < 3072; c += 512) { const int r = c >> 3, ch = c & 7, kp = kp0 + r; v4u kv = (v4u){0u, 0u, 0u, 0u}, vv = kv;
            if (kp >= 0 && kp < SEQ) { const bf16* src = QKVU + (size_t)(b * SEQ + kp) * 768; kv = *(const v4u*)(src + 512 + kh * 64 + ch * 8); vv = *(const v4u*)(src + 640 + kh * 64 + ch * 8); }
            *(LAS v4u*)(Ks + r * 64 + ch * 8) = kv; *(LAS v4u*)(Vs + r * 64 + ch * 8) = vv; }
        __syncthreads();
        const int g = w >> 1, qa = (w & 1) * 64, qi = qa + lane, t = qb * 128 + qi, h = kh * 4 + g;
        const float slope = exp2f(-(float)(h + 1));
        float q[64], acc[64];
        { const bf16* qp = QKVU + (size_t)(b * SEQ + t) * 768 + h * 64;
#pragma unroll
          for (int c = 0; c < 8; ++c) { const v4u qq = *(const v4u*)(qp + c * 8);
              q[c * 8 + 0] = bflo(qq.x) * 0.125f; q[c * 8 + 1] = bfhi(qq.x) * 0.125f; q[c * 8 + 2] = bflo(qq.y) * 0.125f; q[c * 8 + 3] = bfhi(qq.y) * 0.125f;
              q[c * 8 + 4] = bflo(qq.z) * 0.125f; q[c * 8 + 5] = bfhi(qq.z) * 0.125f; q[c * 8 + 6] = bflo(qq.w) * 0.125f; q[c * 8 + 7] = bfhi(qq.w) * 0.125f; } }
#pragma unroll
        for (int d = 0; d < 64; ++d) acc[d] = 0.f;
        float mx = sinks[h], l = 1.f;
        for (int jj = qa; jj < qa + 320; ++jj) {
            float s = 0.f;
#pragma unroll
            for (int c = 0; c < 8; ++c) { const v4u kk = *(const LAS v4u*)(Ks + jj * 64 + c * 8);
                s += q[c * 8 + 0] * bflo(kk.x) + q[c * 8 + 1] * bfhi(kk.x) + q[c * 8 + 2] * bflo(kk.y) + q[c * 8 + 3] * bfhi(kk.y)
                   + q[c * 8 + 4] * bflo(kk.z) + q[c * 8 + 5] * bfhi(kk.z) + q[c * 8 + 6] * bflo(kk.w) + q[c * 8 + 7] * bfhi(kk.w); }
            const int rel = jj - 128 - qi, kp = kp0 + jj;
            const bool valid = (rel >= -128) && (rel <= 128) && (kp >= 0) && (kp < SEQ);
            s = valid ? s - slope * fabsf((float)rel) : -1e30f;
            const float mn = fmaxf(mx, s), corr = __expf(mx - mn), p = __expf(s - mn);
            l = l * corr + p; mx = mn;
#pragma unroll
            for (int c = 0; c < 8; ++c) { const v4u vv = *(const LAS v4u*)(Vs + jj * 64 + c * 8);
                acc[c * 8 + 0] = acc[c * 8 + 0] * corr + p * bflo(vv.x); acc[c * 8 + 1] = acc[c * 8 + 1] * corr + p * bfhi(vv.x);
                acc[c * 8 + 2] = acc[c * 8 + 2] * corr + p * bflo(vv.y); acc[c * 8 + 3] = acc[c * 8 + 3] * corr + p * bfhi(vv.y);
                acc[c * 8 + 4] = acc[c * 8 + 4] * corr + p * bflo(vv.z); acc[c * 8 + 5] = acc[c * 8 + 5] * corr + p * bfhi(vv.z);
                acc[c * 8 + 6] = acc[c * 8 + 6] * corr + p * bflo(vv.w); acc[c * 8 + 7] = acc[c * 8 + 7] * corr + p * bfhi(vv.w); }
        }
        const float inv = 1.f / l;
        bf16* op = ATT + (size_t)(b * SEQ + t) * AW + h * 64;
#pragma unroll
        for (int c = 0; c < 8; ++c) { v4u o; o.x = pk2(acc[c * 8 + 0] * inv, acc[c * 8 + 1] * inv); o.y = pk2(acc[c * 8 + 2] * inv, acc[c * 8 + 3] * inv);
            o.z = pk2(acc[c * 8 + 4] * inv, acc[c * 8 + 5] * inv); o.w = pk2(acc[c * 8 + 6] * inv, acc[c * 8 + 7] * inv); *(v4u*)(op + c * 8) = o; }
    }
}

struct SsmP { const float *lam_re, *lam_im, *log_dt, *b_re, *b_im, *c_re, *c_im, *dskip; };
__device__ __forceinline__ float gelu_tanh(float x) { const float z = 1.5957691216f * (x + 0.044715f * x * x * x); return x * __builtin_amdgcn_rcpf(1.f + __expf(-z)); }
__device__ __forceinline__ void lam_of(const SsmP& P, int dg, int p, float& lrdt, float& lidt, float& cr, float& ci) {
    const float lr = fminf(P.lam_re[dg * PS + p], -1e-4f), li = P.lam_im[dg * PS + p], dt = expf(P.log_dt[dg]);
    lrdt = lr * dt; lidt = li * dt;
    const float mag = expf(lrdt), ar = mag * cosf(lidt), ai = mag * sinf(lidt), den = lr * lr + li * li;
    cr = ((ar - 1.f) * lr + ai * li) / den; ci = (ai * lr - (ar - 1.f) * li) / den;
}
__device__ __forceinline__ void apow(float lrdt, float lidt, float k, float& pr, float& pi) { const float m = expf(lrdt * k), a = lidt * k; pr = m * cosf(a); pi = m * sinf(a); }

__device__ __forceinline__ void gen_states_item(const SsmP& P, bf16* MATS, int it, int lane) {
    const int p = it & 63, dir = (it >> 6) & 1, g = it >> 7, dg = dir * NG + g, s = lane >> 1, hh = lane & 1;
    float lrdt, lidt, cr, ci, pr, pi; lam_of(P, dg, p, lrdt, lidt, cr, ci); apow(lrdt, lidt, (float)(dir ? s : TC - 1 - s), pr, pi);
    const float wr = pr * cr - pi * ci, wi = pr * ci + pi * cr;
    const float* brp = P.b_re + (size_t)(dg * PS + p) * HC + hh * 8; const float* bip = P.b_im + (size_t)(dg * PS + p) * HC + hh * 8;
    const f32x4 br0 = *(const f32x4*)brp, br1 = *(const f32x4*)(brp + 4), bi0 = *(const f32x4*)bip, bi1 = *(const f32x4*)(bip + 4);
    const f32x4 re0 = br0 * wr - bi0 * wi, re1 = br1 * wr - bi1 * wi, im0 = bi0 * wr + br0 * wi, im1 = bi1 * wr + br1 * wi;
    v4u o; bf16* dst = MATS + (size_t)(g * 256 + dir * 128 + p) * KS + s * 16 + hh * 8;
    o.x = pk2(re0.x, re0.y); o.y = pk2(re0.z, re0.w); o.z = pk2(re1.x, re1.y); o.w = pk2(re1.z, re1.w); *(v4u*)dst = o;
    o.x = pk2(im0.x, im0.y); o.y = pk2(im0.z, im0.w); o.z = pk2(im1.x, im1.y); o.w = pk2(im1.z, im1.w); *(v4u*)(dst + (size_t)64 * KS) = o;
}
__device__ __forceinline__ void gen_carry_item(const SsmP& P, bf16* MATY, int it, int lane) {
    const int tau = it & 31, dir = (it >> 5) & 1, g = it >> 6, dg = dir * NG + g;
    float lrdt, lidt, cr, ci, pr, pi; lam_of(P, dg, lane, lrdt, lidt, cr, ci); apow(lrdt, lidt, (float)(dir ? TC - tau : tau + 1), pr, pi);
#pragma unroll
    for (int h = 0; h < HC; ++h) { const float c_r = P.c_re[(size_t)(dg * HC + h) * PS + lane], c_i = P.c_im[(size_t)(dg * HC + h) * PS + lane];
        bf16* dst = MATY + (size_t)(g * 512 + tau * 16 + h) * KY + 512 + dir * 128 + lane;
        dst[0] = (bf16)f2bf(c_r * pr - c_i * pi); dst[64] = (bf16)f2bf(-(c_r * pi + c_i * pr)); }
}
__device__ __forceinline__ void gen_toep_item(const SsmP& P, bf16* MATY, LAS float* scr, int it, int lane) {
    const int g = it / 63, dl = it % 63 - 31, k = dl < 0 ? -dl : dl;
    LAS float* Wr = scr; LAS float* Wi = scr + 64; LAS float* Cr = scr + 128; LAS float* Ci = Cr + 16 * 65; LAS float* Br = Ci + 16 * 65; LAS float* Bi = Br + 1024;
    const int h = lane >> 2, q = lane & 3;
    float val[4] = {0.f, 0.f, 0.f, 0.f};
    for (int dir = 0; dir < 2; ++dir) {
        if ((dl > 0 && dir == 1) || (dl < 0 && dir == 0)) continue;
        const int dg = dir * NG + g;
        float lrdt, lidt, cr, ci, pr, pi; lam_of(P, dg, lane, lrdt, lidt, cr, ci); apow(lrdt, lidt, (float)k, pr, pi);
        Wr[lane] = pr * cr - pi * ci; Wi[lane] = pr * ci + pi * cr;
#pragma unroll
        for (int i = 0; i < 16; ++i) { Cr[i * 65 + lane] = P.c_re[(size_t)(dg * HC + i) * PS + lane]; Ci[i * 65 + lane] = P.c_im[(size_t)(dg * HC + i) * PS + lane];
            Br[i * 64 + lane] = P.b_re[(size_t)dg * 1024 + i * 64 + lane]; Bi[i * 64 + lane] = P.b_im[(size_t)dg * 1024 + i * 64 + lane]; }
        LDS_WAIT(); asm volatile("" ::: "memory");
        for (int p = 0; p < 64; ++p) { const float wr = Wr[p], wi = Wi[p], c_r = Cr[h * 65 + p], c_i = Ci[h * 65 + p], tr = c_r * wr - c_i * wi, ti = c_r * wi + c_i * wr;
            const f32x4 b_r = *(const LAS f32x4*)(Br + p * 16 + 4 * q), b_i = *(const LAS f32x4*)(Bi + p * 16 + 4 * q);
            val[0] += tr * b_r.x - ti * b_i.x; val[1] += tr * b_r.y - ti * b_i.y; val[2] += tr * b_r.z - ti * b_i.z; val[3] += tr * b_r.w - ti * b_i.w; }
        LDS_WAIT(); asm volatile("" ::: "memory");
    }
    if (dl == 0) { const float dsk = P.dskip[g * HC + h];
#pragma unroll
        for (int j = 0; j < 4; ++j) if (4 * q + j == h) val[j] += dsk; }
    v2u o; o.x = pk2(val[0], val[1]); o.y = pk2(val[2], val[3]);
    const int t_lo = dl > 0 ? dl : 0, t_hi = dl < 0 ? TC - 1 + dl : TC - 1;
    for (int tau = t_lo; tau <= t_hi; ++tau) { const int s = tau - dl; *(v2u*)(MATY + (size_t)(g * 512 + tau * 16 + h) * KY + s * 16 + 4 * q) = o; }
}

namespace pg8 {
struct GroupOrder {
    int rm, rn, nwg, G, c;
    __device__ void init(int ng, int rm_, int rn_, int G_, int c_) { rm = rm_; rn = rn_; nwg = ng * rm * rn; G = G_; c = c_; }
    __device__ bool next(int i, Unit& u) const { const long L = (long)i * G + c; if (L >= nwg) return false; const int per = rm * rn, gi = (int)L / per, r = (int)L % per; u.pm = gi * rm + r % rm; u.pn = gi * rn + r / rm; return true; }
    __device__ __forceinline__ void a_ready(const Unit&) const {}
    __device__ __forceinline__ void done(const Unit&) const {}
};
struct EpiWin {
    static constexpr bool PERM = true, AFTER_DRAIN = false;
    bf16_t* QKV; bf16_t* UA;
    __device__ __forceinline__ void operator()(const f32x4 (&acc)[2][2][4][2], const Unit& u, int wr, int wc, int fr, int fq) const {
        const int row0 = u.pm * BM + wr * 64 + fr;
#pragma unroll
        for (int ai = 0; ai < 2; ++ai)
#pragma unroll
            for (int m = 0; m < 4; ++m) { const int r = row0 + ai * HALF + m * 16;
#pragma unroll
                for (int bj = 0; bj < 2; ++bj) { const f32x4 v0 = acc[ai][bj][m][0], v1 = acc[ai][bj][m][1];
                    u32x4 w; w.x = cvt_pk_bf16(v0[0], v0[1]); w.y = cvt_pk_bf16(v0[2], v0[3]); w.z = cvt_pk_bf16(v1[0], v1[1]); w.w = cvt_pk_bf16(v1[2], v1[3]);
                    if (u.pn < 3) { *(u32x4*)(QKV + (size_t)r * 768 + u.pn * BM + bj * HALF + wc * 32 + 8 * fq) = w; }
                    else { const int ucol = (u.pn - 3) * BM + bj * HALF + wc * 32 + 8 * fq, gi = ucol >> 4, h0 = ucol & 15, b = r >> 11, t = r & 2047, c = t >> 5, tau = t & 31;
                        *(u32x4*)(UA + (size_t)(gi * 512 + b * 64 + c) * KY + tau * 16 + h0) = w; } } }
    }
};
struct EpiStates {
    static constexpr bool PERM = false, AFTER_DRAIN = true;
    float* SST; bf16_t* UA; const float *lam_re, *lam_im, *log_dt;
    __device__ __forceinline__ void fused(f32x4 (&acc)[2][2][4][2], const Unit& u, int wr, int wc, int fr, int fq, PG8_LAS unsigned char* lds, int wid, int lane) const {
#pragma unroll
        for (int ai = 0; ai < 2; ++ai)
#pragma unroll
            for (int m = 0; m < 4; ++m) { float* rowp = SST + (size_t)(u.pm * BM + ai * HALF + wr * 64 + m * 16 + fr) * 256 + wc * 32 + 4 * fq;
#pragma unroll
                for (int bj = 0; bj < 2; ++bj)
#pragma unroll
                    for (int n = 0; n < 2; ++n) *(f32x4*)(rowp + bj * HALF + n * 16) = acc[ai][bj][m][n]; }
        __threadfence(); __syncthreads();
        const int gi = u.pm >> 1, bl = wid >> 1, dir = wid & 1, dg = dir * NG + gi;
        const float lr = fminf(lam_re[dg * PS + lane], -1e-4f), li = lam_im[dg * PS + lane], dt = expf(log_dt[dg]);
        const float mg = expf(lr * dt * (float)TC), ang = li * dt * (float)TC, a_r = mg * cosf(ang), a_i = mg * sinf(ang);
        const size_t rowbase = (size_t)u.pm * BM + bl * 64;
        const float* sre = SST + rowbase * 256 + dir * 128 + lane;
        bf16_t* cre = UA + rowbase * KY + 512 + dir * 128 + lane;
        float xr = 0.f, xi = 0.f;
#pragma unroll 8
        for (int i = 0; i < NC; ++i) { const int c = dir ? NC - 1 - i : i;
            cre[(size_t)c * KY] = (bf16_t)f2bf(xr); cre[(size_t)c * KY + 64] = (bf16_t)f2bf(xi);
            const float sr = __hip_atomic_load(sre + (size_t)c * 256, __ATOMIC_RELAXED, __HIP_MEMORY_SCOPE_AGENT), si = __hip_atomic_load(sre + (size_t)c * 256 + 64, __ATOMIC_RELAXED, __HIP_MEMORY_SCOPE_AGENT);
            const float nr = a_r * xr - a_i * xi + sr; xi = a_r * xi + a_i * xr + si; xr = nr; }
    }
};
struct EpiSsmOut {
    static constexpr bool PERM = true, AFTER_DRAIN = false;
    bf16_t* YG;
    __device__ __forceinline__ void operator()(const f32x4 (&acc)[2][2][4][2], const Unit& u, int wr, int wc, int fr, int fq) const {
        const int gi = u.pm >> 1;
#pragma unroll
        for (int ai = 0; ai < 2; ++ai)
#pragma unroll
            for (int m = 0; m < 4; ++m) { const int bc = ((u.pm & 1) * BM + ai * HALF + wr * 64 + m * 16 + fr), b = bc >> 6, c = bc & 63;
#pragma unroll
                for (int bj = 0; bj < 2; ++bj) { const int col = (u.pn & 1) * BM + bj * HALF + wc * 32 + 8 * fq, tau = col >> 4, h0 = col & 15;
                    const f32x4 v0 = acc[ai][bj][m][0], v1 = acc[ai][bj][m][1];
                    u32x4 w; w.x = cvt_pk_bf16(gelu_tanh(v0[0]), gelu_tanh(v0[1])); w.y = cvt_pk_bf16(gelu_tanh(v0[2]), gelu_tanh(v0[3]));
                    w.z = cvt_pk_bf16(gelu_tanh(v1[0]), gelu_tanh(v1[1])); w.w = cvt_pk_bf16(gelu_tanh(v1[2]), gelu_tanh(v1[3]));
                    *(u32x4*)(YG + (size_t)(b * SEQ + c * TC + tau) * SWD + gi * 16 + h0) = w; } }
    }
};
}

struct Args { const float* in[26]; float* out; unsigned char* ws; int ph_lo, ph_hi; };
constexpr int N_PHASES = 14;
__global__ void __launch_bounds__(512, 2) mk_fwd(Args args) {
    extern __shared__ __attribute__((aligned(16))) unsigned char lds_raw[];
    LAS unsigned char* lds = (LAS unsigned char*)lds_raw;
    cg::grid_group grid = cg::this_grid();
    const int tid = threadIdx.x, lane = tid & 63, wave = __builtin_amdgcn_readfirstlane(tid >> 6);
    const int G = gridDim.x, bid = blockIdx.x;
    const int gw = bid * 8 + wave, NGW = G * 8;
    unsigned char* ws = args.ws;
    const float* x = args.in[0];
    float* X = args.out;
    bf16* WT1 = (bf16*)(ws + WS_WT1); bf16* WD1 = (bf16*)(ws + WS_WD1); bf16* WT2 = (bf16*)(ws + WS_WT2); bf16* WD2 = (bf16*)(ws + WS_WD2);
    bf16* WIN = (bf16*)(ws + WS_WIN); bf16* WOUT = (bf16*)(ws + WS_WOUT); bf16* WGLU = (bf16*)(ws + WS_WGLU);
    bf16* XA = (bf16*)(ws + WS_XA); bf16* HB = (bf16*)(ws + WS_H); bf16* QKV = (bf16*)(ws + WS_QKV); bf16* ATT = (bf16*)(ws + WS_ATT); bf16* YG = (bf16*)(ws + WS_YG);
    bf16* SB = (bf16*)(ws + WS_S); bf16* MIX = (bf16*)(ws + WS_MIX); bf16* MATS = (bf16*)(ws + WS_MATS); bf16* MATY = (bf16*)(ws + WS_MATY); bf16* UA = (bf16*)(ws + WS_UA); float* SST = (float*)(ws + WS_SST);
    const SsmP SP{args.in[8], args.in[9], args.in[10], args.in[11], args.in[12], args.in[13], args.in[14], args.in[15]};
    const int lo = args.ph_lo, hi = args.ph_hi;
#define IN(k) (lo <= (k) && (k) < hi)
#define SEAM(k) do { if (IN(k) && IN((k) + 1)) grid.sync(); } while (0)

    if (IN(0)) {
        LAS float* scr = (LAS float*)(lds + wave * 16384);
        constexpr int I_UP = (DM / 64) * (FF / 32), I_DN = (FF / 64) * (DM / 32), I_IN = (DM / 64) * (INW / 32), I_GLU = (SWD / 64) * (SWD / 32), I_OUT = (DM / 64) * (DM / 32);
        constexpr int NITEMS = 6 * I_UP + I_IN + I_GLU + I_OUT; static_assert(I_UP == I_DN, "");
        for (int it = gw; it < NITEMS; it += NGW) {
            int r = it;
            if (r < I_UP) { p0_transpose_item<1>(args.in[2], DM, FF, WT1, scr, r, lane); continue; } r -= I_UP;
            if (r < I_UP) { p0_transpose_item<2>(args.in[3], DM, FF, WT1, scr, r, lane); continue; } r -= I_UP;
            if (r < I_DN) { p0_transpose_item<0>(args.in[4], FF, DM, WD1, scr, r, lane); continue; } r -= I_DN;
            if (r < I_UP) { p0_transpose_item<1>(args.in[22], DM, FF, WT2, scr, r, lane); continue; } r -= I_UP;
            if (r < I_UP) { p0_transpose_item<2>(args.in[23], DM, FF, WT2, scr, r, lane); continue; } r -= I_UP;
            if (r < I_DN) { p0_transpose_item<0>(args.in[24], FF, DM, WD2, scr, r, lane); continue; } r -= I_DN;
            if (r < I_IN) { p0_transpose_item<0>(args.in[6], DM, INW, WIN, scr, r, lane); continue; } r -= I_IN;
            if (r < I_GLU) { p0_transpose_item<0>(args.in[16], SWD, SWD, WGLU, scr, r, lane); continue; } r -= I_GLU;
            p0_transpose_item<0>(args.in[20], DM, DM, WOUT, scr, r, lane);
        }
        for (int m = gw; m < M; m += NGW) rms_row_to_bf16(x + (size_t)m * DM, args.in[1], XA + (size_t)m * DM, lane);
    }
    SEAM(0);
    if (IN(1)) { pg8::Gemm g{XA, WT1, M, 2 * FF, DM, DM, DM}; pg8::StaticOrder S; S.init(M, 2 * FF, G, bid); pg8::EpiSwiglu E{HB, FF};
        pg8::gemm_phase<pg8::EpiSwiglu, pg8::StaticOrder, true, true>(lds, g, S, E); }
    SEAM(1);
    if (IN(2)) { pg8::Gemm g{HB, WD1, M, DM, FF, FF, FF}; pg8::StaticOrder S; S.init(M, DM, G, bid); pg8::EpiResid E{x, X, 0.5f};
        pg8::gemm_phase<pg8::EpiResid, pg8::StaticOrder, true, true>(lds, g, S, E); }
    SEAM(2);
    if (IN(3)) {
        LAS float* scr = (LAS float*)(lds + wave * 18432);
        for (int it = gw; it < 32 * 63; it += NGW) gen_toep_item(SP, MATY, scr, it, lane);
        for (int it = gw; it < 32 * 2 * 64; it += NGW) gen_states_item(SP, MATS, it, lane);
        for (int it = gw; it < 32 * 2 * 32; it += NGW) gen_carry_item(SP, MATY, it, lane);
        for (int m = gw; m < M; m += NGW) rms_row_to_bf16(X + (size_t)m * DM, args.in[5], XA + (size_t)m * DM, lane);
    }
    SEAM(3);
    if (IN(4)) { pg8::Gemm g{XA, WIN, M, INW, DM, DM, DM}; pg8::StaticOrder S; S.init(M, INW, G, bid); pg8::EpiWin E{QKV, UA};
        pg8::gemm_phase<pg8::EpiWin, pg8::StaticOrder, true, true>(lds, g, S, E); }
    SEAM(4);
    if (IN(5)) {
        { pg8::Gemm g{UA, MATS, 32 * 512, 32 * 256, KS, KY, KS}; pg8::GroupOrder S; S.init(32, 2, 1, G, bid); pg8::EpiStates E{SST, UA, SP.lam_re, SP.lam_im, SP.log_dt};
          if (G >= 64) pg8::gemm_phase<pg8::EpiStates, pg8::GroupOrder, false, true>(lds, g, S, E); }
        attn_naive(lds, QKV, ATT, args.in[7], G, bid);
    }
    SEAM(5);
    if (IN(6)) { pg8::Gemm g{UA, MATY, 32 * 512, 32 * 512, KY, KY, KY}; pg8::GroupOrder S; S.init(32, 2, 2, G, bid); pg8::EpiSsmOut E{YG};
        pg8::gemm_phase<pg8::EpiSsmOut, pg8::GroupOrder, true, true>(lds, g, S, E); }
    SEAM(6);
    if (IN(7)) { pg8::Gemm g{YG, WGLU, M, SWD, SWD, SWD, SWD}; pg8::StaticOrder S; S.init(M, SWD, G, bid); pg8::EpiGlu E{YG, SB, args.in[17]};
        pg8::gemm_phase<pg8::EpiGlu, pg8::StaticOrder, true, true>(lds, g, S, E); }
    SEAM(7);
    if (IN(8)) { for (int m = gw; m < M; m += NGW) mix_row(ATT + (size_t)m * AW, SB + (size_t)m * SWD, args.in[18], args.in[19], MIX + (size_t)m * DM, lane); }
    SEAM(8);
    if (IN(9)) { pg8::Gemm g{MIX, WOUT, M, DM, DM, DM, DM}; pg8::StaticOrder S; S.init(M, DM, G, bid); pg8::EpiResid E{X, X, 1.0f};
        pg8::gemm_phase<pg8::EpiResid, pg8::StaticOrder, true, true>(lds, g, S, E); }
    SEAM(9);
    if (IN(10)) { for (int m = gw; m < M; m += NGW) rms_row_to_bf16(X + (size_t)m * DM, args.in[21], XA + (size_t)m * DM, lane); }
    SEAM(10);
    if (IN(11)) { pg8::Gemm g{XA, WT2, M, 2 * FF, DM, DM, DM}; pg8::StaticOrder S; S.init(M, 2 * FF, G, bid); pg8::EpiSwiglu E{HB, FF};
        pg8::gemm_phase<pg8::EpiSwiglu, pg8::StaticOrder, true, true>(lds, g, S, E); }
    SEAM(11);
    if (IN(12)) { pg8::Gemm g{HB, WD2, M, DM, FF, FF, FF}; pg8::StaticOrder S; S.init(M, DM, G, bid); pg8::EpiResid E{X, X, 0.5f};
        pg8::gemm_phase<pg8::EpiResid, pg8::StaticOrder, true, true>(lds, g, S, E); }
    SEAM(12);
    if (IN(13)) { for (int m = gw; m < M; m += NGW) rms_row_f32(X + (size_t)m * DM, args.in[25], lane); }
#undef IN
#undef SEAM
}

extern "C" void kernel_launch(void* const* d_in, const int* in_sizes, int n_in, void* d_out, int out_size, void* d_ws, size_t ws_size, hipStream_t stream) {
    static int grid = 0;
    if (grid == 0) {
        if (n_in != 26 || in_sizes[0] != M * DM || out_size != M * DM || ws_size < WS_END) { fprintf(stderr, "kernel_launch: unexpected shapes n_in %d in0 %d out %d ws %zu\n", n_in, n_in > 0 ? in_sizes[0] : -1, out_size, ws_size); grid = -1; return; }
        int dev = 0, cus = 0, per_cu = 0;
        (void)hipGetDevice(&dev); (void)hipDeviceGetAttribute(&cus, hipDeviceAttributeMultiprocessorCount, dev);
        if (hipFuncSetAttribute((const void*)mk_fwd, hipFuncAttributeMaxDynamicSharedMemorySize, LDS_BYTES) != hipSuccess) { fprintf(stderr, "kernel_launch: hipFuncSetAttribute failed\n"); grid = -1; return; }
        if (hipOccupancyMaxActiveBlocksPerMultiprocessor(&per_cu, (const void*)mk_fwd, 512, LDS_BYTES) != hipSuccess || per_cu < 1) { fprintf(stderr, "kernel_launch: occupancy query says %d\n", per_cu); per_cu = 1; }
        (void)hipGetLastError();
        grid = cus * per_cu;
        fprintf(stderr, "kernel_launch: grid %d (cus %d per_cu %d)\n", grid, cus, per_cu);
    }
    if (grid < 0) return;
    Args a{};
    for (int i = 0; i < 26; ++i) a.in[i] = (const float*)d_in[i];
    a.out = (float*)d_out; a.ws = (unsigned char*)d_ws;
#if MK_MULTI
    for (int ph = 0; ph < N_PHASES; ++ph) { a.ph_lo = ph; a.ph_hi = ph + 1; hipLaunchKernelGGL(mk_fwd, dim3(grid), dim3(512), LDS_BYTES, stream, a); }
#else
    a.ph_lo = 0; a.ph_hi = N_PHASES;
    void* kargs[] = {&a};
    hipError_t e = hipLaunchCooperativeKernel((const void*)mk_fwd, dim3(grid), dim3(512), kargs, LDS_BYTES, stream);
    if (e != hipSuccess) fprintf(stderr, "cooperative launch failed: %s (grid %d)\n", hipGetErrorString(e), grid);
#endif
}
```

```cpp
#include <hip/hip_runtime.h>
#include <hip/hip_cooperative_groups.h>
#include <cstdio>
#include <cstdint>
namespace cg = cooperative_groups;
#define MK_MULTI 0
namespace pg8 {
#define PG8_LAS __attribute__((address_space(3)))
typedef unsigned short bf16_t;
typedef short bf16x8 __attribute__((ext_vector_type(8)));
typedef float f32x4 __attribute__((ext_vector_type(4)));
typedef unsigned u32x4 __attribute__((ext_vector_type(4)));
constexpr int BM = 256, BK = 64, HALF = 128, HTB = HALF * BK * 2  , STAGE_BYTES = 8 * HTB, NXCD = 8, WGM = 8;

__host__ __device__ __forceinline__ int lds_byte(int r, int c) { const int st = (r >> 4) * 2 + (c >> 5), rr = r & 15, cc = c & 31, ob = rr * 64 + cc * 2; return st * 1024 + (ob ^ (((ob >> 9) & 1) << 5)); }
__host__ __device__ __forceinline__ void stage_rc(int b, int& R, int& C) { const int st = b / 1024, sb = b % 1024, swz = sb ^ (((sb >> 9) & 1) << 5); R = (st >> 1) * 16 + swz / 64; C = (st & 1) * 32 + (swz % 64) / 2; }
__host__ __device__ __forceinline__ int perm32(int rho) { const int n = rho >> 4, i = rho & 15; return 8 * (i >> 2) + 4 * n + (i & 3); }

struct Unit { int pm, pn; };
struct Gemm { const bf16_t* A; const bf16_t* Bt; int M, N, K, lda, ldb; };

struct StaticOrder {
    int nM, nN, nwg, G, c;
    __host__ __device__ void init(int M, int N, int G_, int c_) { nM = M / BM; nN = N / BM; nwg = nM * nN; G = G_; c = c_; }
    __host__ __device__ bool next(int i, Unit& u) const {
        const long L = (long)i * G + c; if (L >= nwg) return false;
        int wgid = (int)L; { const int q = nwg / NXCD, r = nwg % NXCD, xcd = wgid % NXCD, off = wgid / NXCD; wgid = (xcd < r ? xcd * (q + 1) : r * (q + 1) + (xcd - r) * q) + off; }
        const int nig = WGM * nN, gid = wgid / nig, fm = gid * WGM, gsz = (nM - fm) < WGM ? (nM - fm) : WGM;
        u.pm = fm + ((wgid % nig) % gsz); u.pn = (wgid % nig) / gsz; return true;
    }
    __device__ __forceinline__ void a_ready(const Unit&) const {}
    __device__ __forceinline__ void done(const Unit&) const {}
};

__device__ __forceinline__ unsigned cvt_pk_bf16(float lo, float hi) { unsigned r; asm volatile("v_cvt_pk_bf16_f32 %0, %1, %2" : "=v"(r) : "v"(lo), "v"(hi)); return r; }
typedef float f32x2 __attribute__((ext_vector_type(2)));
__device__ __forceinline__ f32x2 gelu_pk(f32x2 v) {
    const f32x2 av = __builtin_elementwise_abs(v), d = av * 0.2316418882f + 1.0f;
    f32x2 t; t.x = __builtin_amdgcn_rcpf(d.x); t.y = __builtin_amdgcn_rcpf(d.y);
    f32x2 q = t * 0.5307027145f + (-0.7265760135f); q = q * t + 0.7107068705f; q = q * t + (-0.142248368f); q = q * t + 0.127414796f; q = q * t;
    const f32x2 s = (v * v) * (-0.72134752044f);
    f32x2 e; e.x = __builtin_amdgcn_exp2f(s.x); e.y = __builtin_amdgcn_exp2f(s.y);
    const f32x2 m = v * (q * e), r = v - m;
    f32x2 o; o.x = v.x < 0.f ? m.x : r.x; o.y = v.y < 0.f ? m.y : r.y; return o;
}

template <int ACT  > struct EpiBf16 {
    static constexpr bool PERM = true, AFTER_DRAIN = false; static_assert(ACT == 0 || ACT == 1, "EpiBf16: ACT is 0 (none) or 1 (gelu_pk)");
    bf16_t* O; int ldc; const float* bias; int split_cols; size_t split_stride; float scale0;
    __device__ __forceinline__ void operator()(const f32x4 (&acc)[2][2][4][2], const Unit& u, int wr, int wc, int fr, int fq) const {
        const int row0 = u.pm * BM + wr * 64 + fr; int colt = u.pn * BM; bf16_t* base = O;
        float sc = 1.f; if (split_cols) { const int t = colt / split_cols; base += (size_t)t * split_stride; colt -= t * split_cols; if (t == 0) sc = scale0; }
        const int col0 = colt + wc * 32 + 8 * fq, bcol0 = u.pn * BM + wc * 32 + 8 * fq;
        f32x4 bv[2][2];
#pragma unroll
        for (int bj = 0; bj < 2; ++bj)
#pragma unroll
            for (int n = 0; n < 2; ++n) bv[bj][n] = bias ? *(const f32x4*)(bias + bcol0 + bj * HALF + 4 * n) : (f32x4){0.f, 0.f, 0.f, 0.f};
#pragma unroll
        for (int ai = 0; ai < 2; ++ai)
#pragma unroll
            for (int m = 0; m < 4; ++m) { bf16_t* rowp = base + (size_t)(row0 + ai * HALF + m * 16) * ldc + col0;
#pragma unroll
                for (int bj = 0; bj < 2; ++bj) { f32x4 v0 = acc[ai][bj][m][0] + bv[bj][0], v1 = acc[ai][bj][m][1] + bv[bj][1];
                    if (ACT == 1) { f32x2 a = gelu_pk((f32x2){v0[0], v0[1]}), b = gelu_pk((f32x2){v0[2], v0[3]}), c = gelu_pk((f32x2){v1[0], v1[1]}), d = gelu_pk((f32x2){v1[2], v1[3]});
                        v0 = (f32x4){a.x, a.y, b.x, b.y}; v1 = (f32x4){c.x, c.y, d.x, d.y}; }
                    v0 = v0 * sc; v1 = v1 * sc; u32x4 w; w.x = cvt_pk_bf16(v0[0], v0[1]); w.y = cvt_pk_bf16(v0[2], v0[3]); w.z = cvt_pk_bf16(v1[0], v1[1]); w.w = cvt_pk_bf16(v1[2], v1[3]);
                    *(u32x4*)(rowp + bj * HALF) = w; } }
    }
};
template <class Epi, class Sched, bool ALIGN_EPI = false, bool SP2 = false>
__device__ __forceinline__ void gemm_phase(PG8_LAS unsigned char* lds, const Gemm g, const Sched& S, const Epi& E) {
    const int tid = threadIdx.x, wid = __builtin_amdgcn_readfirstlane(tid >> 6), lane = tid & 63, wr = wid >> 2, wc = wid & 3, fr = lane & 15, fq = lane >> 4;
    const int K = g.K, nt = K / BK;
    unsigned voffA[2], voffB[2];
#pragma unroll
    for (int i = 0; i < 2; ++i) { int R, C; stage_rc(tid * 16 + i * 8192, R, C); const int Rb = Epi::PERM ? ((R & ~31) + perm32(R & 31)) : R;
        voffA[i] = (unsigned)(R * g.lda + C) * 2u; voffB[i] = (unsigned)(Rb * g.ldb + C) * 2u; }
    const size_t kstep = (size_t)(BK * 2);
    const size_t hstepA = (size_t)HALF * g.lda * 2, hstepB = (size_t)HALF * g.ldb * 2;
    const size_t tstepA = 2 * hstepA, tstepB = 2 * hstepB;
    const unsigned ldsw = (unsigned)wid * 1024u;
    const int aoff = lds_byte(wr * 64 + fr, fq * 8), boff = lds_byte(wc * 32 + fr, fq * 8);
#define PG8_SA(b, h) (((b) * 2 + (h)) * HTB)
#define PG8_SB(b, h) ((4 + (b) * 2 + (h)) * HTB)
#define PG8_STAGE(bufoff, gbase, voff) do { _Pragma("unroll") for (int _i = 0; _i < 2; ++_i) \
        __builtin_amdgcn_global_load_lds((const unsigned*)((const char*)(gbase) + (voff)[_i]), (PG8_LAS unsigned*)(lds + (bufoff) + ldsw + _i * 8192), 16, 0, 0); } while (0)
#define PG8_LDA(dst, b, h) do { _Pragma("unroll") for (int m = 0; m < 4; ++m) _Pragma("unroll") for (int k = 0; k < 2; ++k) dst[m][k] = *(const PG8_LAS bf16x8*)(lds + PG8_SA(b, h) + aoff + m * 2048 + k * 1024); } while (0)
#define PG8_LDB(dst, b, h) do { _Pragma("unroll") for (int n = 0; n < 2; ++n) _Pragma("unroll") for (int k = 0; k < 2; ++k) dst[n][k] = *(const PG8_LAS bf16x8*)(lds + PG8_SB(b, h) + boff + n * 2048 + k * 1024); } while (0)
#define PG8_MMA(ai, bj, At, Bt) do { __builtin_amdgcn_s_setprio(1); _Pragma("unroll") for (int m = 0; m < 4; ++m) _Pragma("unroll") for (int n = 0; n < 2; ++n) _Pragma("unroll") for (int k = 0; k < 2; ++k) \
        acc[ai][bj][m][n] = __builtin_amdgcn_mfma_f32_16x16x32_bf16(Bt[n][k], At[m][k], acc[ai][bj][m][n], 0, 0, 0); __builtin_amdgcn_s_setprio(0); } while (0)
#define PG8_WAIT_V(n) asm volatile("s_waitcnt vmcnt(" #n ")" ::: "memory")
#define PG8_WAIT_L(n) asm volatile("s_waitcnt lgkmcnt(" #n ")" ::: "memory")
#define PG8_BAR __builtin_amdgcn_s_barrier()
#define PG8_SCHED __builtin_amdgcn_sched_barrier(0)
    Unit cur, nxt; int ui = 0;
    if (!S.next(0, cur)) return;
    f32x4 acc[2][2][4][2];
#pragma unroll
    for (int a = 0; a < 2; ++a)
#pragma unroll
        for (int b = 0; b < 2; ++b)
#pragma unroll
            for (int m = 0; m < 4; ++m)
#pragma unroll
                for (int n = 0; n < 2; ++n) acc[a][b][m][n] = (f32x4){0.f, 0.f, 0.f, 0.f};
    bf16x8 At[4][2], B0[2][2], B1[2][2];
    const char* cA = (const char*)g.A + (size_t)cur.pm * tstepA; const char* cB = (const char*)g.Bt + (size_t)cur.pn * tstepB;
    S.a_ready(cur);
    if constexpr (SP2) {
        PG8_STAGE(PG8_SB(0, 0), cB, voffB); PG8_STAGE(PG8_SB(0, 1), cB + hstepB, voffB); PG8_STAGE(PG8_SA(0, 0), cA, voffA); PG8_STAGE(PG8_SA(0, 1), cA + hstepA, voffA);
        if (wr == 1) PG8_BAR;
        PG8_WAIT_V(2); PG8_BAR;
        PG8_STAGE(PG8_SB(1, 0), cB + kstep, voffB); PG8_STAGE(PG8_SA(1, 0), cA + kstep, voffA); PG8_STAGE(PG8_SB(1, 1), cB + hstepB + kstep, voffB);
        PG8_WAIT_V(6); PG8_BAR;
    } else {
        PG8_STAGE(PG8_SB(0, 0), cB, voffB); PG8_STAGE(PG8_SA(0, 0), cA, voffA); PG8_STAGE(PG8_SB(0, 1), cB + hstepB, voffB); PG8_STAGE(PG8_SA(0, 1), cA + hstepA, voffA);
        if (wr == 1) PG8_BAR;
        PG8_WAIT_V(4); PG8_BAR;
        PG8_STAGE(PG8_SB(1, 0), cB + kstep, voffB); PG8_STAGE(PG8_SA(1, 0), cA + kstep, voffA); PG8_STAGE(PG8_SB(1, 1), cB + hstepB + kstep, voffB);
        PG8_WAIT_V(6); PG8_BAR;
    }
    for (;;) {
        const bool has_next = S.next(ui + 1, nxt);
        const char* nA = has_next ? (const char*)g.A + (size_t)nxt.pm * tstepA : cA; const char* nB = has_next ? (const char*)g.Bt + (size_t)nxt.pn * tstepB : cB;
        for (int t = 0; t < nt; t += 2) {
            const bool last = (t == nt - 2);
            const char* a1 = cA + (size_t)(t + 1) * kstep;
            const char* a2 = last ? nA : cA + (size_t)(t + 2) * kstep; const char* b2 = last ? nB : cB + (size_t)(t + 2) * kstep;
            const char* a3 = a2 + kstep; const char* b3 = b2 + kstep;
            if (last && has_next) S.a_ready(nxt);
            if constexpr (SP2) {
            PG8_LDB(B0, 0, 0); PG8_LDB(B1, 0, 1); PG8_SCHED; PG8_LDA(At, 0, 0); PG8_STAGE(PG8_SA(1, 1), a1 + hstepA, voffA);
            PG8_WAIT_V(8); PG8_WAIT_L(0); PG8_BAR; PG8_MMA(0, 0, At, B0); PG8_MMA(0, 1, At, B1); PG8_BAR; PG8_SCHED;
            PG8_LDA(At, 0, 1); PG8_STAGE(PG8_SB(0, 0), b2, voffB); PG8_STAGE(PG8_SB(0, 1), b2 + hstepB, voffB); PG8_STAGE(PG8_SA(0, 0), a2, voffA);
            PG8_WAIT_V(8); PG8_WAIT_L(0); PG8_BAR; PG8_MMA(1, 0, At, B0); PG8_MMA(1, 1, At, B1); PG8_BAR; PG8_SCHED;
            PG8_LDB(B0, 1, 0); PG8_LDB(B1, 1, 1); PG8_SCHED; PG8_LDA(At, 1, 0); PG8_STAGE(PG8_SA(0, 1), a2 + hstepA, voffA);
            PG8_WAIT_V(8); PG8_WAIT_L(0); PG8_BAR; PG8_MMA(0, 0, At, B0); PG8_MMA(0, 1, At, B1); PG8_BAR; PG8_SCHED;
            PG8_LDA(At, 1, 1); PG8_STAGE(PG8_SB(1, 0), b3, voffB); PG8_STAGE(PG8_SB(1, 1), b3 + hstepB, voffB); PG8_STAGE(PG8_SA(1, 0), a3, voffA);
            PG8_WAIT_V(8); PG8_WAIT_L(0); PG8_BAR; PG8_MMA(1, 0, At, B0); PG8_MMA(1, 1, At, B1); PG8_BAR; PG8_SCHED;
            } else {
            PG8_LDB(B0, 0, 0); PG8_SCHED; PG8_LDA(At, 0, 0); PG8_STAGE(PG8_SA(1, 1), a1 + hstepA, voffA);
            PG8_WAIT_L(8); PG8_BAR; PG8_WAIT_L(0); PG8_MMA(0, 0, At, B0); PG8_BAR; PG8_SCHED;
            PG8_LDB(B1, 0, 1); PG8_STAGE(PG8_SB(0, 0), b2, voffB);
            PG8_BAR; PG8_WAIT_L(0); PG8_MMA(0, 1, At, B1); PG8_BAR;
            PG8_LDA(At, 0, 1); PG8_STAGE(PG8_SA(0, 0), a2, voffA);
            PG8_BAR; PG8_WAIT_L(0); PG8_MMA(1, 0, At, B0); PG8_BAR; PG8_SCHED;
            PG8_STAGE(PG8_SB(0, 1), b2 + hstepB, voffB);
            PG8_WAIT_V(6); PG8_BAR; PG8_MMA(1, 1, At, B1); PG8_BAR;
            PG8_LDB(B0, 1, 0); PG8_SCHED; PG8_LDA(At, 1, 0); PG8_STAGE(PG8_SA(0, 1), a2 + hstepA, voffA);
            PG8_WAIT_L(8); PG8_BAR; PG8_WAIT_L(0); PG8_MMA(0, 0, At, B0); PG8_BAR; PG8_SCHED;
            PG8_LDB(B1, 1, 1); PG8_STAGE(PG8_SB(1, 0), b3, voffB);
            PG8_BAR; PG8_WAIT_L(0); PG8_MMA(0, 1, At, B1); PG8_BAR;
            PG8_LDA(At, 1, 1); PG8_STAGE(PG8_SA(1, 0), a3, voffA);
            PG8_BAR; PG8_WAIT_L(0); PG8_MMA(1, 0, At, B0); PG8_BAR; PG8_SCHED;
            PG8_STAGE(PG8_SB(1, 1), b3 + hstepB, voffB);
            PG8_WAIT_V(6); PG8_BAR; PG8_MMA(1, 1, At, B1); PG8_BAR;
            }
        }
        if constexpr (ALIGN_EPI) { if (wr == 0) PG8_BAR; }
        if constexpr (!Epi::AFTER_DRAIN) { E(acc, cur, wr, wc, fr, fq); S.done(cur); }
        if (!has_next) break;
#pragma unroll
        for (int a = 0; a < 2; ++a)
#pragma unroll
            for (int b = 0; b < 2; ++b)
#pragma unroll
                for (int m = 0; m < 4; ++m)
#pragma unroll
                    for (int n = 0; n < 2; ++n) acc[a][b][m][n] = (f32x4){0.f, 0.f, 0.f, 0.f};
        cur = nxt; cA = nA; cB = nB; ++ui;
        if constexpr (ALIGN_EPI) { if (wr == 1) PG8_BAR; }
    }
    PG8_WAIT_V(0);
    if constexpr (!ALIGN_EPI) { if (wr == 0) PG8_BAR; }
    PG8_BAR;
    if constexpr (Epi::AFTER_DRAIN) { E.fused(acc, cur, wr, wc, fr, fq, lds, wid, lane); S.done(cur); }
#undef PG8_SA
#undef PG8_SB
#undef PG8_STAGE
#undef PG8_LDA
#undef PG8_LDB
#undef PG8_MMA
#undef PG8_WAIT_V
#undef PG8_WAIT_L
#undef PG8_BAR
#undef PG8_SCHED
}
}

#define GAS __attribute__((address_space(1)))
#define LAS __attribute__((address_space(3)))
typedef unsigned short bf16;
typedef unsigned v4u __attribute__((ext_vector_type(4)));
typedef unsigned v2u __attribute__((ext_vector_type(2)));
typedef float f32x4 __attribute__((ext_vector_type(4)));

#ifndef MK_MULTI
#define MK_MULTI 0
#endif

constexpr int BATCH = 8, SEQ = 2048, DM = 1024, M = BATCH * SEQ;
constexpr int NH = 8, HD = 64, AW = 512, SWD = 512, NG = 32, HC = 16, PS = 64, INW = 1280, FF = 2816;
constexpr float EPS = 1e-6f;
constexpr size_t MiB = 1u << 20;
constexpr size_t WS_WT1 = 2 * MiB, WS_WD1 = 14 * MiB, WS_WT2 = 20 * MiB, WS_WD2 = 32 * MiB, WS_WIN = 38 * MiB, WS_WOUT = 41 * MiB, WS_WGLU = 43 * MiB;
constexpr size_t WS_MATS = 44 * MiB;
constexpr size_t WS_XA = 64 * MiB;
constexpr size_t WS_H = 96 * MiB;
constexpr size_t WS_S = 96 * MiB;
constexpr size_t WS_SST = 96 * MiB;
constexpr size_t WS_MIX = 112 * MiB;
constexpr size_t WS_MATY = 144 * MiB;
constexpr size_t WS_UA = 168 * MiB;
constexpr size_t WS_QKV = 192 * MiB;
constexpr size_t WS_ATT = 216 * MiB;
constexpr size_t WS_YG = 232 * MiB;
constexpr size_t WS_END = 256 * MiB;
constexpr int TC = 32, NC = SEQ / TC, KY = 16 * TC + 256, KS = 16 * TC;
constexpr int LDS_BYTES = 147456;

__device__ __forceinline__ unsigned f2bf(float f) { unsigned u = __builtin_bit_cast(unsigned, f); return (u + 0x7fffu + ((u >> 16) & 1u)) >> 16; }
__device__ __forceinline__ unsigned pk2(float lo, float hi) { return f2bf(lo) | (f2bf(hi) << 16); }
__device__ __forceinline__ float bflo(unsigned w) { return __builtin_bit_cast(float, w << 16); }
__device__ __forceinline__ float bfhi(unsigned w) { return __builtin_bit_cast(float, w & 0xffff0000u); }
#define LDS_WAIT() asm volatile("s_waitcnt lgkmcnt(0)" ::: "memory")
__device__ __forceinline__ float wave_sum(float v) {
#pragma unroll
    for (int o = 1; o < 64; o <<= 1) v += __shfl_xor(v, o);
    return v;
}
__device__ __forceinline__ float sigmoidf_(float x) { return __builtin_amdgcn_rcpf(1.f + __expf(-x)); }

namespace pg8 {
struct EpiSwiglu {
    static constexpr bool PERM = true, AFTER_DRAIN = false;
    bf16_t* H; int ldh;
    __device__ __forceinline__ void operator()(const f32x4 (&acc)[2][2][4][2], const Unit& u, int wr, int wc, int fr, int fq) const {
        const int row0 = u.pm * BM + wr * 64 + fr, col0 = u.pn * HALF + wc * 32 + 8 * fq;
#pragma unroll
        for (int ai = 0; ai < 2; ++ai)
#pragma unroll
            for (int m = 0; m < 4; ++m) {
                bf16_t* rowp = H + (size_t)(row0 + ai * HALF + m * 16) * ldh + col0;
                float hv[8];
#pragma unroll
                for (int n = 0; n < 2; ++n)
#pragma unroll
                    for (int i = 0; i < 4; ++i) { const float g = acc[ai][0][m][n][i], up = acc[ai][1][m][n][i]; hv[n * 4 + i] = g * __builtin_amdgcn_rcpf(1.f + __expf(-g)) * up; }
                u32x4 w; w.x = cvt_pk_bf16(hv[0], hv[1]); w.y = cvt_pk_bf16(hv[2], hv[3]); w.z = cvt_pk_bf16(hv[4], hv[5]); w.w = cvt_pk_bf16(hv[6], hv[7]);
                *(u32x4*)rowp = w;
            }
    }
};
struct EpiResid {
    static constexpr bool PERM = false, AFTER_DRAIN = false;
    const float* base; float* out; float alpha;
    __device__ __forceinline__ void operator()(const f32x4 (&acc)[2][2][4][2], const Unit& u, int wr, int wc, int fr, int fq) const {
        const int col0 = u.pn * BM + wc * 32 + 4 * fq;
#pragma unroll
        for (int ai = 0; ai < 2; ++ai)
#pragma unroll
            for (int m = 0; m < 4; ++m) {
                const size_t off = (size_t)(u.pm * BM + ai * HALF + wr * 64 + m * 16 + fr) * 1024 + col0;
#pragma unroll
                for (int bj = 0; bj < 2; ++bj)
#pragma unroll
                    for (int n = 0; n < 2; ++n) { const f32x4 b = *(const f32x4*)(base + off + bj * HALF + n * 16); *(f32x4*)(out + off + bj * HALF + n * 16) = b + acc[ai][bj][m][n] * alpha; }
            }
    }
};
struct EpiGlu {
    static constexpr bool PERM = true, AFTER_DRAIN = false;
    const bf16_t* Y; bf16_t* S; const float* bias;
    __device__ __forceinline__ void operator()(const f32x4 (&acc)[2][2][4][2], const Unit& u, int wr, int wc, int fr, int fq) const {
        const int row0 = u.pm * BM + wr * 64 + fr, col0 = u.pn * BM + wc * 32 + 8 * fq;
#pragma unroll
        for (int bj = 0; bj < 2; ++bj) {
            const f32x4 b0 = *(const f32x4*)(bias + col0 + bj * HALF), b1 = *(const f32x4*)(bias + col0 + bj * HALF + 4);
#pragma unroll
            for (int ai = 0; ai < 2; ++ai)
#pragma unroll
                for (int m = 0; m < 4; ++m) {
                    const size_t off = (size_t)(row0 + ai * HALF + m * 16) * 512 + col0 + bj * HALF;
                    const u32x4 yv = *(const u32x4*)(Y + off);
                    const f32x4 v0 = acc[ai][bj][m][0] + b0, v1 = acc[ai][bj][m][1] + b1;
                    float o[8];
                    o[0] = bflo(yv.x) * sigmoidf_(v0[0]); o[1] = bfhi(yv.x) * sigmoidf_(v0[1]); o[2] = bflo(yv.y) * sigmoidf_(v0[2]); o[3] = bfhi(yv.y) * sigmoidf_(v0[3]);
                    o[4] = bflo(yv.z) * sigmoidf_(v1[0]); o[5] = bfhi(yv.z) * sigmoidf_(v1[1]); o[6] = bflo(yv.w) * sigmoidf_(v1[2]); o[7] = bfhi(yv.w) * sigmoidf_(v1[3]);
                    u32x4 w; w.x = cvt_pk_bf16(o[0], o[1]); w.y = cvt_pk_bf16(o[2], o[3]); w.z = cvt_pk_bf16(o[4], o[5]); w.w = cvt_pk_bf16(o[6], o[7]);
                    *(u32x4*)(S + off) = w;
                }
        }
    }
};
}

template <int MODE>
__device__ __forceinline__ void p0_transpose_item(const float* W, int K, int N, bf16* WT, LAS float* scr, int item, int lane) {
    const int nblk = N / 32, kb = item / nblk, nb = item % nblk, k0 = 64 * kb, n0 = 32 * nb;
#pragma unroll 8
    for (int i = 0; i < 32; ++i) { const int kk = 2 * i + (lane >> 5); scr[kk * 33 + (lane & 31)] = W[(size_t)(k0 + kk) * N + n0 + (lane & 31)]; }
    LDS_WAIT(); asm volatile("" ::: "memory");
    const int c = lane & 7;
    const int r0 = MODE == 0 ? n0 : ((n0 >> 7) * 256 + (n0 & 127) + (MODE == 2 ? 128 : 0));
#pragma unroll
    for (int j = 0; j < 4; ++j) { const int n = (lane >> 3) + 8 * j; const LAS float* s = scr + (8 * c) * 33 + n;
        v4u o; o.x = pk2(s[0 * 33], s[1 * 33]); o.y = pk2(s[2 * 33], s[3 * 33]); o.z = pk2(s[4 * 33], s[5 * 33]); o.w = pk2(s[6 * 33], s[7 * 33]);
        *(v4u*)(WT + (size_t)(r0 + n) * K + k0 + 8 * c) = o; }
    LDS_WAIT(); asm volatile("" ::: "memory");
}

__device__ __forceinline__ void rms_row_to_bf16(const float* xrow, const float* gain, bf16* orow, int lane) {
    const f32x4* xr = (const f32x4*)xrow + lane; const f32x4* gr = (const f32x4*)gain + lane;
    f32x4 v[4]; float s = 0.f;
#pragma unroll
    for (int j = 0; j < 4; ++j) { v[j] = xr[64 * j]; s += (v[j].x * v[j].x + v[j].y * v[j].y) + (v[j].z * v[j].z + v[j].w * v[j].w); }
    const float rstd = 1.f / sqrtf(wave_sum(s) * (1.f / DM) + EPS);
    unsigned long long* o8 = (unsigned long long*)orow + lane;
#pragma unroll
    for (int j = 0; j < 4; ++j) { const f32x4 g = gr[64 * j];
        o8[64 * j] = (unsigned long long)pk2(v[j].x * rstd * g.x, v[j].y * rstd * g.y) | ((unsigned long long)pk2(v[j].z * rstd * g.z, v[j].w * rstd * g.w) << 32); }
}
__device__ __forceinline__ void rms_row_f32(float* xrow, const float* gain, int lane) {
    f32x4* xr = (f32x4*)xrow + lane; const f32x4* gr = (const f32x4*)gain + lane;
    f32x4 v[4]; float s = 0.f;
#pragma unroll
    for (int j = 0; j < 4; ++j) { v[j] = xr[64 * j]; s += (v[j].x * v[j].x + v[j].y * v[j].y) + (v[j].z * v[j].z + v[j].w * v[j].w); }
    const float rstd = 1.f / sqrtf(wave_sum(s) * (1.f / DM) + EPS);
#pragma unroll
    for (int j = 0; j < 4; ++j) { const f32x4 g = gr[64 * j]; xr[64 * j] = v[j] * rstd * g; }
}
__device__ __forceinline__ void mix_row(const bf16* arow, const bf16* srow, const float* ga, const float* gs, bf16* orow, int lane) {
    const v4u a = *((const v4u*)arow + lane), s = *((const v4u*)srow + lane);
    float av[8] = {bflo(a.x), bfhi(a.x), bflo(a.y), bfhi(a.y), bflo(a.z), bfhi(a.z), bflo(a.w), bfhi(a.w)};
    float sv[8] = {bflo(s.x), bfhi(s.x), bflo(s.y), bfhi(s.y), bflo(s.z), bfhi(s.z), bflo(s.w), bfhi(s.w)};
    float sa = 0.f, ss = 0.f;
#pragma unroll
    for (int i = 0; i < 8; ++i) { sa += av[i] * av[i]; ss += sv[i] * sv[i]; }
    const float ra = 1.f / sqrtf(wave_sum(sa) * (1.f / 512.f) + EPS), rs = 1.f / sqrtf(wave_sum(ss) * (1.f / 512.f) + EPS);
    const f32x4 ga0 = *((const f32x4*)ga + 2 * lane), ga1 = *((const f32x4*)ga + 2 * lane + 1), gs0 = *((const f32x4*)gs + 2 * lane), gs1 = *((const f32x4*)gs + 2 * lane + 1);
    v4u oa, os;
    oa.x = pk2(av[0] * ra * ga0.x, av[1] * ra * ga0.y); oa.y = pk2(av[2] * ra * ga0.z, av[3] * ra * ga0.w); oa.z = pk2(av[4] * ra * ga1.x, av[5] * ra * ga1.y); oa.w = pk2(av[6] * ra * ga1.z, av[7] * ra * ga1.w);
    os.x = pk2(sv[0] * rs * gs0.x, sv[1] * rs * gs0.y); os.y = pk2(sv[2] * rs * gs0.z, sv[3] * rs * gs0.w); os.z = pk2(sv[4] * rs * gs1.x, sv[5] * rs * gs1.y); os.w = pk2(sv[6] * rs * gs1.z, sv[7] * rs * gs1.w);
    *((v4u*)orow + lane) = oa; *((v4u*)(orow + 512) + lane) = os;
}

typedef float f32x16 __attribute__((ext_vector_type(16)));
typedef short bf16x8 __attribute__((ext_vector_type(8)));
typedef __bf16 bf16x2_t __attribute__((ext_vector_type(2)));
typedef float f32x2_t __attribute__((ext_vector_type(2)));
__device__ __forceinline__ unsigned cvtpk(float lo, float hi) { f32x2_t v = {lo, hi}; bf16x2_t b = __builtin_convertvector(v, bf16x2_t); return __builtin_bit_cast(unsigned, b); }
__device__ __forceinline__ void attn_mfma(LAS unsigned char* lds, const bf16* QKV  , bf16* ATT, const float* sinks, int G, int bid) {
    constexpr int KSTR = 144, VSTR = 784, VT_OFF = 384 * KSTR;
    constexpr float LOG2E = 1.4426950408889634f, K1 = 0.125f * LOG2E;
    const int tid = threadIdx.x, lane = tid & 63, w = tid >> 6, r = lane & 31, hi = lane >> 5;
    for (int unit = bid; unit < 256; unit += G) {
        const int kh = unit & 1, qb = (unit >> 1) & 15, b = unit >> 5, kp0 = qb * 128 - 128;
        __syncthreads();
        for (int c = tid; c < 3072; c += 512) { const int rr = c >> 3, ch = c & 7, kp = kp0 + rr; v4u kv = (v4u){0u, 0u, 0u, 0u}, vv = kv;
            if (kp >= 0 && kp < SEQ) { const bf16* src = QKV + (size_t)(b * SEQ + kp) * 768; kv = *(const v4u*)(src + 512 + kh * 64 + ch * 8); vv = *(const v4u*)(src + 640 + kh * 64 + ch * 8); }
            *(LAS v4u*)(lds + rr * KSTR + ch * 16) = kv;
            const int pos = (rr & ~15) | (((rr >> 2) & 1) << 3) | (((rr >> 3) & 1) << 2) | (rr & 3);
            LAS unsigned short* vt = (LAS unsigned short*)(lds + VT_OFF + (ch * 8) * VSTR + pos * 2);
            vt[0 * (VSTR / 2)] = (unsigned short)(vv.x & 0xffffu); vt[1 * (VSTR / 2)] = (unsigned short)(vv.x >> 16); vt[2 * (VSTR / 2)] = (unsigned short)(vv.y & 0xffffu); vt[3 * (VSTR / 2)] = (unsigned short)(vv.y >> 16);
            vt[4 * (VSTR / 2)] = (unsigned short)(vv.z & 0xffffu); vt[5 * (VSTR / 2)] = (unsigned short)(vv.z >> 16); vt[6 * (VSTR / 2)] = (unsigned short)(vv.w & 0xffffu); vt[7 * (VSTR / 2)] = (unsigned short)(vv.w >> 16); }
        __syncthreads();
        const int h = kh * 4 + (w >> 1);
        const float slope2 = exp2f(-(float)(h + 1)) * LOG2E, sink2 = sinks[h] * LOG2E;
        const bool qedge = (qb == 0) || (qb == 15);
        for (int qi2 = 0; qi2 < 2; ++qi2) {
            const int q0 = ((w & 1) * 2 + qi2) * 32, t = qb * 128 + q0 + r;
            bf16x8 qf[4];
            { const bf16* qp = QKV + (size_t)(b * SEQ + t) * 768 + h * 64 + hi * 8;
#pragma unroll
              for (int ks = 0; ks < 4; ++ks) qf[ks] = *(const bf16x8*)(qp + ks * 16); }
            float m2 = sink2, l = 0.f;
            f32x16 o0, o1;
#pragma unroll
            for (int i = 0; i < 16; ++i) { o0[i] = 0.f; o1[i] = 0.f; }
            for (int kb = 0; kb < 9; ++kb) {
                const int jj0 = q0 + kb * 32;
                f32x16 s;
#pragma unroll
                for (int i = 0; i < 16; ++i) s[i] = 0.f;
#pragma unroll
                for (int ks = 0; ks < 4; ++ks) { const bf16x8 kf = *(const LAS bf16x8*)(lds + (jj0 + r) * KSTR + ks * 32 + hi * 16); s = __builtin_amdgcn_mfma_f32_32x32x16_bf16(kf, qf[ks], s, 0, 0, 0); }
                const float relbf = (float)(kb * 32 - 128 - r + 4 * hi);
#pragma unroll
                for (int i = 0; i < 16; ++i) { const float ci = (float)((i & 3) + 8 * (i >> 2)); s[i] = s[i] * K1 - slope2 * fabsf(relbf + ci); }
                if (kb == 0 || kb == 8 || qedge) {
                    const float kpf = (float)(kp0 + jj0 + 4 * hi);
#pragma unroll
                    for (int i = 0; i < 16; ++i) { const float ci = (float)((i & 3) + 8 * (i >> 2)); const bool valid = (fabsf(relbf + ci) <= 128.f) && (kpf + ci >= 0.f) && (kpf + ci < (float)SEQ); s[i] = valid ? s[i] : -1e30f; }
                }
                float bm = s[0];
#pragma unroll
                for (int i = 1; i < 16; ++i) bm = fmaxf(bm, s[i]);
                bm = fmaxf(bm, __shfl_xor(bm, 32));
                const float mn = fmaxf(m2, bm), corr = __builtin_amdgcn_exp2f(m2 - mn);
                m2 = mn;
                float ps = 0.f;
#pragma unroll
                for (int i = 0; i < 16; ++i) { s[i] = __builtin_amdgcn_exp2f(s[i] - mn); ps += s[i]; }
                l = l * corr + ps;
#pragma unroll
                for (int i = 0; i < 16; ++i) { o0[i] *= corr; o1[i] *= corr; }
#pragma unroll
                for (int st = 0; st < 2; ++st) {
                    v4u pw; pw.x = cvtpk(s[8 * st + 0], s[8 * st + 1]); pw.y = cvtpk(s[8 * st + 2], s[8 * st + 3]); pw.z = cvtpk(s[8 * st + 4], s[8 * st + 5]); pw.w = cvtpk(s[8 * st + 6], s[8 * st + 7]);
                    const bf16x8 pf = __builtin_bit_cast(bf16x8, pw);
                    const bf16x8 v0 = *(const LAS bf16x8*)(lds + VT_OFF + r * VSTR + (jj0 + 16 * st + 8 * hi) * 2);
                    const bf16x8 v1 = *(const LAS bf16x8*)(lds + VT_OFF + (32 + r) * VSTR + (jj0 + 16 * st + 8 * hi) * 2);
                    o0 = __builtin_amdgcn_mfma_f32_32x32x16_bf16(v0, pf, o0, 0, 0, 0);
                    o1 = __builtin_amdgcn_mfma_f32_32x32x16_bf16(v1, pf, o1, 0, 0, 0);
                }
            }
            const float ltot = l + __shfl_xor(l, 32) + __builtin_amdgcn_exp2f(sink2 - m2), inv = 1.f / ltot;
            bf16* op = ATT + (size_t)(b * SEQ + t) * AW + h * 64 + 4 * hi;
#pragma unroll
            for (int gq = 0; gq < 4; ++gq) {
                v2u a; a.x = cvtpk(o0[4 * gq] * inv, o0[4 * gq + 1] * inv); a.y = cvtpk(o0[4 * gq + 2] * inv, o0[4 * gq + 3] * inv); *(v2u*)(op + 8 * gq) = a;
                v2u c; c.x = cvtpk(o1[4 * gq] * inv, o1[4 * gq + 1] * inv); c.y = cvtpk(o1[4 * gq + 2] * inv, o1[4 * gq + 3] * inv); *(v2u*)(op + 32 + 8 * gq) = c; }
        }
    }
}

struct SsmP { const float *lam_re, *lam_im, *log_dt, *b_re, *b_im, *c_re, *c_im, *dskip; };
__device__ __forceinline__ float gelu_tanh(float x) { const float z = 1.5957691216f * (x + 0.044715f * x * x * x); return x * __builtin_amdgcn_rcpf(1.f + __expf(-z)); }
__device__ __forceinline__ void lam_of(const SsmP& P, int dg, int p, float& lrdt, float& lidt, float& cr, float& ci) {
    const float lr = fminf(P.lam_re[dg * PS + p], -1e-4f), li = P.lam_im[dg * PS + p], dt = expf(P.log_dt[dg]);
    lrdt = lr * dt; lidt = li * dt;
    const float mag = expf(lrdt), ar = mag * cosf(lidt), ai = mag * sinf(lidt), den = lr * lr + li * li;
    cr = ((ar - 1.f) * lr + ai * li) / den; ci = (ai * lr - (ar - 1.f) * li) / den;
}
__device__ __forceinline__ void apow(float lrdt, float lidt, float k, float& pr, float& pi) { const float m = expf(lrdt * k), a = lidt * k; pr = m * cosf(a); pi = m * sinf(a); }

__device__ __forceinline__ void gen_states_item(const SsmP& P, bf16* MATS, int it, int lane) {
    const int p = it & 63, dir = (it >> 6) & 1, g = it >> 7, dg = dir * NG + g, s = lane >> 1, hh = lane & 1;
    float lrdt, lidt, cr, ci, pr, pi; lam_of(P, dg, p, lrdt, lidt, cr, ci); apow(lrdt, lidt, (float)(dir ? s : TC - 1 - s), pr, pi);
    const float wr = pr * cr - pi * ci, wi = pr * ci + pi * cr;
    const float* brp = P.b_re + (size_t)(dg * PS + p) * HC + hh * 8; const float* bip = P.b_im + (size_t)(dg * PS + p) * HC + hh * 8;
    const f32x4 br0 = *(const f32x4*)brp, br1 = *(const f32x4*)(brp + 4), bi0 = *(const f32x4*)bip, bi1 = *(const f32x4*)(bip + 4);
    const f32x4 re0 = br0 * wr - bi0 * wi, re1 = br1 * wr - bi1 * wi, im0 = bi0 * wr + br0 * wi, im1 = bi1 * wr + br1 * wi;
    v4u o; bf16* dst = MATS + (size_t)(g * 256 + dir * 128 + p) * KS + s * 16 + hh * 8;
    o.x = pk2(re0.x, re0.y); o.y = pk2(re0.z, re0.w); o.z = pk2(re1.x, re1.y); o.w = pk2(re1.z, re1.w); *(v4u*)dst = o;
    o.x = pk2(im0.x, im0.y); o.y = pk2(im0.z, im0.w); o.z = pk2(im1.x, im1.y); o.w = pk2(im1.z, im1.w); *(v4u*)(dst + (size_t)64 * KS) = o;
}
__device__ __forceinline__ void gen_carry_item(const SsmP& P, bf16* MATY, int it, int lane) {
    const int tau = it & 31, dir = (it >> 5) & 1, g = it >> 6, dg = dir * NG + g;
    float lrdt, lidt, cr, ci, pr, pi; lam_of(P, dg, lane, lrdt, lidt, cr, ci); apow(lrdt, lidt, (float)(dir ? TC - tau : tau + 1), pr, pi);
#pragma unroll
    for (int h = 0; h < HC; ++h) { const float c_r = P.c_re[(size_t)(dg * HC + h) * PS + lane], c_i = P.c_im[(size_t)(dg * HC + h) * PS + lane];
        bf16* dst = MATY + (size_t)(g * 512 + tau * 16 + h) * KY + 512 + dir * 128 + lane;
        dst[0] = (bf16)f2bf(c_r * pr - c_i * pi); dst[64] = (bf16)f2bf(-(c_r * pi + c_i * pr)); }
}
__device__ __forceinline__ void gen_toep_item(const SsmP& P, bf16* MATY, LAS float* scr, int it, int lane) {
    const int g = it / 63, dl = it % 63 - 31, k = dl < 0 ? -dl : dl;
    LAS float* Wr = scr; LAS float* Wi = scr + 64; LAS float* Cr = scr + 128; LAS float* Ci = Cr + 16 * 65; LAS float* Br = Ci + 16 * 65; LAS float* Bi = Br + 1024;
    const int h = lane >> 2, q = lane & 3;
    float val[4] = {0.f, 0.f, 0.f, 0.f};
    for (int dir = 0; dir < 2; ++dir) {
        if ((dl > 0 && dir == 1) || (dl < 0 && dir == 0)) continue;
        const int dg = dir * NG + g;
        float lrdt, lidt, cr, ci, pr, pi; lam_of(P, dg, lane, lrdt, lidt, cr, ci); apow(lrdt, lidt, (float)k, pr, pi);
        Wr[lane] = pr * cr - pi * ci; Wi[lane] = pr * ci + pi * cr;
#pragma unroll
        for (int i = 0; i < 16; ++i) { Cr[i * 65 + lane] = P.c_re[(size_t)(dg * HC + i) * PS + lane]; Ci[i * 65 + lane] = P.c_im[(size_t)(dg * HC + i) * PS + lane];
            Br[i * 64 + lane] = P.b_re[(size_t)dg * 1024 + i * 64 + lane]; Bi[i * 64 + lane] = P.b_im[(size_t)dg * 1024 + i * 64 + lane]; }
        LDS_WAIT(); asm volatile("" ::: "memory");
        for (int p = 0; p < 64; ++p) { const float wr = Wr[p], wi = Wi[p], c_r = Cr[h * 65 + p], c_i = Ci[h * 65 + p], tr = c_r * wr - c_i * wi, ti = c_r * wi + c_i * wr;
            const f32x4 b_r = *(const LAS f32x4*)(Br + p * 16 + 4 * q), b_i = *(const LAS f32x4*)(Bi + p * 16 + 4 * q);
            val[0] += tr * b_r.x - ti * b_i.x; val[1] += tr * b_r.y - ti * b_i.y; val[2] += tr * b_r.z - ti * b_i.z; val[3] += tr * b_r.w - ti * b_i.w; }
        LDS_WAIT(); asm volatile("" ::: "memory");
    }
    if (dl == 0) { const float dsk = P.dskip[g * HC + h];
#pragma unroll
        for (int j = 0; j < 4; ++j) if (4 * q + j == h) val[j] += dsk; }
    v2u o; o.x = pk2(val[0], val[1]); o.y = pk2(val[2], val[3]);
    const int t_lo = dl > 0 ? dl : 0, t_hi = dl < 0 ? TC - 1 + dl : TC - 1;
    for (int tau = t_lo; tau <= t_hi; ++tau) { const int s = tau - dl; *(v2u*)(MATY + (size_t)(g * 512 + tau * 16 + h) * KY + s * 16 + 4 * q) = o; }
}

namespace pg8 {
struct GroupOrder {
    int rm, rn, nwg, G, c;
    __device__ void init(int ng, int rm_, int rn_, int G_, int c_) { rm = rm_; rn = rn_; nwg = ng * rm * rn; G = G_; c = c_; }
    __device__ bool next(int i, Unit& u) const { const long L = (long)i * G + c; if (L >= nwg) return false; const int per = rm * rn, gi = (int)L / per, r = (int)L % per; u.pm = gi * rm + r % rm; u.pn = gi * rn + r / rm; return true; }
    __device__ __forceinline__ void a_ready(const Unit&) const {}
    __device__ __forceinline__ void done(const Unit&) const {}
};
struct EpiWin {
    static constexpr bool PERM = true, AFTER_DRAIN = false;
    bf16_t* QKV; bf16_t* UA;
    __device__ __forceinline__ void operator()(const f32x4 (&acc)[2][2][4][2], const Unit& u, int wr, int wc, int fr, int fq) const {
        const int row0 = u.pm * BM + wr * 64 + fr;
#pragma unroll
        for (int ai = 0; ai < 2; ++ai)
#pragma unroll
            for (int m = 0; m < 4; ++m) { const int r = row0 + ai * HALF + m * 16;
#pragma unroll
                for (int bj = 0; bj < 2; ++bj) { const f32x4 v0 = acc[ai][bj][m][0], v1 = acc[ai][bj][m][1];
                    u32x4 w; w.x = cvt_pk_bf16(v0[0], v0[1]); w.y = cvt_pk_bf16(v0[2], v0[3]); w.z = cvt_pk_bf16(v1[0], v1[1]); w.w = cvt_pk_bf16(v1[2], v1[3]);
                    if (u.pn < 3) { *(u32x4*)(QKV + (size_t)r * 768 + u.pn * BM + bj * HALF + wc * 32 + 8 * fq) = w; }
                    else { const int ucol = (u.pn - 3) * BM + bj * HALF + wc * 32 + 8 * fq, gi = ucol >> 4, h0 = ucol & 15, b = r >> 11, t = r & 2047, c = t >> 5, tau = t & 31;
                        *(u32x4*)(UA + (size_t)(gi * 512 + b * 64 + c) * KY + tau * 16 + h0) = w; } } }
    }
};
struct EpiStates {
    static constexpr bool PERM = false, AFTER_DRAIN = true;
    float* SST; bf16_t* UA; const float *lam_re, *lam_im, *log_dt;
    __device__ __forceinline__ void fused(f32x4 (&acc)[2][2][4][2], const Unit& u, int wr, int wc, int fr, int fq, PG8_LAS unsigned char* lds, int wid, int lane) const {
#pragma unroll
        for (int ai = 0; ai < 2; ++ai)
#pragma unroll
            for (int m = 0; m < 4; ++m) { float* rowp = SST + (size_t)(u.pm * BM + ai * HALF + wr * 64 + m * 16 + fr) * 256 + wc * 32 + 4 * fq;
#pragma unroll
                for (int bj = 0; bj < 2; ++bj)
#pragma unroll
                    for (int n = 0; n < 2; ++n) *(f32x4*)(rowp + bj * HALF + n * 16) = acc[ai][bj][m][n]; }
        __threadfence(); __syncthreads();
        const int gi = u.pm >> 1, bl = wid >> 1, dir = wid & 1, dg = dir * NG + gi;
        const float lr = fminf(lam_re[dg * PS + lane], -1e-4f), li = lam_im[dg * PS + lane], dt = expf(log_dt[dg]);
        const float mg = expf(lr * dt * (float)TC), ang = li * dt * (float)TC, a_r = mg * cosf(ang), a_i = mg * sinf(ang);
        const size_t rowbase = (size_t)u.pm * BM + bl * 64;
        const float* sre = SST + rowbase * 256 + dir * 128 + lane;
        bf16_t* cre = UA + rowbase * KY + 512 + dir * 128 + lane;
        float xr = 0.f, xi = 0.f;
#pragma unroll 8
        for (int i = 0; i < NC; ++i) { const int c = dir ? NC - 1 - i : i;
            cre[(size_t)c * KY] = (bf16_t)f2bf(xr); cre[(size_t)c * KY + 64] = (bf16_t)f2bf(xi);
            const float sr = __hip_atomic_load(sre + (size_t)c * 256, __ATOMIC_RELAXED, __HIP_MEMORY_SCOPE_AGENT), si = __hip_atomic_load(sre + (size_t)c * 256 + 64, __ATOMIC_RELAXED, __HIP_MEMORY_SCOPE_AGENT);
            const float nr = a_r * xr - a_i * xi + sr; xi = a_r * xi + a_i * xr + si; xr = nr; }
    }
};
struct EpiSsmOut {
    static constexpr bool PERM = true, AFTER_DRAIN = false;
    bf16_t* YG;
    __device__ __forceinline__ void operator()(const f32x4 (&acc)[2][2][4][2], const Unit& u, int wr, int wc, int fr, int fq) const {
        const int gi = u.pm >> 1;
#pragma unroll
        for (int ai = 0; ai < 2; ++ai)
#pragma unroll
            for (int m = 0; m < 4; ++m) { const int bc = ((u.pm & 1) * BM + ai * HALF + wr * 64 + m * 16 + fr), b = bc >> 6, c = bc & 63;
#pragma unroll
                for (int bj = 0; bj < 2; ++bj) { const int col = (u.pn & 1) * BM + bj * HALF + wc * 32 + 8 * fq, tau = col >> 4, h0 = col & 15;
                    const f32x4 v0 = acc[ai][bj][m][0], v1 = acc[ai][bj][m][1];
                    u32x4 w; w.x = cvt_pk_bf16(gelu_tanh(v0[0]), gelu_tanh(v0[1])); w.y = cvt_pk_bf16(gelu_tanh(v0[2]), gelu_tanh(v0[3]));
                    w.z = cvt_pk_bf16(gelu_tanh(v1[0]), gelu_tanh(v1[1])); w.w = cvt_pk_bf16(gelu_tanh(v1[2]), gelu_tanh(v1[3]));
                    *(u32x4*)(YG + (size_t)(b * SEQ + c * TC + tau) * SWD + gi * 16 + h0) = w; } }
    }
};
}

struct Args { const float* in[26]; float* out; unsigned char* ws; int ph_lo, ph_hi; };
constexpr int N_PHASES = 14;
__global__ void __launch_bounds__(512, 2) mk_fwd(Args args) {
    extern __shared__ __attribute__((aligned(16))) unsigned char lds_raw[];
    LAS unsigned char* lds = (LAS unsigned char*)lds_raw;
    cg::grid_group grid = cg::this_grid();
    const int tid = threadIdx.x, lane = tid & 63, wave = __builtin_amdgcn_readfirstlane(tid >> 6);
    const int G = gridDim.x, bid = blockIdx.x;
    const int gw = bid * 8 + wave, NGW = G * 8;
    unsigned char* ws = args.ws;
    const float* x = args.in[0];
    float* X = args.out;
    bf16* WT1 = (bf16*)(ws + WS_WT1); bf16* WD1 = (bf16*)(ws + WS_WD1); bf16* WT2 = (bf16*)(ws + WS_WT2); bf16* WD2 = (bf16*)(ws + WS_WD2);
    bf16* WIN = (bf16*)(ws + WS_WIN); bf16* WOUT = (bf16*)(ws + WS_WOUT); bf16* WGLU = (bf16*)(ws + WS_WGLU);
    bf16* XA = (bf16*)(ws + WS_XA); bf16* HB = (bf16*)(ws + WS_H); bf16* QKV = (bf16*)(ws + WS_QKV); bf16* ATT = (bf16*)(ws + WS_ATT); bf16* YG = (bf16*)(ws + WS_YG);
    bf16* SB = (bf16*)(ws + WS_S); bf16* MIX = (bf16*)(ws + WS_MIX); bf16* MATS = (bf16*)(ws + WS_MATS); bf16* MATY = (bf16*)(ws + WS_MATY); bf16* UA = (bf16*)(ws + WS_UA); float* SST = (float*)(ws + WS_SST);
    const SsmP SP{args.in[8], args.in[9], args.in[10], args.in[11], args.in[12], args.in[13], args.in[14], args.in[15]};
    const int lo = args.ph_lo, hi = args.ph_hi;
#define IN(k) (lo <= (k) && (k) < hi)
#define SEAM(k) do { if (IN(k) && IN((k) + 1)) grid.sync(); } while (0)

    if (IN(0)) {
        LAS float* scr = (LAS float*)(lds + wave * 16384);
        constexpr int I_UP = (DM / 64) * (FF / 32), I_DN = (FF / 64) * (DM / 32), I_IN = (DM / 64) * (INW / 32), I_GLU = (SWD / 64) * (SWD / 32), I_OUT = (DM / 64) * (DM / 32);
        constexpr int NITEMS = 6 * I_UP + I_IN + I_GLU + I_OUT; static_assert(I_UP == I_DN, "");
        for (int it = gw; it < NITEMS; it += NGW) {
            int r = it;
            if (r < I_UP) { p0_transpose_item<1>(args.in[2], DM, FF, WT1, scr, r, lane); continue; } r -= I_UP;
            if (r < I_UP) { p0_transpose_item<2>(args.in[3], DM, FF, WT1, scr, r, lane); continue; } r -= I_UP;
            if (r < I_DN) { p0_transpose_item<0>(args.in[4], FF, DM, WD1, scr, r, lane); continue; } r -= I_DN;
            if (r < I_UP) { p0_transpose_item<1>(args.in[22], DM, FF, WT2, scr, r, lane); continue; } r -= I_UP;
            if (r < I_UP) { p0_transpose_item<2>(args.in[23], DM, FF, WT2, scr, r, lane); continue; } r -= I_UP;
            if (r < I_DN) { p0_transpose_item<0>(args.in[24], FF, DM, WD2, scr, r, lane); continue; } r -= I_DN;
            if (r < I_IN) { p0_transpose_item<0>(args.in[6], DM, INW, WIN, scr, r, lane); continue; } r -= I_IN;
            if (r < I_GLU) { p0_transpose_item<0>(args.in[16], SWD, SWD, WGLU, scr, r, lane); continue; } r -= I_GLU;
            p0_transpose_item<0>(args.in[20], DM, DM, WOUT, scr, r, lane);
        }
        for (int m = gw; m < M; m += NGW) rms_row_to_bf16(x + (size_t)m * DM, args.in[1], XA + (size_t)m * DM, lane);
    }
    SEAM(0);
    if (IN(1)) { pg8::Gemm g{XA, WT1, M, 2 * FF, DM, DM, DM}; pg8::StaticOrder S; S.init(M, 2 * FF, G, bid); pg8::EpiSwiglu E{HB, FF};
        pg8::gemm_phase<pg8::EpiSwiglu, pg8::StaticOrder, true, true>(lds, g, S, E); }
    SEAM(1);
    if (IN(2)) { pg8::Gemm g{HB, WD1, M, DM, FF, FF, FF}; pg8::StaticOrder S; S.init(M, DM, G, bid); pg8::EpiResid E{x, X, 0.5f};
        pg8::gemm_phase<pg8::EpiResid, pg8::StaticOrder, true, true>(lds, g, S, E); }
    SEAM(2);
    if (IN(3)) {
        LAS float* scr = (LAS float*)(lds + wave * 18432);
        for (int it = gw; it < 32 * 63; it += NGW) gen_toep_item(SP, MATY, scr, it, lane);
        for (int it = gw; it < 32 * 2 * 64; it += NGW) gen_states_item(SP, MATS, it, lane);
        for (int it = gw; it < 32 * 2 * 32; it += NGW) gen_carry_item(SP, MATY, it, lane);
        for (int m = gw; m < M; m += NGW) rms_row_to_bf16(X + (size_t)m * DM, args.in[5], XA + (size_t)m * DM, lane);
    }
    SEAM(3);
    if (IN(4)) { pg8::Gemm g{XA, WIN, M, INW, DM, DM, DM}; pg8::StaticOrder S; S.init(M, INW, G, bid); pg8::EpiWin E{QKV, UA};
        pg8::gemm_phase<pg8::EpiWin, pg8::StaticOrder, true, true>(lds, g, S, E); }
    SEAM(4);
    if (IN(5)) {
        { pg8::Gemm g{UA, MATS, 32 * 512, 32 * 256, KS, KY, KS}; pg8::GroupOrder S; S.init(32, 2, 1, G, bid); pg8::EpiStates E{SST, UA, SP.lam_re, SP.lam_im, SP.log_dt};
          if (G >= 64) pg8::gemm_phase<pg8::EpiStates, pg8::GroupOrder, false, true>(lds, g, S, E); }
        attn_mfma(lds, QKV, ATT, args.in[7], G, bid);
    }
    SEAM(5);
    if (IN(6)) { pg8::Gemm g{UA, MATY, 32 * 512, 32 * 512, KY, KY, KY}; pg8::GroupOrder S; S.init(32, 2, 2, G, bid); pg8::EpiSsmOut E{YG};
        pg8::gemm_phase<pg8::EpiSsmOut, pg8::GroupOrder, true, true>(lds, g, S, E); }
    SEAM(6);
    if (IN(7)) { pg8::Gemm g{YG, WGLU, M, SWD, SWD, SWD, SWD}; pg8::StaticOrder S; S.init(M, SWD, G, bid); pg8::EpiGlu E{YG, SB, args.in[17]};
        pg8::gemm_phase<pg8::EpiGlu, pg8::StaticOrder, true, true>(lds, g, S, E); }
    SEAM(7);
    if (IN(8)) { for (int m = gw; m < M; m += NGW) mix_row(ATT + (size_t)m * AW, SB + (size_t)m * SWD, args.in[18], args.in[19], MIX + (size_t)m * DM, lane); }
    SEAM(8);
    if (IN(9)) { pg8::Gemm g{MIX, WOUT, M, DM, DM, DM, DM}; pg8::StaticOrder S; S.init(M, DM, G, bid); pg8::EpiResid E{X, X, 1.0f};
        pg8::gemm_phase<pg8::EpiResid, pg8::StaticOrder, true, true>(lds, g, S, E); }
    SEAM(9);
    if (IN(10)) { for (int m = gw; m < M; m += NGW) rms_row_to_bf16(X + (size_t)m * DM, args.in[21], XA + (size_t)m * DM, lane); }
    SEAM(10);
    if (IN(11)) { pg8::Gemm g{XA, WT2, M, 2 * FF, DM, DM, DM}; pg8::StaticOrder S; S.init(M, 2 * FF, G, bid); pg8::EpiSwiglu E{HB, FF};
        pg8::gemm_phase<pg8::EpiSwiglu, pg8::StaticOrder, true, true>(lds, g, S, E); }
    SEAM(11);
    if (IN(12)) { pg8::Gemm g{HB, WD2, M, DM, FF, FF, FF}; pg8::StaticOrder S; S.init(M, DM, G, bid); pg8::EpiResid E{X, X, 0.5f};
        pg8::gemm_phase<pg8::EpiResid, pg8::StaticOrder, true, true>(lds, g, S, E); }
    SEAM(12);
    if (IN(13)) { for (int m = gw; m < M; m += NGW) rms_row_f32(X + (size_t)m * DM, args.in[25], lane); }
#undef IN
#undef SEAM
}

extern "C" void kernel_launch(void* const* d_in, const int* in_sizes, int n_in, void* d_out, int out_size, void* d_ws, size_t ws_size, hipStream_t stream) {
    static int grid = 0;
    if (grid == 0) {
        if (n_in != 26 || in_sizes[0] != M * DM || out_size != M * DM || ws_size < WS_END) { fprintf(stderr, "kernel_launch: unexpected shapes n_in %d in0 %d out %d ws %zu\n", n_in, n_in > 0 ? in_sizes[0] : -1, out_size, ws_size); grid = -1; return; }
        int dev = 0, cus = 0, per_cu = 0;
        (void)hipGetDevice(&dev); (void)hipDeviceGetAttribute(&cus, hipDeviceAttributeMultiprocessorCount, dev);
        if (hipFuncSetAttribute((const void*)mk_fwd, hipFuncAttributeMaxDynamicSharedMemorySize, LDS_BYTES) != hipSuccess) { fprintf(stderr, "kernel_launch: hipFuncSetAttribute failed\n"); grid = -1; return; }
        if (hipOccupancyMaxActiveBlocksPerMultiprocessor(&per_cu, (const void*)mk_fwd, 512, LDS_BYTES) != hipSuccess || per_cu < 1) { fprintf(stderr, "kernel_launch: occupancy query says %d\n", per_cu); per_cu = 1; }
        (void)hipGetLastError();
        grid = cus * per_cu;
        fprintf(stderr, "kernel_launch: grid %d (cus %d per_cu %d)\n", grid, cus, per_cu);
    }
    if (grid < 0) return;
    Args a{};
    for (int i = 0; i < 26; ++i) a.in[i] = (const float*)d_in[i];
    a.out = (float*)d_out; a.ws = (unsigned char*)d_ws;
#if MK_MULTI
    for (int ph = 0; ph < N_PHASES; ++ph) { a.ph_lo = ph; a.ph_hi = ph + 1; hipLaunchKernelGGL(mk_fwd, dim3(grid), dim3(512), LDS_BYTES, stream, a); }
#else
    a.ph_lo = 0; a.ph_hi = N_PHASES;
    void* kargs[] = {&a};
    hipError_t e = hipLaunchCooperativeKernel((const void*)mk_fwd, dim3(grid), dim3(512), kargs, LDS_BYTES, stream);
    if (e != hipSuccess) fprintf(stderr, "cooperative launch failed: %s (grid %d)\n", hipGetErrorString(e), grid);
#endif
}
```

```cpp
#include <hip/hip_runtime.h>
#include <hip/hip_cooperative_groups.h>
#include <cstdio>
#include <cstdint>
namespace cg = cooperative_groups;
#define MK_MULTI 0
namespace pg8 {
#define PG8_LAS __attribute__((address_space(3)))
typedef unsigned short bf16_t;
typedef short bf16x8 __attribute__((ext_vector_type(8)));
typedef float f32x4 __attribute__((ext_vector_type(4)));
typedef unsigned u32x4 __attribute__((ext_vector_type(4)));
constexpr int BM = 256, BK = 64, HALF = 128, HTB = HALF * BK * 2  , STAGE_BYTES = 8 * HTB, NXCD = 8, WGM = 8;

__host__ __device__ __forceinline__ int lds_byte(int r, int c) { const int st = (r >> 4) * 2 + (c >> 5), rr = r & 15, cc = c & 31, ob = rr * 64 + cc * 2; return st * 1024 + (ob ^ (((ob >> 9) & 1) << 5)); }
__host__ __device__ __forceinline__ void stage_rc(int b, int& R, int& C) { const int st = b / 1024, sb = b % 1024, swz = sb ^ (((sb >> 9) & 1) << 5); R = (st >> 1) * 16 + swz / 64; C = (st & 1) * 32 + (swz % 64) / 2; }
__host__ __device__ __forceinline__ int perm32(int rho) { const int n = rho >> 4, i = rho & 15; return 8 * (i >> 2) + 4 * n + (i & 3); }

struct Unit { int pm, pn; };
struct Gemm { const bf16_t* A; const bf16_t* Bt; int M, N, K, lda, ldb; };

struct StaticOrder {
    int nM, nN, nwg, G, c;
    __host__ __device__ void init(int M, int N, int G_, int c_) { nM = M / BM; nN = N / BM; nwg = nM * nN; G = G_; c = c_; }
    __host__ __device__ bool next(int i, Unit& u) const {
        const long L = (long)i * G + c; if (L >= nwg) return false;
        int wgid = (int)L; { const int q = nwg / NXCD, r = nwg % NXCD, xcd = wgid % NXCD, off = wgid / NXCD; wgid = (xcd < r ? xcd * (q + 1) : r * (q + 1) + (xcd - r) * q) + off; }
        const int nig = WGM * nN, gid = wgid / nig, fm = gid * WGM, gsz = (nM - fm) < WGM ? (nM - fm) : WGM;
        u.pm = fm + ((wgid % nig) % gsz); u.pn = (wgid % nig) / gsz; return true;
    }
    __device__ __forceinline__ void a_ready(const Unit&) const {}
    __device__ __forceinline__ void done(const Unit&) const {}
};

__device__ __forceinline__ unsigned cvt_pk_bf16(float lo, float hi) { unsigned r; asm volatile("v_cvt_pk_bf16_f32 %0, %1, %2" : "=v"(r) : "v"(lo), "v"(hi)); return r; }
typedef float f32x2 __attribute__((ext_vector_type(2)));
__device__ __forceinline__ f32x2 gelu_pk(f32x2 v) {
    const f32x2 av = __builtin_elementwise_abs(v), d = av * 0.2316418882f + 1.0f;
    f32x2 t; t.x = __builtin_amdgcn_rcpf(d.x); t.y = __builtin_amdgcn_rcpf(d.y);
    f32x2 q = t * 0.5307027145f + (-0.7265760135f); q = q * t + 0.7107068705f; q = q * t + (-0.142248368f); q = q * t + 0.127414796f; q = q * t;
    const f32x2 s = (v * v) * (-0.72134752044f);
    f32x2 e; e.x = __builtin_amdgcn_exp2f(s.x); e.y = __builtin_amdgcn_exp2f(s.y);
    const f32x2 m = v * (q * e), r = v - m;
    f32x2 o; o.x = v.x < 0.f ? m.x : r.x; o.y = v.y < 0.f ? m.y : r.y; return o;
}

template <int ACT  > struct EpiBf16 {
    static constexpr bool PERM = true, AFTER_DRAIN = false; static_assert(ACT == 0 || ACT == 1, "EpiBf16: ACT is 0 (none) or 1 (gelu_pk)");
    bf16_t* O; int ldc; const float* bias; int split_cols; size_t split_stride; float scale0;
    __device__ __forceinline__ void operator()(const f32x4 (&acc)[2][2][4][2], const Unit& u, int wr, int wc, int fr, int fq) const {
        const int row0 = u.pm * BM + wr * 64 + fr; int colt = u.pn * BM; bf16_t* base = O;
        float sc = 1.f; if (split_cols) { const int t = colt / split_cols; base += (size_t)t * split_stride; colt -= t * split_cols; if (t == 0) sc = scale0; }
        const int col0 = colt + wc * 32 + 8 * fq, bcol0 = u.pn * BM + wc * 32 + 8 * fq;
        f32x4 bv[2][2];
#pragma unroll
        for (int bj = 0; bj < 2; ++bj)
#pragma unroll
            for (int n = 0; n < 2; ++n) bv[bj][n] = bias ? *(const f32x4*)(bias + bcol0 + bj * HALF + 4 * n) : (f32x4){0.f, 0.f, 0.f, 0.f};
#pragma unroll
        for (int ai = 0; ai < 2; ++ai)
#pragma unroll
            for (int m = 0; m < 4; ++m) { bf16_t* rowp = base + (size_t)(row0 + ai * HALF + m * 16) * ldc + col0;
#pragma unroll
                for (int bj = 0; bj < 2; ++bj) { f32x4 v0 = acc[ai][bj][m][0] + bv[bj][0], v1 = acc[ai][bj][m][1] + bv[bj][1];
                    if (ACT == 1) { f32x2 a = gelu_pk((f32x2){v0[0], v0[1]}), b = gelu_pk((f32x2){v0[2], v0[3]}), c = gelu_pk((f32x2){v1[0], v1[1]}), d = gelu_pk((f32x2){v1[2], v1[3]});
                        v0 = (f32x4){a.x, a.y, b.x, b.y}; v1 = (f32x4){c.x, c.y, d.x, d.y}; }
                    v0 = v0 * sc; v1 = v1 * sc; u32x4 w; w.x = cvt_pk_bf16(v0[0], v0[1]); w.y = cvt_pk_bf16(v0[2], v0[3]); w.z = cvt_pk_bf16(v1[0], v1[1]); w.w = cvt_pk_bf16(v1[2], v1[3]);
                    *(u32x4*)(rowp + bj * HALF) = w; } }
    }
};
template <class Epi, class Sched, bool ALIGN_EPI = false, bool SP2 = false>
__device__ __forceinline__ void gemm_phase(PG8_LAS unsigned char* lds, const Gemm g, const Sched& S, const Epi& E) {
    const int tid = threadIdx.x, wid = __builtin_amdgcn_readfirstlane(tid >> 6), lane = tid & 63, wr = wid >> 2, wc = wid & 3, fr = lane & 15, fq = lane >> 4;
    const int K = g.K, nt = K / BK;
    unsigned voffA[2], voffB[2];
#pragma unroll
    for (int i = 0; i < 2; ++i) { int R, C; stage_rc(tid * 16 + i * 8192, R, C); const int Rb = Epi::PERM ? ((R & ~31) + perm32(R & 31)) : R;
        voffA[i] = (unsigned)(R * g.lda + C) * 2u; voffB[i] = (unsigned)(Rb * g.ldb + C) * 2u; }
    const size_t kstep = (size_t)(BK * 2);
    const size_t hstepA = (size_t)HALF * g.lda * 2, hstepB = (size_t)HALF * g.ldb * 2;
    const size_t tstepA = 2 * hstepA, tstepB = 2 * hstepB;
    const unsigned ldsw = (unsigned)wid * 1024u;
    const int aoff = lds_byte(wr * 64 + fr, fq * 8), boff = lds_byte(wc * 32 + fr, fq * 8);
#define PG8_SA(b, h) (((b) * 2 + (h)) * HTB)
#define PG8_SB(b, h) ((4 + (b) * 2 + (h)) * HTB)
#define PG8_STAGE(bufoff, gbase, voff) do { _Pragma("unroll") for (int _i = 0; _i < 2; ++_i) \
        __builtin_amdgcn_global_load_lds((const unsigned*)((const char*)(gbase) + (voff)[_i]), (PG8_LAS unsigned*)(lds + (bufoff) + ldsw + _i * 8192), 16, 0, 0); } while (0)
#define PG8_LDA(dst, b, h) do { _Pragma("unroll") for (int m = 0; m < 4; ++m) _Pragma("unroll") for (int k = 0; k < 2; ++k) dst[m][k] = *(const PG8_LAS bf16x8*)(lds + PG8_SA(b, h) + aoff + m * 2048 + k * 1024); } while (0)
#define PG8_LDB(dst, b, h) do { _Pragma("unroll") for (int n = 0; n < 2; ++n) _Pragma("unroll") for (int k = 0; k < 2; ++k) dst[n][k] = *(const PG8_LAS bf16x8*)(lds + PG8_SB(b, h) + boff + n * 2048 + k * 1024); } while (0)
#define PG8_MMA(ai, bj, At, Bt) do { __builtin_amdgcn_s_setprio(1); _Pragma("unroll") for (int m = 0; m < 4; ++m) _Pragma("unroll") for (int n = 0; n < 2; ++n) _Pragma("unroll") for (int k = 0; k < 2; ++k) \
        acc[ai][bj][m][n] = __builtin_amdgcn_mfma_f32_16x16x32_bf16(Bt[n][k], At[m][k], acc[ai][bj][m][n], 0, 0, 0); __builtin_amdgcn_s_setprio(0); } while (0)
#define PG8_WAIT_V(n) asm volatile("s_waitcnt vmcnt(" #n ")" ::: "memory")
#define PG8_WAIT_L(n) asm volatile("s_waitcnt lgkmcnt(" #n ")" ::: "memory")
#define PG8_BAR __builtin_amdgcn_s_barrier()
#define PG8_SCHED __builtin_amdgcn_sched_barrier(0)
    Unit cur, nxt; int ui = 0;
    if (!S.next(0, cur)) return;
    f32x4 acc[2][2][4][2];
#pragma unroll
    for (int a = 0; a < 2; ++a)
#pragma unroll
        for (int b = 0; b < 2; ++b)
#pragma unroll
            for (int m = 0; m < 4; ++m)
#pragma unroll
                for (int n = 0; n < 2; ++n) acc[a][b][m][n] = (f32x4){0.f, 0.f, 0.f, 0.f};
    bf16x8 At[4][2], B0[2][2], B1[2][2];
    const char* cA = (const char*)g.A + (size_t)cur.pm * tstepA; const char* cB = (const char*)g.Bt + (size_t)cur.pn * tstepB;
    S.a_ready(cur);
    if constexpr (SP2) {
        PG8_STAGE(PG8_SB(0, 0), cB, voffB); PG8_STAGE(PG8_SB(0, 1), cB + hstepB, voffB); PG8_STAGE(PG8_SA(0, 0), cA, voffA); PG8_STAGE(PG8_SA(0, 1), cA + hstepA, voffA);
        if (wr == 1) PG8_BAR;
        PG8_WAIT_V(2); PG8_BAR;
        PG8_STAGE(PG8_SB(1, 0), cB + kstep, voffB); PG8_STAGE(PG8_SA(1, 0), cA + kstep, voffA); PG8_STAGE(PG8_SB(1, 1), cB + hstepB + kstep, voffB);
        PG8_WAIT_V(6); PG8_BAR;
    } else {
        PG8_STAGE(PG8_SB(0, 0), cB, voffB); PG8_STAGE(PG8_SA(0, 0), cA, voffA); PG8_STAGE(PG8_SB(0, 1), cB + hstepB, voffB); PG8_STAGE(PG8_SA(0, 1), cA + hstepA, voffA);
        if (wr == 1) PG8_BAR;
        PG8_WAIT_V(4); PG8_BAR;
        PG8_STAGE(PG8_SB(1, 0), cB + kstep, voffB); PG8_STAGE(PG8_SA(1, 0), cA + kstep, voffA); PG8_STAGE(PG8_SB(1, 1), cB + hstepB + kstep, voffB);
        PG8_WAIT_V(6); PG8_BAR;
    }
    for (;;) {
        const bool has_next = S.next(ui + 1, nxt);
        const char* nA = has_next ? (const char*)g.A + (size_t)nxt.pm * tstepA : cA; const char* nB = has_next ? (const char*)g.Bt + (size_t)nxt.pn * tstepB : cB;
        for (int t = 0; t < nt; t += 2) {
            const bool last = (t == nt - 2);
            const char* a1 = cA + (size_t)(t + 1) * kstep;
            const char* a2 = last ? nA : cA + (size_t)(t + 2) * kstep; const char* b2 = last ? nB : cB + (size_t)(t + 2) * kstep;
            const char* a3 = a2 + kstep; const char* b3 = b2 + kstep;
            if (last && has_next) S.a_ready(nxt);
            if constexpr (SP2) {
            PG8_LDB(B0, 0, 0); PG8_LDB(B1, 0, 1); PG8_SCHED; PG8_LDA(At, 0, 0); PG8_STAGE(PG8_SA(1, 1), a1 + hstepA, voffA);
            PG8_WAIT_V(8); PG8_WAIT_L(0); PG8_BAR; PG8_MMA(0, 0, At, B0); PG8_MMA(0, 1, At, B1); PG8_BAR; PG8_SCHED;
            PG8_LDA(At, 0, 1); PG8_STAGE(PG8_SB(0, 0), b2, voffB); PG8_STAGE(PG8_SB(0, 1), b2 + hstepB, voffB); PG8_STAGE(PG8_SA(0, 0), a2, voffA);
            PG8_WAIT_V(8); PG8_WAIT_L(0); PG8_BAR; PG8_MMA(1, 0, At, B0); PG8_MMA(1, 1, At, B1); PG8_BAR; PG8_SCHED;
            PG8_LDB(B0, 1, 0); PG8_LDB(B1, 1, 1); PG8_SCHED; PG8_LDA(At, 1, 0); PG8_STAGE(PG8_SA(0, 1), a2 + hstepA, voffA);
            PG8_WAIT_V(8); PG8_WAIT_L(0); PG8_BAR; PG8_MMA(0, 0, At, B0); PG8_MMA(0, 1, At, B1); PG8_BAR; PG8_SCHED;
            PG8_LDA(At, 1, 1); PG8_STAGE(PG8_SB(1, 0), b3, voffB); PG8_STAGE(PG8_SB(1, 1), b3 + hstepB, voffB); PG8_STAGE(PG8_SA(1, 0), a3, voffA);
            PG8_WAIT_V(8); PG8_WAIT_L(0); PG8_BAR; PG8_MMA(1, 0, At, B0); PG8_MMA(1, 1, At, B1); PG8_BAR; PG8_SCHED;
            } else {
            PG8_LDB(B0, 0, 0); PG8_SCHED; PG8_LDA(At, 0, 0); PG8_STAGE(PG8_SA(1, 1), a1 + hstepA, voffA);
            PG8_WAIT_L(8); PG8_BAR; PG8_WAIT_L(0); PG8_MMA(0, 0, At, B0); PG8_BAR; PG8_SCHED;
            PG8_LDB(B1, 0, 1); PG8_STAGE(PG8_SB(0, 0), b2, voffB);
            PG8_BAR; PG8_WAIT_L(0); PG8_MMA(0, 1, At, B1); PG8_BAR;
            PG8_LDA(At, 0, 1); PG8_STAGE(PG8_SA(0, 0), a2, voffA);
            PG8_BAR; PG8_WAIT_L(0); PG8_MMA(1, 0, At, B0); PG8_BAR; PG8_SCHED;
            PG8_STAGE(PG8_SB(0, 1), b2 + hstepB, voffB);
            PG8_WAIT_V(6); PG8_BAR; PG8_MMA(1, 1, At, B1); PG8_BAR;
            PG8_LDB(B0, 1, 0); PG8_SCHED; PG8_LDA(At, 1, 0); PG8_STAGE(PG8_SA(0, 1), a2 + hstepA, voffA);
            PG8_WAIT_L(8); PG8_BAR; PG8_WAIT_L(0); PG8_MMA(0, 0, At, B0); PG8_BAR; PG8_SCHED;
            PG8_LDB(B1, 1, 1); PG8_STAGE(PG8_SB(1, 0), b3, voffB);
            PG8_BAR; PG8_WAIT_L(0); PG8_MMA(0, 1, At, B1); PG8_BAR;
            PG8_LDA(At, 1, 1); PG8_STAGE(PG8_SA(1, 0), a3, voffA);
            PG8_BAR; PG8_WAIT_L(0); PG8_MMA(1, 0, At, B0); PG8_BAR; PG8_SCHED;
            PG8_STAGE(PG8_SB(1, 1), b3 + hstepB, voffB);
            PG8_WAIT_V(6); PG8_BAR; PG8_MMA(1, 1, At, B1); PG8_BAR;
            }
        }
        if constexpr (ALIGN_EPI) { if (wr == 0) PG8_BAR; }
        if constexpr (!Epi::AFTER_DRAIN) { E(acc, cur, wr, wc, fr, fq); S.done(cur); }
        if (!has_next) break;
#pragma unroll
        for (int a = 0; a < 2; ++a)
#pragma unroll
            for (int b = 0; b < 2; ++b)
#pragma unroll
                for (int m = 0; m < 4; ++m)
#pragma unroll
                    for (int n = 0; n < 2; ++n) acc[a][b][m][n] = (f32x4){0.f, 0.f, 0.f, 0.f};
        cur = nxt; cA = nA; cB = nB; ++ui;
        if constexpr (ALIGN_EPI) { if (wr == 1) PG8_BAR; }
    }
    PG8_WAIT_V(0);
    if constexpr (!ALIGN_EPI) { if (wr == 0) PG8_BAR; }
    PG8_BAR;
    if constexpr (Epi::AFTER_DRAIN) { E.fused(acc, cur, wr, wc, fr, fq, lds, wid, lane); S.done(cur); }
#undef PG8_SA
#undef PG8_SB
#undef PG8_STAGE
#undef PG8_LDA
#undef PG8_LDB
#undef PG8_MMA
#undef PG8_WAIT_V
#undef PG8_WAIT_L
#undef PG8_BAR
#undef PG8_SCHED
}
}

#define GAS __attribute__((address_space(1)))
#define LAS __attribute__((address_space(3)))
typedef unsigned short bf16;
typedef unsigned v4u __attribute__((ext_vector_type(4)));
typedef unsigned v2u __attribute__((ext_vector_type(2)));
typedef float f32x4 __attribute__((ext_vector_type(4)));

#ifndef MK_MULTI
#define MK_MULTI 0
#endif

constexpr int BATCH = 8, SEQ = 2048, DM = 1024, M = BATCH * SEQ;
constexpr int NH = 8, HD = 64, AW = 512, SWD = 512, NG = 32, HC = 16, PS = 64, INW = 1280, FF = 2816;
constexpr float EPS = 1e-6f;
constexpr size_t MiB = 1u << 20;
constexpr size_t WS_WT1 = 2 * MiB, WS_WD1 = 14 * MiB, WS_WT2 = 20 * MiB, WS_WD2 = 32 * MiB, WS_WIN = 38 * MiB, WS_WOUT = 41 * MiB, WS_WGLU = 43 * MiB;
constexpr size_t WS_MATS = 44 * MiB;
constexpr size_t WS_XA = 64 * MiB;
constexpr size_t WS_H = 96 * MiB;
constexpr size_t WS_S = 96 * MiB;
constexpr size_t WS_SST = 96 * MiB;
constexpr size_t WS_MIX = 112 * MiB;
constexpr size_t WS_MATY = 144 * MiB;
constexpr size_t WS_UA = 168 * MiB;
constexpr size_t WS_QKV = 192 * MiB;
constexpr size_t WS_ATT = 216 * MiB;
constexpr size_t WS_YG = 232 * MiB;
constexpr size_t WS_END = 256 * MiB;
constexpr int TC = 32, NC = SEQ / TC, KY = 16 * TC + 256, KS = 16 * TC;
constexpr int LDS_BYTES = 147456, MISC_OFF = 147328;
constexpr size_t CTL_ZERO_BYTES = 16384;

__device__ __forceinline__ unsigned f2bf(float f) { unsigned u = __builtin_bit_cast(unsigned, f); return (u + 0x7fffu + ((u >> 16) & 1u)) >> 16; }
__device__ __forceinline__ unsigned pk2(float lo, float hi) { return f2bf(lo) | (f2bf(hi) << 16); }
__device__ __forceinline__ float bflo(unsigned w) { return __builtin_bit_cast(float, w << 16); }
__device__ __forceinline__ float bfhi(unsigned w) { return __builtin_bit_cast(float, w & 0xffff0000u); }
#define LDS_WAIT() asm volatile("s_waitcnt lgkmcnt(0)" ::: "memory")
__device__ __forceinline__ float wave_sum(float v) {
#pragma unroll
    for (int o = 1; o < 64; o <<= 1) v += __shfl_xor(v, o);
    return v;
}
__device__ __forceinline__ float sigmoidf_(float x) { return __builtin_amdgcn_rcpf(1.f + __expf(-x)); }

#define XB_TMO      128
#define XB_XCNT(j)  (256  + 64 * (j))
#define XB_XSUB(j)  (1280 + 64 * (j))
#define XB_XGEN(j)  (2304 + 64 * (j))
#define XB_TOP      3328
#define XB_TOPGEN   3392
#define XCD_BAR_WORDS 3456
#define XB_SPIN_CAP (1u << 18)

__device__ __forceinline__ unsigned xb_ld(unsigned* p)              { return __hip_atomic_load(p, __ATOMIC_RELAXED, __HIP_MEMORY_SCOPE_AGENT); }
__device__ __forceinline__ unsigned xb_add(unsigned* p, unsigned v) { return __hip_atomic_fetch_add(p, v, __ATOMIC_RELAXED, __HIP_MEMORY_SCOPE_AGENT); }
__device__ __forceinline__ unsigned xb_xcc_id() { return (unsigned)__builtin_amdgcn_s_getreg((3 << 11) | 20) & 0xFu; }
#define XB_SPIN(cond, bar) do { unsigned _sp = 0; while (cond) { __builtin_amdgcn_s_sleep(1); \
    if ((++_sp & 255u) == 0u) { if (xb_ld(&(bar)[XB_TMO])) break; if (_sp > XB_SPIN_CAP) { atomicAdd(&(bar)[XB_TMO], 1u); break; } } } } while (0)

struct XcdBarrier {
    unsigned* bar; unsigned x;
    volatile LAS unsigned* st;
};

__device__ __forceinline__ XcdBarrier xcd_barrier_post(unsigned* bar, volatile LAS unsigned* st) {
    XcdBarrier b; b.bar = bar; b.x = xb_xcc_id(); b.st = st;
    if (threadIdx.x == 0) (void)xb_add(&bar[XB_XCNT(b.x)], 1u);
    return b;
}
__device__ __forceinline__ void xcd_barrier_complete(unsigned* bar, unsigned x, unsigned& nloc, unsigned& nx) {
    const unsigned G = gridDim.x * gridDim.y * gridDim.z;
    unsigned sum, cnt, mine, sp = 0u;
    for (;;) {
        sum = 0u; cnt = 0u; mine = 0u;
#pragma unroll
        for (unsigned j = 0; j < 16; ++j) { const unsigned c = xb_ld(&bar[XB_XCNT(j)]); sum += c; cnt += (c > 0u) ? 1u : 0u; mine = (j == x) ? c : mine; }
        if (sum == G) break;
        __builtin_amdgcn_s_sleep(1);
        if ((++sp & 255u) == 0u) { if (xb_ld(&bar[XB_TMO])) break; if (sp > XB_SPIN_CAP) { atomicAdd(&bar[XB_TMO], 1u); break; } }
    }
    nloc = mine > 0u ? mine : 1u; nx = cnt > 0u ? cnt : 1u;
}

__device__ __forceinline__ void xcd_barrier(const XcdBarrier& b) {
    asm volatile("s_waitcnt vmcnt(0)" ::: "memory");
    __syncthreads();
    if (threadIdx.x == 0) {
        unsigned* bar = b.bar;
        __builtin_amdgcn_s_waitcnt(0);
        unsigned nloc = b.st[0], nx = b.st[1];
        if (nloc == 0u) { xcd_barrier_complete(bar, b.x, nloc, nx); b.st[0] = nloc; b.st[1] = nx; }
        const unsigned old = xb_add(&bar[XB_XSUB(b.x)], 1u);
        const unsigned gen = old / nloc;
        if (old + 1u == (gen + 1u) * nloc) {
            __builtin_amdgcn_fence(__ATOMIC_RELEASE, "agent");
            asm volatile("s_waitcnt vmcnt(0)" ::: "memory");
            const unsigned og = xb_add(&bar[XB_TOP], 1u);
            const unsigned tg = og / nx;
            if (og + 1u == (tg + 1u) * nx) xb_add(&bar[XB_TOPGEN], 1u);
            else XB_SPIN(xb_ld(&bar[XB_TOPGEN]) == tg, bar);
            __builtin_amdgcn_fence(__ATOMIC_ACQUIRE, "agent");
            xb_add(&bar[XB_XGEN(b.x)], 1u);
            asm volatile("s_waitcnt vmcnt(0)" ::: "memory");
        } else {
            XB_SPIN(xb_ld(&bar[XB_XGEN(b.x)]) == gen, bar);
            __builtin_amdgcn_fence(__ATOMIC_ACQUIRE, "agent");
            asm volatile("s_waitcnt vmcnt(0)" ::: "memory");
        }
    }
    __syncthreads();
}

namespace pg8 {
struct EpiSwiglu {
    static constexpr bool PERM = true, AFTER_DRAIN = false;
    bf16_t* H; int ldh;
    __device__ __forceinline__ void operator()(const f32x4 (&acc)[2][2][4][2], const Unit& u, int wr, int wc, int fr, int fq) const {
        const int row0 = u.pm * BM + wr * 64 + fr, col0 = u.pn * HALF + wc * 32 + 8 * fq;
#pragma unroll
        for (int ai = 0; ai < 2; ++ai)
#pragma unroll
            for (int m = 0; m < 4; ++m) {
                bf16_t* rowp = H + (size_t)(row0 + ai * HALF + m * 16) * ldh + col0;
                float hv[8];
#pragma unroll
                for (int n = 0; n < 2; ++n)
#pragma unroll
                    for (int i = 0; i < 4; ++i) { const float g = acc[ai][0][m][n][i], up = acc[ai][1][m][n][i]; hv[n * 4 + i] = g * __builtin_amdgcn_rcpf(1.f + __expf(-g)) * up; }
                u32x4 w; w.x = cvt_pk_bf16(hv[0], hv[1]); w.y = cvt_pk_bf16(hv[2], hv[3]); w.z = cvt_pk_bf16(hv[4], hv[5]); w.w = cvt_pk_bf16(hv[6], hv[7]);
                *(u32x4*)rowp = w;
            }
    }
};
struct EpiResid {
    static constexpr bool PERM = false, AFTER_DRAIN = false;
    const float* base; float* out; float alpha;
    __device__ __forceinline__ void operator()(const f32x4 (&acc)[2][2][4][2], const Unit& u, int wr, int wc, int fr, int fq) const {
        const int col0 = u.pn * BM + wc * 32 + 4 * fq;
#pragma unroll
        for (int ai = 0; ai < 2; ++ai)
#pragma unroll
            for (int m = 0; m < 4; ++m) {
                const size_t off = (size_t)(u.pm * BM + ai * HALF + wr * 64 + m * 16 + fr) * 1024 + col0;
#pragma unroll
                for (int bj = 0; bj < 2; ++bj)
#pragma unroll
                    for (int n = 0; n < 2; ++n) { const f32x4 b = *(const f32x4*)(base + off + bj * HALF + n * 16); *(f32x4*)(out + off + bj * HALF + n * 16) = b + acc[ai][bj][m][n] * alpha; }
            }
    }
};
struct EpiGlu {
    static constexpr bool PERM = true, AFTER_DRAIN = false;
    const bf16_t* Y; bf16_t* S; const float* bias;
    __device__ __forceinline__ void operator()(const f32x4 (&acc)[2][2][4][2], const Unit& u, int wr, int wc, int fr, int fq) const {
        const int row0 = u.pm * BM + wr * 64 + fr, col0 = u.pn * BM + wc * 32 + 8 * fq;
#pragma unroll
        for (int bj = 0; bj < 2; ++bj) {
            const f32x4 b0 = *(const f32x4*)(bias + col0 + bj * HALF), b1 = *(const f32x4*)(bias + col0 + bj * HALF + 4);
#pragma unroll
            for (int ai = 0; ai < 2; ++ai)
#pragma unroll
                for (int m = 0; m < 4; ++m) {
                    const size_t off = (size_t)(row0 + ai * HALF + m * 16) * 512 + col0 + bj * HALF;
                    const u32x4 yv = *(const u32x4*)(Y + off);
                    const f32x4 v0 = acc[ai][bj][m][0] + b0, v1 = acc[ai][bj][m][1] + b1;
                    float o[8];
                    o[0] = bflo(yv.x) * sigmoidf_(v0[0]); o[1] = bfhi(yv.x) * sigmoidf_(v0[1]); o[2] = bflo(yv.y) * sigmoidf_(v0[2]); o[3] = bfhi(yv.y) * sigmoidf_(v0[3]);
                    o[4] = bflo(yv.z) * sigmoidf_(v1[0]); o[5] = bfhi(yv.z) * sigmoidf_(v1[1]); o[6] = bflo(yv.w) * sigmoidf_(v1[2]); o[7] = bfhi(yv.w) * sigmoidf_(v1[3]);
                    u32x4 w; w.x = cvt_pk_bf16(o[0], o[1]); w.y = cvt_pk_bf16(o[2], o[3]); w.z = cvt_pk_bf16(o[4], o[5]); w.w = cvt_pk_bf16(o[6], o[7]);
                    *(u32x4*)(S + off) = w;
                }
        }
    }
};
}

template <int MODE>
__device__ __forceinline__ void p0_transpose_item(const float* W, int K, int N, bf16* WT, LAS float* scr, int item, int lane) {
    const int nblk = N / 32, kb = item / nblk, nb = item % nblk, k0 = 64 * kb, n0 = 32 * nb;
#pragma unroll 8
    for (int i = 0; i < 32; ++i) { const int kk = 2 * i + (lane >> 5); scr[kk * 33 + (lane & 31)] = W[(size_t)(k0 + kk) * N + n0 + (lane & 31)]; }
    LDS_WAIT(); asm volatile("" ::: "memory");
    const int c = lane & 7;
    const int r0 = MODE == 0 ? n0 : ((n0 >> 7) * 256 + (n0 & 127) + (MODE == 2 ? 128 : 0));
#pragma unroll
    for (int j = 0; j < 4; ++j) { const int n = (lane >> 3) + 8 * j; const LAS float* s = scr + (8 * c) * 33 + n;
        v4u o; o.x = pk2(s[0 * 33], s[1 * 33]); o.y = pk2(s[2 * 33], s[3 * 33]); o.z = pk2(s[4 * 33], s[5 * 33]); o.w = pk2(s[6 * 33], s[7 * 33]);
        *(v4u*)(WT + (size_t)(r0 + n) * K + k0 + 8 * c) = o; }
    LDS_WAIT(); asm volatile("" ::: "memory");
}

__device__ __forceinline__ void rms_row_to_bf16(const float* xrow, const float* gain, bf16* orow, int lane) {
    const f32x4* xr = (const f32x4*)xrow + lane; const f32x4* gr = (const f32x4*)gain + lane;
    f32x4 v[4]; float s = 0.f;
#pragma unroll
    for (int j = 0; j < 4; ++j) { v[j] = xr[64 * j]; s += (v[j].x * v[j].x + v[j].y * v[j].y) + (v[j].z * v[j].z + v[j].w * v[j].w); }
    const float rstd = 1.f / sqrtf(wave_sum(s) * (1.f / DM) + EPS);
    unsigned long long* o8 = (unsigned long long*)orow + lane;
#pragma unroll
    for (int j = 0; j < 4; ++j) { const f32x4 g = gr[64 * j];
        o8[64 * j] = (unsigned long long)pk2(v[j].x * rstd * g.x, v[j].y * rstd * g.y) | ((unsigned long long)pk2(v[j].z * rstd * g.z, v[j].w * rstd * g.w) << 32); }
}
__device__ __forceinline__ void rms_row_f32(float* xrow, const float* gain, int lane) {
    f32x4* xr = (f32x4*)xrow + lane; const f32x4* gr = (const f32x4*)gain + lane;
    f32x4 v[4]; float s = 0.f;
#pragma unroll
    for (int j = 0; j < 4; ++j) { v[j] = xr[64 * j]; s += (v[j].x * v[j].x + v[j].y * v[j].y) + (v[j].z * v[j].z + v[j].w * v[j].w); }
    const float rstd = 1.f / sqrtf(wave_sum(s) * (1.f / DM) + EPS);
#pragma unroll
    for (int j = 0; j < 4; ++j) { const f32x4 g = gr[64 * j]; xr[64 * j] = v[j] * rstd * g; }
}
__device__ __forceinline__ void mix_row(const bf16* arow, const bf16* srow, const float* ga, const float* gs, bf16* orow, int lane) {
    const v4u a = *((const v4u*)arow + lane), s = *((const v4u*)srow + lane);
    float av[8] = {bflo(a.x), bfhi(a.x), bflo(a.y), bfhi(a.y), bflo(a.z), bfhi(a.z), bflo(a.w), bfhi(a.w)};
    float sv[8] = {bflo(s.x), bfhi(s.x), bflo(s.y), bfhi(s.y), bflo(s.z), bfhi(s.z), bflo(s.w), bfhi(s.w)};
    float sa = 0.f, ss = 0.f;
#pragma unroll
    for (int i = 0; i < 8; ++i) { sa += av[i] * av[i]; ss += sv[i] * sv[i]; }
    const float ra = 1.f / sqrtf(wave_sum(sa) * (1.f / 512.f) + EPS), rs = 1.f / sqrtf(wave_sum(ss) * (1.f / 512.f) + EPS);
    const f32x4 ga0 = *((const f32x4*)ga + 2 * lane), ga1 = *((const f32x4*)ga + 2 * lane + 1), gs0 = *((const f32x4*)gs + 2 * lane), gs1 = *((const f32x4*)gs + 2 * lane + 1);
    v4u oa, os;
    oa.x = pk2(av[0] * ra * ga0.x, av[1] * ra * ga0.y); oa.y = pk2(av[2] * ra * ga0.z, av[3] * ra * ga0.w); oa.z = pk2(av[4] * ra * ga1.x, av[5] * ra * ga1.y); oa.w = pk2(av[6] * ra * ga1.z, av[7] * ra * ga1.w);
    os.x = pk2(sv[0] * rs * gs0.x, sv[1] * rs * gs0.y); os.y = pk2(sv[2] * rs * gs0.z, sv[3] * rs * gs0.w); os.z = pk2(sv[4] * rs * gs1.x, sv[5] * rs * gs1.y); os.w = pk2(sv[6] * rs * gs1.z, sv[7] * rs * gs1.w);
    *((v4u*)orow + lane) = oa; *((v4u*)(orow + 512) + lane) = os;
}

typedef float f32x16 __attribute__((ext_vector_type(16)));
typedef short bf16x8 __attribute__((ext_vector_type(8)));
typedef __bf16 bf16x2_t __attribute__((ext_vector_type(2)));
typedef float f32x2_t __attribute__((ext_vector_type(2)));
__device__ __forceinline__ unsigned cvtpk(float lo, float hi) { f32x2_t v = {lo, hi}; bf16x2_t b = __builtin_convertvector(v, bf16x2_t); return __builtin_bit_cast(unsigned, b); }
__device__ __forceinline__ void attn_mfma(LAS unsigned char* lds, const bf16* QKV  , bf16* ATT, const float* sinks, int G, int bid) {
    constexpr int KSTR = 144, VSTR = 784, VT_OFF = 384 * KSTR;
    constexpr float LOG2E = 1.4426950408889634f, K1 = 0.125f * LOG2E;
    const int tid = threadIdx.x, lane = tid & 63, w = tid >> 6, r = lane & 31, hi = lane >> 5;
    for (int unit = bid; unit < 256; unit += G) {
        const int kh = unit & 1, qb = (unit >> 1) & 15, b = unit >> 5, kp0 = qb * 128 - 128;
        __syncthreads();
        for (int c = tid; c < 3072; c += 512) { const int rr = c >> 3, ch = c & 7, kp = kp0 + rr; v4u kv = (v4u){0u, 0u, 0u, 0u}, vv = kv;
            if (kp >= 0 && kp < SEQ) { const bf16* src = QKV + (size_t)(b * SEQ + kp) * 768; kv = *(const v4u*)(src + 512 + kh * 64 + ch * 8); vv = *(const v4u*)(src + 640 + kh * 64 + ch * 8); }
            *(LAS v4u*)(lds + rr * KSTR + ch * 16) = kv;
            const int pos = (rr & ~15) | (((rr >> 2) & 1) << 3) | (((rr >> 3) & 1) << 2) | (rr & 3);
            LAS unsigned short* vt = (LAS unsigned short*)(lds + VT_OFF + (ch * 8) * VSTR + pos * 2);
            vt[0 * (VSTR / 2)] = (unsigned short)(vv.x & 0xffffu); vt[1 * (VSTR / 2)] = (unsigned short)(vv.x >> 16); vt[2 * (VSTR / 2)] = (unsigned short)(vv.y & 0xffffu); vt[3 * (VSTR / 2)] = (unsigned short)(vv.y >> 16);
            vt[4 * (VSTR / 2)] = (unsigned short)(vv.z & 0xffffu); vt[5 * (VSTR / 2)] = (unsigned short)(vv.z >> 16); vt[6 * (VSTR / 2)] = (unsigned short)(vv.w & 0xffffu); vt[7 * (VSTR / 2)] = (unsigned short)(vv.w >> 16); }
        __syncthreads();
        const int h = kh * 4 + (w >> 1);
        const float slope2 = exp2f(-(float)(h + 1)) * LOG2E, sink2 = sinks[h] * LOG2E;
        const bool qedge = (qb == 0) || (qb == 15);
        for (int qi2 = 0; qi2 < 2; ++qi2) {
            const int q0 = ((w & 1) * 2 + qi2) * 32, t = qb * 128 + q0 + r;
            bf16x8 qf[4];
            { const bf16* qp = QKV + (size_t)(b * SEQ + t) * 768 + h * 64 + hi * 8;
#pragma unroll
              for (int ks = 0; ks < 4; ++ks) qf[ks] = *(const bf16x8*)(qp + ks * 16); }
            float m2 = sink2, l = 0.f;
            f32x16 o0, o1;
#pragma unroll
            for (int i = 0; i < 16; ++i) { o0[i] = 0.f; o1[i] = 0.f; }
            for (int kb = 0; kb < 9; ++kb) {
                const int jj0 = q0 + kb * 32;
                f32x16 s;
#pragma unroll
                for (int i = 0; i < 16; ++i) s[i] = 0.f;
#pragma unroll
                for (int ks = 0; ks < 4; ++ks) { const bf16x8 kf = *(const LAS bf16x8*)(lds + (jj0 + r) * KSTR + ks * 32 + hi * 16); s = __builtin_amdgcn_mfma_f32_32x32x16_bf16(kf, qf[ks], s, 0, 0, 0); }
                const float relbf = (float)(kb * 32 - 128 - r + 4 * hi);
#pragma unroll
                for (int i = 0; i < 16; ++i) { const float ci = (float)((i & 3) + 8 * (i >> 2)); s[i] = s[i] * K1 - slope2 * fabsf(relbf + ci); }
                if (kb == 0 || kb == 8 || qedge) {
                    const float kpf = (float)(kp0 + jj0 + 4 * hi);
#pragma unroll
                    for (int i = 0; i < 16; ++i) { const float ci = (float)((i & 3) + 8 * (i >> 2)); const bool valid = (fabsf(relbf + ci) <= 128.f) && (kpf + ci >= 0.f) && (kpf + ci < (float)SEQ); s[i] = valid ? s[i] : -1e30f; }
                }
                float bm = s[0];
#pragma unroll
                for (int i = 1; i < 16; ++i) bm = fmaxf(bm, s[i]);
                bm = fmaxf(bm, __shfl_xor(bm, 32));
                const float mn = fmaxf(m2, bm), corr = __builtin_amdgcn_exp2f(m2 - mn);
                m2 = mn;
                float ps = 0.f;
#pragma unroll
                for (int i = 0; i < 16; ++i) { s[i] = __builtin_amdgcn_exp2f(s[i] - mn); ps += s[i]; }
                l = l * corr + ps;
#pragma unroll
                for (int i = 0; i < 16; ++i) { o0[i] *= corr; o1[i] *= corr; }
#pragma unroll
                for (int st = 0; st < 2; ++st) {
                    v4u pw; pw.x = cvtpk(s[8 * st + 0], s[8 * st + 1]); pw.y = cvtpk(s[8 * st + 2], s[8 * st + 3]); pw.z = cvtpk(s[8 * st + 4], s[8 * st + 5]); pw.w = cvtpk(s[8 * st + 6], s[8 * st + 7]);
                    const bf16x8 pf = __builtin_bit_cast(bf16x8, pw);
                    const bf16x8 v0 = *(const LAS bf16x8*)(lds + VT_OFF + r * VSTR + (jj0 + 16 * st + 8 * hi) * 2);
                    const bf16x8 v1 = *(const LAS bf16x8*)(lds + VT_OFF + (32 + r) * VSTR + (jj0 + 16 * st + 8 * hi) * 2);
                    o0 = __builtin_amdgcn_mfma_f32_32x32x16_bf16(v0, pf, o0, 0, 0, 0);
                    o1 = __builtin_amdgcn_mfma_f32_32x32x16_bf16(v1, pf, o1, 0, 0, 0);
                }
            }
            const float ltot = l + __shfl_xor(l, 32) + __builtin_amdgcn_exp2f(sink2 - m2), inv = 1.f / ltot;
            bf16* op = ATT + (size_t)(b * SEQ + t) * AW + h * 64 + 4 * hi;
#pragma unroll
            for (int gq = 0; gq < 4; ++gq) {
                v2u a; a.x = cvtpk(o0[4 * gq] * inv, o0[4 * gq + 1] * inv); a.y = cvtpk(o0[4 * gq + 2] * inv, o0[4 * gq + 3] * inv); *(v2u*)(op + 8 * gq) = a;
                v2u c; c.x = cvtpk(o1[4 * gq] * inv, o1[4 * gq + 1] * inv); c.y = cvtpk(o1[4 * gq + 2] * inv, o1[4 * gq + 3] * inv); *(v2u*)(op + 32 + 8 * gq) = c; }
        }
    }
}

struct SsmP { const float *lam_re, *lam_im, *log_dt, *b_re, *b_im, *c_re, *c_im, *dskip; };
__device__ __forceinline__ float gelu_tanh(float x) { const float z = 1.5957691216f * (x + 0.044715f * x * x * x); return x * __builtin_amdgcn_rcpf(1.f + __expf(-z)); }
__device__ __forceinline__ void lam_of(const SsmP& P, int dg, int p, float& lrdt, float& lidt, float& cr, float& ci) {
    const float lr = fminf(P.lam_re[dg * PS + p], -1e-4f), li = P.lam_im[dg * PS + p], dt = expf(P.log_dt[dg]);
    lrdt = lr * dt; lidt = li * dt;
    const float mag = expf(lrdt), ar = mag * cosf(lidt), ai = mag * sinf(lidt), den = lr * lr + li * li;
    cr = ((ar - 1.f) * lr + ai * li) / den; ci = (ai * lr - (ar - 1.f) * li) / den;
}
__device__ __forceinline__ void apow(float lrdt, float lidt, float k, float& pr, float& pi) { const float m = expf(lrdt * k), a = lidt * k; pr = m * cosf(a); pi = m * sinf(a); }

__device__ __forceinline__ void gen_states_item(const SsmP& P, bf16* MATS, int it, int lane) {
    const int p = it & 63, dir = (it >> 6) & 1, g = it >> 7, dg = dir * NG + g, s = lane >> 1, hh = lane & 1;
    float lrdt, lidt, cr, ci, pr, pi; lam_of(P, dg, p, lrdt, lidt, cr, ci); apow(lrdt, lidt, (float)(dir ? s : TC - 1 - s), pr, pi);
    const float wr = pr * cr - pi * ci, wi = pr * ci + pi * cr;
    const float* brp = P.b_re + (size_t)(dg * PS + p) * HC + hh * 8; const float* bip = P.b_im + (size_t)(dg * PS + p) * HC + hh * 8;
    const f32x4 br0 = *(const f32x4*)brp, br1 = *(const f32x4*)(brp + 4), bi0 = *(const f32x4*)bip, bi1 = *(const f32x4*)(bip + 4);
    const f32x4 re0 = br0 * wr - bi0 * wi, re1 = br1 * wr - bi1 * wi, im0 = bi0 * wr + br0 * wi, im1 = bi1 * wr + br1 * wi;
    v4u o; bf16* dst = MATS + (size_t)(g * 256 + dir * 128 + p) * KS + s * 16 + hh * 8;
    o.x = pk2(re0.x, re0.y); o.y = pk2(re0.z, re0.w); o.z = pk2(re1.x, re1.y); o.w = pk2(re1.z, re1.w); *(v4u*)dst = o;
    o.x = pk2(im0.x, im0.y); o.y = pk2(im0.z, im0.w); o.z = pk2(im1.x, im1.y); o.w = pk2(im1.z, im1.w); *(v4u*)(dst + (size_t)64 * KS) = o;
}
__device__ __forceinline__ void gen_carry_item(const SsmP& P, bf16* MATY, int it, int lane) {
    const int tau = it & 31, dir = (it >> 5) & 1, g = it >> 6, dg = dir * NG + g;
    float lrdt, lidt, cr, ci, pr, pi; lam_of(P, dg, lane, lrdt, lidt, cr, ci); apow(lrdt, lidt, (float)(dir ? TC - tau : tau + 1), pr, pi);
#pragma unroll
    for (int h = 0; h < HC; ++h) { const float c_r = P.c_re[(size_t)(dg * HC + h) * PS + lane], c_i = P.c_im[(size_t)(dg * HC + h) * PS + lane];
        bf16* dst = MATY + (size_t)(g * 512 + tau * 16 + h) * KY + 512 + dir * 128 + lane;
        dst[0] = (bf16)f2bf(c_r * pr - c_i * pi); dst[64] = (bf16)f2bf(-(c_r * pi + c_i * pr)); }
}
__device__ __forceinline__ void gen_toep_item(const SsmP& P, bf16* MATY, LAS float* scr, int it, int lane) {
    const int g = it / 63, dl = it % 63 - 31, k = dl < 0 ? -dl : dl;
    LAS float* Wr = scr; LAS float* Wi = scr + 64; LAS float* Cr = scr + 128; LAS float* Ci = Cr + 16 * 65; LAS float* Br = Ci + 16 * 65; LAS float* Bi = Br + 1024;
    const int h = lane >> 2, q = lane & 3;
    float val[4] = {0.f, 0.f, 0.f, 0.f};
    for (int dir = 0; dir < 2; ++dir) {
        if ((dl > 0 && dir == 1) || (dl < 0 && dir == 0)) continue;
        const int dg = dir * NG + g;
        float lrdt, lidt, cr, ci, pr, pi; lam_of(P, dg, lane, lrdt, lidt, cr, ci); apow(lrdt, lidt, (float)k, pr, pi);
        Wr[lane] = pr * cr - pi * ci; Wi[lane] = pr * ci + pi * cr;
#pragma unroll
        for (int i = 0; i < 16; ++i) { Cr[i * 65 + lane] = P.c_re[(size_t)(dg * HC + i) * PS + lane]; Ci[i * 65 + lane] = P.c_im[(size_t)(dg * HC + i) * PS + lane];
            Br[i * 64 + lane] = P.b_re[(size_t)dg * 1024 + i * 64 + lane]; Bi[i * 64 + lane] = P.b_im[(size_t)dg * 1024 + i * 64 + lane]; }
        LDS_WAIT(); asm volatile("" ::: "memory");
        for (int p = 0; p < 64; ++p) { const float wr = Wr[p], wi = Wi[p], c_r = Cr[h * 65 + p], c_i = Ci[h * 65 + p], tr = c_r * wr - c_i * wi, ti = c_r * wi + c_i * wr;
            const f32x4 b_r = *(const LAS f32x4*)(Br + p * 16 + 4 * q), b_i = *(const LAS f32x4*)(Bi + p * 16 + 4 * q);
            val[0] += tr * b_r.x - ti * b_i.x; val[1] += tr * b_r.y - ti * b_i.y; val[2] += tr * b_r.z - ti * b_i.z; val[3] += tr * b_r.w - ti * b_i.w; }
        LDS_WAIT(); asm volatile("" ::: "memory");
    }
    if (dl == 0) { const float dsk = P.dskip[g * HC + h];
#pragma unroll
        for (int j = 0; j < 4; ++j) if (4 * q + j == h) val[j] += dsk; }
    v2u o; o.x = pk2(val[0], val[1]); o.y = pk2(val[2], val[3]);
    const int t_lo = dl > 0 ? dl : 0, t_hi = dl < 0 ? TC - 1 + dl : TC - 1;
    for (int tau = t_lo; tau <= t_hi; ++tau) { const int s = tau - dl; *(v2u*)(MATY + (size_t)(g * 512 + tau * 16 + h) * KY + s * 16 + 4 * q) = o; }
}

namespace pg8 {
struct GroupOrder {
    int rm, rn, nwg, G, c;
    __device__ void init(int ng, int rm_, int rn_, int G_, int c_) { rm = rm_; rn = rn_; nwg = ng * rm * rn; G = G_; c = c_; }
    __device__ bool next(int i, Unit& u) const { const long L = (long)i * G + c; if (L >= nwg) return false; const int per = rm * rn, gi = (int)L / per, r = (int)L % per; u.pm = gi * rm + r % rm; u.pn = gi * rn + r / rm; return true; }
    __device__ __forceinline__ void a_ready(const Unit&) const {}
    __device__ __forceinline__ void done(const Unit&) const {}
};
struct EpiWin {
    static constexpr bool PERM = true, AFTER_DRAIN = false;
    bf16_t* QKV; bf16_t* UA;
    __device__ __forceinline__ void operator()(const f32x4 (&acc)[2][2][4][2], const Unit& u, int wr, int wc, int fr, int fq) const {
        const int row0 = u.pm * BM + wr * 64 + fr;
#pragma unroll
        for (int ai = 0; ai < 2; ++ai)
#pragma unroll
            for (int m = 0; m < 4; ++m) { const int r = row0 + ai * HALF + m * 16;
#pragma unroll
                for (int bj = 0; bj < 2; ++bj) { const f32x4 v0 = acc[ai][bj][m][0], v1 = acc[ai][bj][m][1];
                    u32x4 w; w.x = cvt_pk_bf16(v0[0], v0[1]); w.y = cvt_pk_bf16(v0[2], v0[3]); w.z = cvt_pk_bf16(v1[0], v1[1]); w.w = cvt_pk_bf16(v1[2], v1[3]);
                    if (u.pn < 3) { *(u32x4*)(QKV + (size_t)r * 768 + u.pn * BM + bj * HALF + wc * 32 + 8 * fq) = w; }
                    else { const int ucol = (u.pn - 3) * BM + bj * HALF + wc * 32 + 8 * fq, gi = ucol >> 4, h0 = ucol & 15, b = r >> 11, t = r & 2047, c = t >> 5, tau = t & 31;
                        *(u32x4*)(UA + (size_t)(gi * 512 + b * 64 + c) * KY + tau * 16 + h0) = w; } } }
    }
};
struct EpiStates {
    static constexpr bool PERM = false, AFTER_DRAIN = true;
    float* SST; bf16_t* UA; const float *lam_re, *lam_im, *log_dt;
    __device__ __forceinline__ void fused(f32x4 (&acc)[2][2][4][2], const Unit& u, int wr, int wc, int fr, int fq, PG8_LAS unsigned char* lds, int wid, int lane) const {
#pragma unroll
        for (int ai = 0; ai < 2; ++ai)
#pragma unroll
            for (int m = 0; m < 4; ++m) { float* rowp = SST + (size_t)(u.pm * BM + ai * HALF + wr * 64 + m * 16 + fr) * 256 + wc * 32 + 4 * fq;
#pragma unroll
                for (int bj = 0; bj < 2; ++bj)
#pragma unroll
                    for (int n = 0; n < 2; ++n) *(f32x4*)(rowp + bj * HALF + n * 16) = acc[ai][bj][m][n]; }
        __threadfence(); __syncthreads();
        const int gi = u.pm >> 1, bl = wid >> 1, dir = wid & 1, dg = dir * NG + gi;
        const float lr = fminf(lam_re[dg * PS + lane], -1e-4f), li = lam_im[dg * PS + lane], dt = expf(log_dt[dg]);
        const float mg = expf(lr * dt * (float)TC), ang = li * dt * (float)TC, a_r = mg * cosf(ang), a_i = mg * sinf(ang);
        const size_t rowbase = (size_t)u.pm * BM + bl * 64;
        const float* sre = SST + rowbase * 256 + dir * 128 + lane;
        bf16_t* cre = UA + rowbase * KY + 512 + dir * 128 + lane;
        float xr = 0.f, xi = 0.f;
#pragma unroll 8
        for (int i = 0; i < NC; ++i) { const int c = dir ? NC - 1 - i : i;
            cre[(size_t)c * KY] = (bf16_t)f2bf(xr); cre[(size_t)c * KY + 64] = (bf16_t)f2bf(xi);
            const float sr = __hip_atomic_load(sre + (size_t)c * 256, __ATOMIC_RELAXED, __HIP_MEMORY_SCOPE_AGENT), si = __hip_atomic_load(sre + (size_t)c * 256 + 64, __ATOMIC_RELAXED, __HIP_MEMORY_SCOPE_AGENT);
            const float nr = a_r * xr - a_i * xi + sr; xi = a_r * xi + a_i * xr + si; xr = nr; }
    }
};
struct EpiSsmOut {
    static constexpr bool PERM = true, AFTER_DRAIN = false;
    bf16_t* YG;
    __device__ __forceinline__ void operator()(const f32x4 (&acc)[2][2][4][2], const Unit& u, int wr, int wc, int fr, int fq) const {
        const int gi = u.pm >> 1;
#pragma unroll
        for (int ai = 0; ai < 2; ++ai)
#pragma unroll
            for (int m = 0; m < 4; ++m) { const int bc = ((u.pm & 1) * BM + ai * HALF + wr * 64 + m * 16 + fr), b = bc >> 6, c = bc & 63;
#pragma unroll
                for (int bj = 0; bj < 2; ++bj) { const int col = (u.pn & 1) * BM + bj * HALF + wc * 32 + 8 * fq, tau = col >> 4, h0 = col & 15;
                    const f32x4 v0 = acc[ai][bj][m][0], v1 = acc[ai][bj][m][1];
                    u32x4 w; w.x = cvt_pk_bf16(gelu_tanh(v0[0]), gelu_tanh(v0[1])); w.y = cvt_pk_bf16(gelu_tanh(v0[2]), gelu_tanh(v0[3]));
                    w.z = cvt_pk_bf16(gelu_tanh(v1[0]), gelu_tanh(v1[1])); w.w = cvt_pk_bf16(gelu_tanh(v1[2]), gelu_tanh(v1[3]));
                    *(u32x4*)(YG + (size_t)(b * SEQ + c * TC + tau) * SWD + gi * 16 + h0) = w; } }
    }
};
}

struct Args { const float* in[26]; float* out; unsigned char* ws; int ph_lo, ph_hi; };
constexpr int N_PHASES = 14;
__global__ void __launch_bounds__(512, 2) mk_fwd(Args args) {
    extern __shared__ __attribute__((aligned(16))) unsigned char lds_raw[];
    LAS unsigned char* lds = (LAS unsigned char*)lds_raw;
    cg::grid_group grid = cg::this_grid();
    const int tid = threadIdx.x, lane = tid & 63, wave = __builtin_amdgcn_readfirstlane(tid >> 6);
    const int G = gridDim.x, bid = blockIdx.x;
    const int gw = bid * 8 + wave, NGW = G * 8;
    unsigned char* ws = args.ws;
    const float* x = args.in[0];
    float* X = args.out;
    bf16* WT1 = (bf16*)(ws + WS_WT1); bf16* WD1 = (bf16*)(ws + WS_WD1); bf16* WT2 = (bf16*)(ws + WS_WT2); bf16* WD2 = (bf16*)(ws + WS_WD2);
    bf16* WIN = (bf16*)(ws + WS_WIN); bf16* WOUT = (bf16*)(ws + WS_WOUT); bf16* WGLU = (bf16*)(ws + WS_WGLU);
    bf16* XA = (bf16*)(ws + WS_XA); bf16* HB = (bf16*)(ws + WS_H); bf16* QKV = (bf16*)(ws + WS_QKV); bf16* ATT = (bf16*)(ws + WS_ATT); bf16* YG = (bf16*)(ws + WS_YG);
    bf16* SB = (bf16*)(ws + WS_S); bf16* MIX = (bf16*)(ws + WS_MIX); bf16* MATS = (bf16*)(ws + WS_MATS); bf16* MATY = (bf16*)(ws + WS_MATY); bf16* UA = (bf16*)(ws + WS_UA); float* SST = (float*)(ws + WS_SST);
    const SsmP SP{args.in[8], args.in[9], args.in[10], args.in[11], args.in[12], args.in[13], args.in[14], args.in[15]};
    const int lo = args.ph_lo, hi = args.ph_hi;
    volatile LAS unsigned* MISC = (volatile LAS unsigned*)(lds + MISC_OFF);
    if (tid < 32) MISC[tid] = 0u;
    __syncthreads();
    XcdBarrier bar = xcd_barrier_post((unsigned*)ws, MISC + 8);
    if (lo < 0) grid.sync();
#define IN(k) (lo <= (k) && (k) < hi)
#define SEAM(k) do { if (IN(k) && IN((k) + 1)) xcd_barrier(bar); } while (0)

    if (IN(0)) {
        LAS float* scr = (LAS float*)(lds + wave * 16384);
        constexpr int I_UP = (DM / 64) * (FF / 32), I_DN = (FF / 64) * (DM / 32), I_IN = (DM / 64) * (INW / 32), I_GLU = (SWD / 64) * (SWD / 32), I_OUT = (DM / 64) * (DM / 32);
        constexpr int NITEMS = 6 * I_UP + I_IN + I_GLU + I_OUT; static_assert(I_UP == I_DN, "");
        for (int it = gw; it < NITEMS; it += NGW) {
            int r = it;
            if (r < I_UP) { p0_transpose_item<1>(args.in[2], DM, FF, WT1, scr, r, lane); continue; } r -= I_UP;
            if (r < I_UP) { p0_transpose_item<2>(args.in[3], DM, FF, WT1, scr, r, lane); continue; } r -= I_UP;
            if (r < I_DN) { p0_transpose_item<0>(args.in[4], FF, DM, WD1, scr, r, lane); continue; } r -= I_DN;
            if (r < I_UP) { p0_transpose_item<1>(args.in[22], DM, FF, WT2, scr, r, lane); continue; } r -= I_UP;
            if (r < I_UP) { p0_transpose_item<2>(args.in[23], DM, FF, WT2, scr, r, lane); continue; } r -= I_UP;
            if (r < I_DN) { p0_transpose_item<0>(args.in[24], FF, DM, WD2, scr, r, lane); continue; } r -= I_DN;
            if (r < I_IN) { p0_transpose_item<0>(args.in[6], DM, INW, WIN, scr, r, lane); continue; } r -= I_IN;
            if (r < I_GLU) { p0_transpose_item<0>(args.in[16], SWD, SWD, WGLU, scr, r, lane); continue; } r -= I_GLU;
            p0_transpose_item<0>(args.in[20], DM, DM, WOUT, scr, r, lane);
        }
        for (int m = gw; m < M; m += NGW) rms_row_to_bf16(x + (size_t)m * DM, args.in[1], XA + (size_t)m * DM, lane);
    }
    SEAM(0);
    if (IN(1)) { pg8::Gemm g{XA, WT1, M, 2 * FF, DM, DM, DM}; pg8::StaticOrder S; S.init(M, 2 * FF, G, bid); pg8::EpiSwiglu E{HB, FF};
        pg8::gemm_phase<pg8::EpiSwiglu, pg8::StaticOrder, true, true>(lds, g, S, E); }
    SEAM(1);
    if (IN(2)) { pg8::Gemm g{HB, WD1, M, DM, FF, FF, FF}; pg8::StaticOrder S; S.init(M, DM, G, bid); pg8::EpiResid E{x, X, 0.5f};
        pg8::gemm_phase<pg8::EpiResid, pg8::StaticOrder, true, true>(lds, g, S, E); }
    SEAM(2);
    if (IN(3)) {
        LAS float* scr = (LAS float*)(lds + wave * 17024);
        for (int it = gw; it < 32 * 63; it += NGW) gen_toep_item(SP, MATY, scr, it, lane);
        for (int it = gw; it < 32 * 2 * 64; it += NGW) gen_states_item(SP, MATS, it, lane);
        for (int it = gw; it < 32 * 2 * 32; it += NGW) gen_carry_item(SP, MATY, it, lane);
        for (int m = gw; m < M; m += NGW) rms_row_to_bf16(X + (size_t)m * DM, args.in[5], XA + (size_t)m * DM, lane);
    }
    SEAM(3);
    if (IN(4)) { pg8::Gemm g{XA, WIN, M, INW, DM, DM, DM}; pg8::StaticOrder S; S.init(M, INW, G, bid); pg8::EpiWin E{QKV, UA};
        pg8::gemm_phase<pg8::EpiWin, pg8::StaticOrder, true, true>(lds, g, S, E); }
    SEAM(4);
    if (IN(5)) {
        { pg8::Gemm g{UA, MATS, 32 * 512, 32 * 256, KS, KY, KS}; pg8::GroupOrder S; S.init(32, 2, 1, G, bid); pg8::EpiStates E{SST, UA, SP.lam_re, SP.lam_im, SP.log_dt};
          if (G >= 64) pg8::gemm_phase<pg8::EpiStates, pg8::GroupOrder, false, true>(lds, g, S, E); }
        attn_mfma(lds, QKV, ATT, args.in[7], G, bid);
    }
    SEAM(5);
    if (IN(6)) { pg8::Gemm g{UA, MATY, 32 * 512, 32 * 512, KY, KY, KY}; pg8::GroupOrder S; S.init(32, 2, 2, G, bid); pg8::EpiSsmOut E{YG};
        pg8::gemm_phase<pg8::EpiSsmOut, pg8::GroupOrder, true, true>(lds, g, S, E); }
    SEAM(6);
    if (IN(7)) { pg8::Gemm g{YG, WGLU, M, SWD, SWD, SWD, SWD}; pg8::StaticOrder S; S.init(M, SWD, G, bid); pg8::EpiGlu E{YG, SB, args.in[17]};
        pg8::gemm_phase<pg8::EpiGlu, pg8::StaticOrder, true, true>(lds, g, S, E); }
    SEAM(7);
    if (IN(8)) { for (int m = gw; m < M; m += NGW) mix_row(ATT + (size_t)m * AW, SB + (size_t)m * SWD, args.in[18], args.in[19], MIX + (size_t)m * DM, lane); }
    SEAM(8);
    if (IN(9)) { pg8::Gemm g{MIX, WOUT, M, DM, DM, DM, DM}; pg8::StaticOrder S; S.init(M, DM, G, bid); pg8::EpiResid E{X, X, 1.0f};
        pg8::gemm_phase<pg8::EpiResid, pg8::StaticOrder, true, true>(lds, g, S, E); }
    SEAM(9);
    if (IN(10)) { for (int m = gw; m < M; m += NGW) rms_row_to_bf16(X + (size_t)m * DM, args.in[21], XA + (size_t)m * DM, lane); }
    SEAM(10);
    if (IN(11)) { pg8::Gemm g{XA, WT2, M, 2 * FF, DM, DM, DM}; pg8::StaticOrder S; S.init(M, 2 * FF, G, bid); pg8::EpiSwiglu E{HB, FF};
        pg8::gemm_phase<pg8::EpiSwiglu, pg8::StaticOrder, true, true>(lds, g, S, E); }
    SEAM(11);
    if (IN(12)) { pg8::Gemm g{HB, WD2, M, DM, FF, FF, FF}; pg8::StaticOrder S; S.init(M, DM, G, bid); pg8::EpiResid E{X, X, 0.5f};
        pg8::gemm_phase<pg8::EpiResid, pg8::StaticOrder, true, true>(lds, g, S, E); }
    SEAM(12);
    if (IN(13)) { for (int m = gw; m < M; m += NGW) rms_row_f32(X + (size_t)m * DM, args.in[25], lane); }
#undef IN
#undef SEAM
}

extern "C" void kernel_launch(void* const* d_in, const int* in_sizes, int n_in, void* d_out, int out_size, void* d_ws, size_t ws_size, hipStream_t stream) {
    static int grid = 0;
    if (grid == 0) {
        if (n_in != 26 || in_sizes[0] != M * DM || out_size != M * DM || ws_size < WS_END) { fprintf(stderr, "kernel_launch: unexpected shapes n_in %d in0 %d out %d ws %zu\n", n_in, n_in > 0 ? in_sizes[0] : -1, out_size, ws_size); grid = -1; return; }
        int dev = 0, cus = 0, per_cu = 0;
        (void)hipGetDevice(&dev); (void)hipDeviceGetAttribute(&cus, hipDeviceAttributeMultiprocessorCount, dev);
        if (hipFuncSetAttribute((const void*)mk_fwd, hipFuncAttributeMaxDynamicSharedMemorySize, LDS_BYTES) != hipSuccess) { fprintf(stderr, "kernel_launch: hipFuncSetAttribute failed\n"); grid = -1; return; }
        if (hipOccupancyMaxActiveBlocksPerMultiprocessor(&per_cu, (const void*)mk_fwd, 512, LDS_BYTES) != hipSuccess || per_cu < 1) { fprintf(stderr, "kernel_launch: occupancy query says %d\n", per_cu); per_cu = 1; }
        (void)hipGetLastError();
        grid = cus * per_cu;
        fprintf(stderr, "kernel_launch: grid %d (cus %d per_cu %d)\n", grid, cus, per_cu);
    }
    if (grid < 0) return;
    if (hipMemsetAsync(d_ws, 0, CTL_ZERO_BYTES, stream) != hipSuccess) { fprintf(stderr, "kernel_launch: hipMemsetAsync failed\n"); return; }
    Args a{};
    for (int i = 0; i < 26; ++i) a.in[i] = (const float*)d_in[i];
    a.out = (float*)d_out; a.ws = (unsigned char*)d_ws;
#if MK_MULTI
    for (int ph = 0; ph < N_PHASES; ++ph) { a.ph_lo = ph; a.ph_hi = ph + 1; hipLaunchKernelGGL(mk_fwd, dim3(grid), dim3(512), LDS_BYTES, stream, a); }
#else
    a.ph_lo = 0; a.ph_hi = N_PHASES;
    void* kargs[] = {&a};
    hipError_t e = hipLaunchCooperativeKernel((const void*)mk_fwd, dim3(grid), dim3(512), kargs, LDS_BYTES, stream);
    if (e != hipSuccess) fprintf(stderr, "cooperative launch failed: %s (grid %d)\n", hipGetErrorString(e), grid);
#endif
}
```

```cpp
#include <hip/hip_runtime.h>
#include <hip/hip_cooperative_groups.h>
#include <cstdio>
#include <cstdint>
namespace cg = cooperative_groups;
#define MK_MULTI 0
namespace pg8 {
#define PG8_LAS __attribute__((address_space(3)))
typedef unsigned short bf16_t;
typedef short bf16x8 __attribute__((ext_vector_type(8)));
typedef float f32x4 __attribute__((ext_vector_type(4)));
typedef unsigned u32x4 __attribute__((ext_vector_type(4)));
constexpr int BM = 256, BK = 64, HALF = 128, HTB = HALF * BK * 2  , STAGE_BYTES = 8 * HTB, NXCD = 8, WGM = 8;

__host__ __device__ __forceinline__ int lds_byte(int r, int c) { const int st = (r >> 4) * 2 + (c >> 5), rr = r & 15, cc = c & 31, ob = rr * 64 + cc * 2; return st * 1024 + (ob ^ (((ob >> 9) & 1) << 5)); }
__host__ __device__ __forceinline__ void stage_rc(int b, int& R, int& C) { const int st = b / 1024, sb = b % 1024, swz = sb ^ (((sb >> 9) & 1) << 5); R = (st >> 1) * 16 + swz / 64; C = (st & 1) * 32 + (swz % 64) / 2; }
__host__ __device__ __forceinline__ int perm32(int rho) { const int n = rho >> 4, i = rho & 15; return 8 * (i >> 2) + 4 * n + (i & 3); }

struct Unit { int pm, pn; };
struct Gemm { const bf16_t* A; const bf16_t* Bt; int M, N, K, lda, ldb; };

struct StaticOrder {
    int nM, nN, nwg, G, c;
    __host__ __device__ void init(int M, int N, int G_, int c_) { nM = M / BM; nN = N / BM; nwg = nM * nN; G = G_; c = c_; }
    __host__ __device__ bool next(int i, Unit& u) const {
        const long L = (long)i * G + c; if (L >= nwg) return false;
        int wgid = (int)L; { const int q = nwg / NXCD, r = nwg % NXCD, xcd = wgid % NXCD, off = wgid / NXCD; wgid = (xcd < r ? xcd * (q + 1) : r * (q + 1) + (xcd - r) * q) + off; }
        const int nig = WGM * nN, gid = wgid / nig, fm = gid * WGM, gsz = (nM - fm) < WGM ? (nM - fm) : WGM;
        u.pm = fm + ((wgid % nig) % gsz); u.pn = (wgid % nig) / gsz; return true;
    }
    __device__ __forceinline__ void a_ready(const Unit&) const {}
    __device__ __forceinline__ void done(const Unit&) const {}
};

__device__ __forceinline__ unsigned cvt_pk_bf16(float lo, float hi) { unsigned r; asm volatile("v_cvt_pk_bf16_f32 %0, %1, %2" : "=v"(r) : "v"(lo), "v"(hi)); return r; }
typedef float f32x2 __attribute__((ext_vector_type(2)));
__device__ __forceinline__ f32x2 gelu_pk(f32x2 v) {
    const f32x2 av = __builtin_elementwise_abs(v), d = av * 0.2316418882f + 1.0f;
    f32x2 t; t.x = __builtin_amdgcn_rcpf(d.x); t.y = __builtin_amdgcn_rcpf(d.y);
    f32x2 q = t * 0.5307027145f + (-0.7265760135f); q = q * t + 0.7107068705f; q = q * t + (-0.142248368f); q = q * t + 0.127414796f; q = q * t;
    const f32x2 s = (v * v) * (-0.72134752044f);
    f32x2 e; e.x = __builtin_amdgcn_exp2f(s.x); e.y = __builtin_amdgcn_exp2f(s.y);
    const f32x2 m = v * (q * e), r = v - m;
    f32x2 o; o.x = v.x < 0.f ? m.x : r.x; o.y = v.y < 0.f ? m.y : r.y; return o;
}

template <int ACT  > struct EpiBf16 {
    static constexpr bool PERM = true, AFTER_DRAIN = false; static_assert(ACT == 0 || ACT == 1, "EpiBf16: ACT is 0 (none) or 1 (gelu_pk)");
    bf16_t* O; int ldc; const float* bias; int split_cols; size_t split_stride; float scale0;
    __device__ __forceinline__ void operator()(const f32x4 (&acc)[2][2][4][2], const Unit& u, int wr, int wc, int fr, int fq) const {
        const int row0 = u.pm * BM + wr * 64 + fr; int colt = u.pn * BM; bf16_t* base = O;
        float sc = 1.f; if (split_cols) { const int t = colt / split_cols; base += (size_t)t * split_stride; colt -= t * split_cols; if (t == 0) sc = scale0; }
        const int col0 = colt + wc * 32 + 8 * fq, bcol0 = u.pn * BM + wc * 32 + 8 * fq;
        f32x4 bv[2][2];
#pragma unroll
        for (int bj = 0; bj < 2; ++bj)
#pragma unroll
            for (int n = 0; n < 2; ++n) bv[bj][n] = bias ? *(const f32x4*)(bias + bcol0 + bj * HALF + 4 * n) : (f32x4){0.f, 0.f, 0.f, 0.f};
#pragma unroll
        for (int ai = 0; ai < 2; ++ai)
#pragma unroll
            for (int m = 0; m < 4; ++m) { bf16_t* rowp = base + (size_t)(row0 + ai * HALF + m * 16) * ldc + col0;
#pragma unroll
                for (int bj = 0; bj < 2; ++bj) { f32x4 v0 = acc[ai][bj][m][0] + bv[bj][0], v1 = acc[ai][bj][m][1] + bv[bj][1];
                    if (ACT == 1) { f32x2 a = gelu_pk((f32x2){v0[0], v0[1]}), b = gelu_pk((f32x2){v0[2], v0[3]}), c = gelu_pk((f32x2){v1[0], v1[1]}), d = gelu_pk((f32x2){v1[2], v1[3]});
                        v0 = (f32x4){a.x, a.y, b.x, b.y}; v1 = (f32x4){c.x, c.y, d.x, d.y}; }
                    v0 = v0 * sc; v1 = v1 * sc; u32x4 w; w.x = cvt_pk_bf16(v0[0], v0[1]); w.y = cvt_pk_bf16(v0[2], v0[3]); w.z = cvt_pk_bf16(v1[0], v1[1]); w.w = cvt_pk_bf16(v1[2], v1[3]);
                    *(u32x4*)(rowp + bj * HALF) = w; } }
    }
};
template <class Epi, class Sched, bool ALIGN_EPI = false, bool SP2 = false>
__device__ __forceinline__ void gemm_phase(PG8_LAS unsigned char* lds, const Gemm g, const Sched& S, const Epi& E) {
    const int tid = threadIdx.x, wid = __builtin_amdgcn_readfirstlane(tid >> 6), lane = tid & 63, wr = wid >> 2, wc = wid & 3, fr = lane & 15, fq = lane >> 4;
    const int K = g.K, nt = K / BK;
    unsigned voffA[2], voffB[2];
#pragma unroll
    for (int i = 0; i < 2; ++i) { int R, C; stage_rc(tid * 16 + i * 8192, R, C); const int Rb = Epi::PERM ? ((R & ~31) + perm32(R & 31)) : R;
        voffA[i] = (unsigned)(R * g.lda + C) * 2u; voffB[i] = (unsigned)(Rb * g.ldb + C) * 2u; }
    const size_t kstep = (size_t)(BK * 2);
    const size_t hstepA = (size_t)HALF * g.lda * 2, hstepB = (size_t)HALF * g.ldb * 2;
    const size_t tstepA = 2 * hstepA, tstepB = 2 * hstepB;
    const unsigned ldsw = (unsigned)wid * 1024u;
    const int aoff = lds_byte(wr * 64 + fr, fq * 8), boff = lds_byte(wc * 32 + fr, fq * 8);
#define PG8_SA(b, h) (((b) * 2 + (h)) * HTB)
#define PG8_SB(b, h) ((4 + (b) * 2 + (h)) * HTB)
#define PG8_STAGE(bufoff, gbase, voff) do { _Pragma("unroll") for (int _i = 0; _i < 2; ++_i) \
        __builtin_amdgcn_global_load_lds((const unsigned*)((const char*)(gbase) + (voff)[_i]), (PG8_LAS unsigned*)(lds + (bufoff) + ldsw + _i * 8192), 16, 0, 0); } while (0)
#define PG8_LDA(dst, b, h) do { _Pragma("unroll") for (int m = 0; m < 4; ++m) _Pragma("unroll") for (int k = 0; k < 2; ++k) dst[m][k] = *(const PG8_LAS bf16x8*)(lds + PG8_SA(b, h) + aoff + m * 2048 + k * 1024); } while (0)
#define PG8_LDB(dst, b, h) do { _Pragma("unroll") for (int n = 0; n < 2; ++n) _Pragma("unroll") for (int k = 0; k < 2; ++k) dst[n][k] = *(const PG8_LAS bf16x8*)(lds + PG8_SB(b, h) + boff + n * 2048 + k * 1024); } while (0)
#define PG8_MMA(ai, bj, At, Bt) do { __builtin_amdgcn_s_setprio(1); _Pragma("unroll") for (int m = 0; m < 4; ++m) _Pragma("unroll") for (int n = 0; n < 2; ++n) _Pragma("unroll") for (int k = 0; k < 2; ++k) \
        acc[ai][bj][m][n] = __builtin_amdgcn_mfma_f32_16x16x32_bf16(Bt[n][k], At[m][k], acc[ai][bj][m][n], 0, 0, 0); __builtin_amdgcn_s_setprio(0); } while (0)
#define PG8_WAIT_V(n) asm volatile("s_waitcnt vmcnt(" #n ")" ::: "memory")
#define PG8_WAIT_L(n) asm volatile("s_waitcnt lgkmcnt(" #n ")" ::: "memory")
#define PG8_BAR __builtin_amdgcn_s_barrier()
#define PG8_SCHED __builtin_amdgcn_sched_barrier(0)
    Unit cur, nxt; int ui = 0;
    if (!S.next(0, cur)) return;
    f32x4 acc[2][2][4][2];
#pragma unroll
    for (int a = 0; a < 2; ++a)
#pragma unroll
        for (int b = 0; b < 2; ++b)
#pragma unroll
            for (int m = 0; m < 4; ++m)
#pragma unroll
                for (int n = 0; n < 2; ++n) acc[a][b][m][n] = (f32x4){0.f, 0.f, 0.f, 0.f};
    bf16x8 At[4][2], B0[2][2], B1[2][2];
    const char* cA = (const char*)g.A + (size_t)cur.pm * tstepA; const char* cB = (const char*)g.Bt + (size_t)cur.pn * tstepB;
    S.a_ready(cur);
    if constexpr (SP2) {
        PG8_STAGE(PG8_SB(0, 0), cB, voffB); PG8_STAGE(PG8_SB(0, 1), cB + hstepB, voffB); PG8_STAGE(PG8_SA(0, 0), cA, voffA); PG8_STAGE(PG8_SA(0, 1), cA + hstepA, voffA);
        if (wr == 1) PG8_BAR;
        PG8_WAIT_V(2); PG8_BAR;
        PG8_STAGE(PG8_SB(1, 0), cB + kstep, voffB); PG8_STAGE(PG8_SA(1, 0), cA + kstep, voffA); PG8_STAGE(PG8_SB(1, 1), cB + hstepB + kstep, voffB);
        PG8_WAIT_V(6); PG8_BAR;
    } else {
        PG8_STAGE(PG8_SB(0, 0), cB, voffB); PG8_STAGE(PG8_SA(0, 0), cA, voffA); PG8_STAGE(PG8_SB(0, 1), cB + hstepB, voffB); PG8_STAGE(PG8_SA(0, 1), cA + hstepA, voffA);
        if (wr == 1) PG8_BAR;
        PG8_WAIT_V(4); PG8_BAR;
        PG8_STAGE(PG8_SB(1, 0), cB + kstep, voffB); PG8_STAGE(PG8_SA(1, 0), cA + kstep, voffA); PG8_STAGE(PG8_SB(1, 1), cB + hstepB + kstep, voffB);
        PG8_WAIT_V(6); PG8_BAR;
    }
    for (;;) {
        const bool has_next = S.next(ui + 1, nxt);
        const char* nA = has_next ? (const char*)g.A + (size_t)nxt.pm * tstepA : cA; const char* nB = has_next ? (const char*)g.Bt + (size_t)nxt.pn * tstepB : cB;
        for (int t = 0; t < nt; t += 2) {
            if constexpr (Epi::MIDK) { if (t == nt / 2) E.midk(acc, cur, wr, fr); }
            const bool last = (t == nt - 2);
            const char* a1 = cA + (size_t)(t + 1) * kstep;
            const char* a2 = last ? nA : cA + (size_t)(t + 2) * kstep; const char* b2 = last ? nB : cB + (size_t)(t + 2) * kstep;
            const char* a3 = a2 + kstep; const char* b3 = b2 + kstep;
            if (last && has_next) S.a_ready(nxt);
            if constexpr (SP2) {
            PG8_LDB(B0, 0, 0); PG8_LDB(B1, 0, 1); PG8_SCHED; PG8_LDA(At, 0, 0); PG8_STAGE(PG8_SA(1, 1), a1 + hstepA, voffA);
            PG8_WAIT_V(8); PG8_WAIT_L(0); PG8_BAR; PG8_MMA(0, 0, At, B0); PG8_MMA(0, 1, At, B1); PG8_BAR; PG8_SCHED;
            PG8_LDA(At, 0, 1); PG8_STAGE(PG8_SB(0, 0), b2, voffB); PG8_STAGE(PG8_SB(0, 1), b2 + hstepB, voffB); PG8_STAGE(PG8_SA(0, 0), a2, voffA);
            PG8_WAIT_V(8); PG8_WAIT_L(0); PG8_BAR; PG8_MMA(1, 0, At, B0); PG8_MMA(1, 1, At, B1); PG8_BAR; PG8_SCHED;
            PG8_LDB(B0, 1, 0); PG8_LDB(B1, 1, 1); PG8_SCHED; PG8_LDA(At, 1, 0); PG8_STAGE(PG8_SA(0, 1), a2 + hstepA, voffA);
            PG8_WAIT_V(8); PG8_WAIT_L(0); PG8_BAR; PG8_MMA(0, 0, At, B0); PG8_MMA(0, 1, At, B1); PG8_BAR; PG8_SCHED;
            PG8_LDA(At, 1, 1); PG8_STAGE(PG8_SB(1, 0), b3, voffB); PG8_STAGE(PG8_SB(1, 1), b3 + hstepB, voffB); PG8_STAGE(PG8_SA(1, 0), a3, voffA);
            PG8_WAIT_V(8); PG8_WAIT_L(0); PG8_BAR; PG8_MMA(1, 0, At, B0); PG8_MMA(1, 1, At, B1); PG8_BAR; PG8_SCHED;
            } else {
            PG8_LDB(B0, 0, 0); PG8_SCHED; PG8_LDA(At, 0, 0); PG8_STAGE(PG8_SA(1, 1), a1 + hstepA, voffA);
            PG8_WAIT_L(8); PG8_BAR; PG8_WAIT_L(0); PG8_MMA(0, 0, At, B0); PG8_BAR; PG8_SCHED;
            PG8_LDB(B1, 0, 1); PG8_STAGE(PG8_SB(0, 0), b2, voffB);
            PG8_BAR; PG8_WAIT_L(0); PG8_MMA(0, 1, At, B1); PG8_BAR;
            PG8_LDA(At, 0, 1); PG8_STAGE(PG8_SA(0, 0), a2, voffA);
            PG8_BAR; PG8_WAIT_L(0); PG8_MMA(1, 0, At, B0); PG8_BAR; PG8_SCHED;
            PG8_STAGE(PG8_SB(0, 1), b2 + hstepB, voffB);
            PG8_WAIT_V(6); PG8_BAR; PG8_MMA(1, 1, At, B1); PG8_BAR;
            PG8_LDB(B0, 1, 0); PG8_SCHED; PG8_LDA(At, 1, 0); PG8_STAGE(PG8_SA(0, 1), a2 + hstepA, voffA);
            PG8_WAIT_L(8); PG8_BAR; PG8_WAIT_L(0); PG8_MMA(0, 0, At, B0); PG8_BAR; PG8_SCHED;
            PG8_LDB(B1, 1, 1); PG8_STAGE(PG8_SB(1, 0), b3, voffB);
            PG8_BAR; PG8_WAIT_L(0); PG8_MMA(0, 1, At, B1); PG8_BAR;
            PG8_LDA(At, 1, 1); PG8_STAGE(PG8_SA(1, 0), a3, voffA);
            PG8_BAR; PG8_WAIT_L(0); PG8_MMA(1, 0, At, B0); PG8_BAR; PG8_SCHED;
            PG8_STAGE(PG8_SB(1, 1), b3 + hstepB, voffB);
            PG8_WAIT_V(6); PG8_BAR; PG8_MMA(1, 1, At, B1); PG8_BAR;
            }
        }
        if constexpr (ALIGN_EPI) { if (wr == 0) PG8_BAR; }
        if constexpr (!Epi::AFTER_DRAIN) { E(acc, cur, wr, wc, fr, fq); S.done(cur); }
        if (!has_next) break;
#pragma unroll
        for (int a = 0; a < 2; ++a)
#pragma unroll
            for (int b = 0; b < 2; ++b)
#pragma unroll
                for (int m = 0; m < 4; ++m)
#pragma unroll
                    for (int n = 0; n < 2; ++n) acc[a][b][m][n] = (f32x4){0.f, 0.f, 0.f, 0.f};
        cur = nxt; cA = nA; cB = nB; ++ui;
        if constexpr (ALIGN_EPI) { if (wr == 1) PG8_BAR; }
    }
    PG8_WAIT_V(0);
    if constexpr (!ALIGN_EPI) { if (wr == 0) PG8_BAR; }
    PG8_BAR;
    if constexpr (Epi::AFTER_DRAIN) { E.fused(acc, cur, wr, wc, fr, fq, lds, wid, lane); S.done(cur); }
#undef PG8_SA
#undef PG8_SB
#undef PG8_STAGE
#undef PG8_LDA
#undef PG8_LDB
#undef PG8_MMA
#undef PG8_WAIT_V
#undef PG8_WAIT_L
#undef PG8_BAR
#undef PG8_SCHED
}
}

#define GAS __attribute__((address_space(1)))
#define LAS __attribute__((address_space(3)))
typedef unsigned short bf16;
typedef unsigned v4u __attribute__((ext_vector_type(4)));
typedef unsigned v2u __attribute__((ext_vector_type(2)));
typedef float f32x4 __attribute__((ext_vector_type(4)));

#ifndef MK_MULTI
#define MK_MULTI 0
#endif

constexpr int BATCH = 8, SEQ = 2048, DM = 1024, M = BATCH * SEQ;
constexpr int NH = 8, HD = 64, AW = 512, SWD = 512, NG = 32, HC = 16, PS = 64, INW = 1280, FF = 2816;
constexpr float EPS = 1e-6f;
constexpr size_t MiB = 1u << 20;
constexpr size_t WS_WT1 = 2 * MiB, WS_WD1 = 14 * MiB, WS_WT2 = 20 * MiB, WS_WD2 = 32 * MiB, WS_WIN = 38 * MiB, WS_WOUT = 41 * MiB, WS_WGLU = 43 * MiB;
constexpr size_t WS_MATS = 44 * MiB;
constexpr size_t WS_SS1 = 52 * MiB, WS_SS2 = 53 * MiB;
constexpr size_t WS_SSA = 54 * MiB, WS_SSS = 55 * MiB;
constexpr size_t WS_XA = 64 * MiB;
constexpr size_t WS_YG = 64 * MiB;
constexpr size_t WS_H = 96 * MiB;
constexpr size_t WS_SST = 96 * MiB;
constexpr size_t WS_MIX = 112 * MiB;
constexpr size_t WS_UA = 168 * MiB;
constexpr size_t WS_QKV = 192 * MiB;
constexpr size_t WS_MATY = 216 * MiB;
constexpr size_t WS_END = 256 * MiB;
constexpr int TC = 32, NC = SEQ / TC, KY = 16 * TC + 256, KS = 16 * TC;
constexpr int LDS_BYTES = 147456, MISC_OFF = 147328;
constexpr size_t CTL_ZERO_BYTES = 16384;

__device__ __forceinline__ unsigned f2bf(float f) { unsigned u = __builtin_bit_cast(unsigned, f); return (u + 0x7fffu + ((u >> 16) & 1u)) >> 16; }
__device__ __forceinline__ unsigned pk2(float lo, float hi) { return f2bf(lo) | (f2bf(hi) << 16); }
__device__ __forceinline__ float bflo(unsigned w) { return __builtin_bit_cast(float, w << 16); }
__device__ __forceinline__ float bfhi(unsigned w) { return __builtin_bit_cast(float, w & 0xffff0000u); }
#define LDS_WAIT() asm volatile("s_waitcnt lgkmcnt(0)" ::: "memory")
__device__ __forceinline__ float wave_sum(float v) {
#pragma unroll
    for (int o = 1; o < 64; o <<= 1) v += __shfl_xor(v, o);
    return v;
}
__device__ __forceinline__ float sigmoidf_(float x) { return __builtin_amdgcn_rcpf(1.f + __expf(-x)); }

#define XB_TMO      128
#define XB_XCNT(j)  (256  + 64 * (j))
#define XB_XSUB(j)  (1280 + 64 * (j))
#define XB_XGEN(j)  (2304 + 64 * (j))
#define XB_TOP      3328
#define XB_TOPGEN   3392
#define XCD_BAR_WORDS 3456
#define XB_SPIN_CAP (1u << 18)

__device__ __forceinline__ unsigned xb_ld(unsigned* p)              { return __hip_atomic_load(p, __ATOMIC_RELAXED, __HIP_MEMORY_SCOPE_AGENT); }
__device__ __forceinline__ unsigned xb_add(unsigned* p, unsigned v) { return __hip_atomic_fetch_add(p, v, __ATOMIC_RELAXED, __HIP_MEMORY_SCOPE_AGENT); }
__device__ __forceinline__ unsigned xb_xcc_id() { return (unsigned)__builtin_amdgcn_s_getreg((3 << 11) | 20) & 0xFu; }
#define XB_SPIN(cond, bar) do { unsigned _sp = 0; while (cond) { __builtin_amdgcn_s_sleep(1); \
    if ((++_sp & 255u) == 0u) { if (xb_ld(&(bar)[XB_TMO])) break; if (_sp > XB_SPIN_CAP) { atomicAdd(&(bar)[XB_TMO], 1u); break; } } } } while (0)

struct XcdBarrier {
    unsigned* bar; unsigned x;
    volatile LAS unsigned* st;
};

__device__ __forceinline__ XcdBarrier xcd_barrier_post(unsigned* bar, volatile LAS unsigned* st) {
    XcdBarrier b; b.bar = bar; b.x = xb_xcc_id(); b.st = st;
    if (threadIdx.x == 0) (void)xb_add(&bar[XB_XCNT(b.x)], 1u);
    return b;
}
__device__ __forceinline__ void xcd_barrier_complete(unsigned* bar, unsigned x, unsigned& nloc, unsigned& nx) {
    const unsigned G = gridDim.x * gridDim.y * gridDim.z;
    unsigned sum, cnt, mine, sp = 0u;
    for (;;) {
        sum = 0u; cnt = 0u; mine = 0u;
#pragma unroll
        for (unsigned j = 0; j < 16; ++j) { const unsigned c = xb_ld(&bar[XB_XCNT(j)]); sum += c; cnt += (c > 0u) ? 1u : 0u; mine = (j == x) ? c : mine; }
        if (sum == G) break;
        __builtin_amdgcn_s_sleep(1);
        if ((++sp & 255u) == 0u) { if (xb_ld(&bar[XB_TMO])) break; if (sp > XB_SPIN_CAP) { atomicAdd(&bar[XB_TMO], 1u); break; } }
    }
    nloc = mine > 0u ? mine : 1u; nx = cnt > 0u ? cnt : 1u;
}

__device__ __forceinline__ void xcd_barrier(const XcdBarrier& b) {
    asm volatile("s_waitcnt vmcnt(0)" ::: "memory");
    __syncthreads();
    if (threadIdx.x == 0) {
        unsigned* bar = b.bar;
        __builtin_amdgcn_s_waitcnt(0);
        unsigned nloc = b.st[0], nx = b.st[1];
        if (nloc == 0u) { xcd_barrier_complete(bar, b.x, nloc, nx); b.st[0] = nloc; b.st[1] = nx; }
        const unsigned old = xb_add(&bar[XB_XSUB(b.x)], 1u);
        const unsigned gen = old / nloc;
        if (old + 1u == (gen + 1u) * nloc) {
            __builtin_amdgcn_fence(__ATOMIC_RELEASE, "agent");
            asm volatile("s_waitcnt vmcnt(0)" ::: "memory");
            const unsigned og = xb_add(&bar[XB_TOP], 1u);
            const unsigned tg = og / nx;
            if (og + 1u == (tg + 1u) * nx) xb_add(&bar[XB_TOPGEN], 1u);
            else XB_SPIN(xb_ld(&bar[XB_TOPGEN]) == tg, bar);
            __builtin_amdgcn_fence(__ATOMIC_ACQUIRE, "agent");
            xb_add(&bar[XB_XGEN(b.x)], 1u);
            asm volatile("s_waitcnt vmcnt(0)" ::: "memory");
        } else {
            XB_SPIN(xb_ld(&bar[XB_XGEN(b.x)]) == gen, bar);
            __builtin_amdgcn_fence(__ATOMIC_ACQUIRE, "agent");
            asm volatile("s_waitcnt vmcnt(0)" ::: "memory");
        }
    }
    __syncthreads();
}

namespace pg8 {
__device__ __forceinline__ float rstd16(const float* ss) { const f32x4 a = *(const f32x4*)ss, b = *(const f32x4*)(ss + 4), c = *(const f32x4*)(ss + 8), d = *(const f32x4*)(ss + 12);
    return 1.f / sqrtf((((a.x + a.y) + (a.z + a.w)) + ((b.x + b.y) + (b.z + b.w)) + ((c.x + c.y) + (c.z + c.w)) + ((d.x + d.y) + (d.z + d.w))) * (1.f / 1024.f) + EPS); }
__device__ __forceinline__ float rstd8(const float* ss) { const f32x4 a = *(const f32x4*)ss, b = *(const f32x4*)(ss + 4);
    return 1.f / sqrtf((((a.x + a.y) + (a.z + a.w)) + ((b.x + b.y) + (b.z + b.w))) * (1.f / 512.f) + EPS); }
template <bool SCALE> struct EpiSwiglu {
    static constexpr bool PERM = true, AFTER_DRAIN = false, MIDK = false;
    bf16_t* H; int ldh; const float* SS;
    __device__ __forceinline__ void operator()(const f32x4 (&acc)[2][2][4][2], const Unit& u, int wr, int wc, int fr, int fq) const {
        const int row0 = u.pm * BM + wr * 64 + fr, col0 = u.pn * HALF + wc * 32 + 8 * fq;
#pragma unroll
        for (int ai = 0; ai < 2; ++ai)
#pragma unroll
            for (int m = 0; m < 4; ++m) {
                if (SCALE) asm volatile("" ::: "memory");
                const int row = row0 + ai * HALF + m * 16;
                const float rs = SCALE ? rstd16(SS + (size_t)row * 16) : 1.f;
                bf16_t* rowp = H + (size_t)row * ldh + col0;
                float hv[8];
#pragma unroll
                for (int n = 0; n < 2; ++n)
#pragma unroll
                    for (int i = 0; i < 4; ++i) { const float g = acc[ai][0][m][n][i] * rs, up = acc[ai][1][m][n][i] * rs; hv[n * 4 + i] = g * __builtin_amdgcn_rcpf(1.f + __expf(-g)) * up; }
                u32x4 w; w.x = cvt_pk_bf16(hv[0], hv[1]); w.y = cvt_pk_bf16(hv[2], hv[3]); w.z = cvt_pk_bf16(hv[4], hv[5]); w.w = cvt_pk_bf16(hv[6], hv[7]);
                *(u32x4*)rowp = w;
            }
    }
};
struct EpiResid {
    static constexpr bool PERM = false, AFTER_DRAIN = false, MIDK = false;
    const float* base; float* out; float alpha;
    __device__ __forceinline__ void operator()(const f32x4 (&acc)[2][2][4][2], const Unit& u, int wr, int wc, int fr, int fq) const {
        const int col0 = u.pn * BM + wc * 32 + 4 * fq;
#pragma unroll
        for (int ai = 0; ai < 2; ++ai)
#pragma unroll
            for (int m = 0; m < 4; ++m) {
                const size_t off = (size_t)(u.pm * BM + ai * HALF + wr * 64 + m * 16 + fr) * 1024 + col0;
#pragma unroll
                for (int bj = 0; bj < 2; ++bj)
#pragma unroll
                    for (int n = 0; n < 2; ++n) { const f32x4 b = *(const f32x4*)(base + off + bj * HALF + n * 16); *(f32x4*)(out + off + bj * HALF + n * 16) = b + acc[ai][bj][m][n] * alpha; }
            }
    }
};
template <bool WOUT> struct EpiResidNorm {
    static constexpr bool PERM = false, AFTER_DRAIN = false, MIDK = WOUT;
    const float* base; float* out; float alpha; const float* gain; bf16_t* XG; float* SS; const PG8_LAS float* TAB;
    __device__ __forceinline__ void midk(f32x4 (&acc)[2][2][4][2], const Unit& u, int wr, int fr) const {
#pragma unroll
        for (int ai = 0; ai < 2; ++ai)
#pragma unroll
            for (int m = 0; m < 4; ++m) { const float ratio = TAB[(ai * HALF + wr * 64 + m * 16 + fr) * 2];
#pragma unroll
                for (int bj = 0; bj < 2; ++bj)
#pragma unroll
                    for (int n = 0; n < 2; ++n) acc[ai][bj][m][n] *= ratio; }
    }
    __device__ __forceinline__ void operator()(const f32x4 (&acc)[2][2][4][2], const Unit& u, int wr, int wc, int fr, int fq) const {
        const int col0 = u.pn * BM + wc * 32 + 4 * fq;
#pragma unroll
        for (int ai = 0; ai < 2; ++ai)
#pragma unroll
            for (int m = 0; m < 4; ++m) {
                asm volatile("" ::: "memory");
                const int row = u.pm * BM + ai * HALF + wr * 64 + m * 16 + fr;
                const size_t off = (size_t)row * 1024 + col0;
                const float sc = WOUT ? alpha * TAB[(ai * HALF + wr * 64 + m * 16 + fr) * 2 + 1] : alpha;
                float ssq = 0.f;
#pragma unroll
                for (int bj = 0; bj < 2; ++bj)
#pragma unroll
                    for (int n = 0; n < 2; ++n) { const f32x4 b = *(const f32x4*)(base + off + bj * HALF + n * 16); const f32x4 v = b + acc[ai][bj][m][n] * sc;
                        *(f32x4*)(out + off + bj * HALF + n * 16) = v; ssq += (v.x * v.x + v.y * v.y) + (v.z * v.z + v.w * v.w);
                        const f32x4 xg = v * *(const f32x4*)(gain + col0 + bj * HALF + n * 16); typedef unsigned u32x2v __attribute__((ext_vector_type(2))); u32x2v w; w.x = cvt_pk_bf16(xg.x, xg.y); w.y = cvt_pk_bf16(xg.z, xg.w);
                        *(u32x2v*)(XG + off + bj * HALF + n * 16) = w; }
                ssq += __shfl_xor(ssq, 16); ssq += __shfl_xor(ssq, 32);
                if (fq == 0) SS[(size_t)row * 16 + u.pn * 4 + wc] = ssq;
            }
    }
};
struct EpiGlu {
    static constexpr bool PERM = true, AFTER_DRAIN = false, MIDK = false;
    const bf16_t* Y; bf16_t* MIXB; const float* bias; const float* gs; float* SSS;
    __device__ __forceinline__ void operator()(const f32x4 (&acc)[2][2][4][2], const Unit& u, int wr, int wc, int fr, int fq) const {
        const int row0 = u.pm * BM + wr * 64 + fr, col0 = u.pn * BM + wc * 32 + 8 * fq;
        f32x4 bv[2][2], gv[2][2];
#pragma unroll
        for (int bj = 0; bj < 2; ++bj)
#pragma unroll
            for (int n = 0; n < 2; ++n) { bv[bj][n] = *(const f32x4*)(bias + col0 + bj * HALF + 4 * n); gv[bj][n] = *(const f32x4*)(gs + col0 + bj * HALF + 4 * n); }
#pragma unroll
        for (int ai = 0; ai < 2; ++ai)
#pragma unroll
            for (int m = 0; m < 4; ++m) {
                const int row = row0 + ai * HALF + m * 16; float ssq = 0.f;
#pragma unroll
                for (int bj = 0; bj < 2; ++bj) {
                    const u32x4 yv = *(const u32x4*)(Y + (size_t)row * 512 + col0 + bj * HALF);
                    const f32x4 v0 = acc[ai][bj][m][0] + bv[bj][0], v1 = acc[ai][bj][m][1] + bv[bj][1];
                    float o[8];
                    o[0] = bflo(yv.x) * sigmoidf_(v0[0]); o[1] = bfhi(yv.x) * sigmoidf_(v0[1]); o[2] = bflo(yv.y) * sigmoidf_(v0[2]); o[3] = bfhi(yv.y) * sigmoidf_(v0[3]);
                    o[4] = bflo(yv.z) * sigmoidf_(v1[0]); o[5] = bfhi(yv.z) * sigmoidf_(v1[1]); o[6] = bflo(yv.w) * sigmoidf_(v1[2]); o[7] = bfhi(yv.w) * sigmoidf_(v1[3]);
#pragma unroll
                    for (int i = 0; i < 8; ++i) ssq += o[i] * o[i];
                    const f32x4 g0 = gv[bj][0], g1 = gv[bj][1];
                    u32x4 w; w.x = cvt_pk_bf16(o[0] * g0.x, o[1] * g0.y); w.y = cvt_pk_bf16(o[2] * g0.z, o[3] * g0.w); w.z = cvt_pk_bf16(o[4] * g1.x, o[5] * g1.y); w.w = cvt_pk_bf16(o[6] * g1.z, o[7] * g1.w);
                    *(u32x4*)(MIXB + (size_t)row * 1024 + 512 + col0 + bj * HALF) = w;
                }
                ssq += __shfl_xor(ssq, 16); ssq += __shfl_xor(ssq, 32);
                if (fq == 0) SSS[(size_t)row * 8 + u.pn * 4 + wc] = ssq;
            }
    }
};
}

template <int MODE>
__device__ __forceinline__ void p0_transpose_item(const float* W, int K, int N, bf16* WT, LAS float* scr, int item, int lane) {
    const int nblk = N / 32, kb = item / nblk, nb = item % nblk, k0 = 64 * kb, n0 = 32 * nb;
#pragma unroll 8
    for (int i = 0; i < 32; ++i) { const int kk = 2 * i + (lane >> 5); scr[kk * 33 + (lane & 31)] = W[(size_t)(k0 + kk) * N + n0 + (lane & 31)]; }
    LDS_WAIT(); asm volatile("" ::: "memory");
    const int c = lane & 7;
    const int r0 = MODE == 0 ? n0 : ((n0 >> 7) * 256 + (n0 & 127) + (MODE == 2 ? 128 : 0));
#pragma unroll
    for (int j = 0; j < 4; ++j) { const int n = (lane >> 3) + 8 * j; const LAS float* s = scr + (8 * c) * 33 + n;
        v4u o; o.x = pk2(s[0 * 33], s[1 * 33]); o.y = pk2(s[2 * 33], s[3 * 33]); o.z = pk2(s[4 * 33], s[5 * 33]); o.w = pk2(s[6 * 33], s[7 * 33]);
        *(v4u*)(WT + (size_t)(r0 + n) * K + k0 + 8 * c) = o; }
    LDS_WAIT(); asm volatile("" ::: "memory");
}

__device__ __forceinline__ void rms_row_to_bf16(const float* xrow, const float* gain, bf16* orow, int lane) {
    const f32x4* xr = (const f32x4*)xrow + lane; const f32x4* gr = (const f32x4*)gain + lane;
    f32x4 v[4]; float s = 0.f;
#pragma unroll
    for (int j = 0; j < 4; ++j) { v[j] = xr[64 * j]; s += (v[j].x * v[j].x + v[j].y * v[j].y) + (v[j].z * v[j].z + v[j].w * v[j].w); }
    const float rstd = 1.f / sqrtf(wave_sum(s) * (1.f / DM) + EPS);
    unsigned long long* o8 = (unsigned long long*)orow + lane;
#pragma unroll
    for (int j = 0; j < 4; ++j) { const f32x4 g = gr[64 * j];
        o8[64 * j] = (unsigned long long)pk2(v[j].x * rstd * g.x, v[j].y * rstd * g.y) | ((unsigned long long)pk2(v[j].z * rstd * g.z, v[j].w * rstd * g.w) << 32); }
}
__device__ __forceinline__ void rms_row_f32(float* xrow, const float* gain, int lane) {
    f32x4* xr = (f32x4*)xrow + lane; const f32x4* gr = (const f32x4*)gain + lane;
    f32x4 v[4]; float s = 0.f;
#pragma unroll
    for (int j = 0; j < 4; ++j) { v[j] = xr[64 * j]; s += (v[j].x * v[j].x + v[j].y * v[j].y) + (v[j].z * v[j].z + v[j].w * v[j].w); }
    const float rstd = 1.f / sqrtf(wave_sum(s) * (1.f / DM) + EPS);
#pragma unroll
    for (int j = 0; j < 4; ++j) { const f32x4 g = gr[64 * j]; xr[64 * j] = v[j] * rstd * g; }
}
__device__ __forceinline__ void mix_row(const bf16* arow, const bf16* srow, const float* ga, const float* gs, bf16* orow, int lane) {
    const v4u a = *((const v4u*)arow + lane), s = *((const v4u*)srow + lane);
    float av[8] = {bflo(a.x), bfhi(a.x), bflo(a.y), bfhi(a.y), bflo(a.z), bfhi(a.z), bflo(a.w), bfhi(a.w)};
    float sv[8] = {bflo(s.x), bfhi(s.x), bflo(s.y), bfhi(s.y), bflo(s.z), bfhi(s.z), bflo(s.w), bfhi(s.w)};
    float sa = 0.f, ss = 0.f;
#pragma unroll
    for (int i = 0; i < 8; ++i) { sa += av[i] * av[i]; ss += sv[i] * sv[i]; }
    const float ra = 1.f / sqrtf(wave_sum(sa) * (1.f / 512.f) + EPS), rs = 1.f / sqrtf(wave_sum(ss) * (1.f / 512.f) + EPS);
    const f32x4 ga0 = *((const f32x4*)ga + 2 * lane), ga1 = *((const f32x4*)ga + 2 * lane + 1), gs0 = *((const f32x4*)gs + 2 * lane), gs1 = *((const f32x4*)gs + 2 * lane + 1);
    v4u oa, os;
    oa.x = pk2(av[0] * ra * ga0.x, av[1] * ra * ga0.y); oa.y = pk2(av[2] * ra * ga0.z, av[3] * ra * ga0.w); oa.z = pk2(av[4] * ra * ga1.x, av[5] * ra * ga1.y); oa.w = pk2(av[6] * ra * ga1.z, av[7] * ra * ga1.w);
    os.x = pk2(sv[0] * rs * gs0.x, sv[1] * rs * gs0.y); os.y = pk2(sv[2] * rs * gs0.z, sv[3] * rs * gs0.w); os.z = pk2(sv[4] * rs * gs1.x, sv[5] * rs * gs1.y); os.w = pk2(sv[6] * rs * gs1.z, sv[7] * rs * gs1.w);
    *((v4u*)orow + lane) = oa; *((v4u*)(orow + 512) + lane) = os;
}

typedef float f32x16 __attribute__((ext_vector_type(16)));
typedef short bf16x8 __attribute__((ext_vector_type(8)));
typedef __bf16 bf16x2_t __attribute__((ext_vector_type(2)));
typedef float f32x2_t __attribute__((ext_vector_type(2)));
__device__ __forceinline__ unsigned cvtpk(float lo, float hi) { f32x2_t v = {lo, hi}; bf16x2_t b = __builtin_convertvector(v, bf16x2_t); return __builtin_bit_cast(unsigned, b); }
__device__ __forceinline__ void attn_mfma(LAS unsigned char* lds, const bf16* QKV  , bf16* MIXB  , float* SSA, const float* ga, const float* sinks, int G, int bid) {
    constexpr int KSTR = 144, VSTR = 784, VT_OFF = 384 * KSTR;
    constexpr float LOG2E = 1.4426950408889634f, K1 = 0.125f * LOG2E;
    const int tid = threadIdx.x, lane = tid & 63, w = tid >> 6, r = lane & 31, hi = lane >> 5;
    for (int unit = bid; unit < 256; unit += G) {
        const int kh = unit & 1, qb = (unit >> 1) & 15, b = unit >> 5, kp0 = qb * 128 - 128;
        __syncthreads();
        for (int c = tid; c < 3072; c += 512) { const int rr = c >> 3, ch = c & 7, kp = kp0 + rr; v4u kv = (v4u){0u, 0u, 0u, 0u}, vv = kv;
            if (kp >= 0 && kp < SEQ) { const bf16* src = QKV + (size_t)(b * SEQ + kp) * 768; kv = *(const v4u*)(src + 512 + kh * 64 + ch * 8); vv = *(const v4u*)(src + 640 + kh * 64 + ch * 8); }
            *(LAS v4u*)(lds + rr * KSTR + ch * 16) = kv;
            const int pos = (rr & ~15) | (((rr >> 2) & 1) << 3) | (((rr >> 3) & 1) << 2) | (rr & 3);
            LAS unsigned short* vt = (LAS unsigned short*)(lds + VT_OFF + (ch * 8) * VSTR + pos * 2);
            vt[0 * (VSTR / 2)] = (unsigned short)(vv.x & 0xffffu); vt[1 * (VSTR / 2)] = (unsigned short)(vv.x >> 16); vt[2 * (VSTR / 2)] = (unsigned short)(vv.y & 0xffffu); vt[3 * (VSTR / 2)] = (unsigned short)(vv.y >> 16);
            vt[4 * (VSTR / 2)] = (unsigned short)(vv.z & 0xffffu); vt[5 * (VSTR / 2)] = (unsigned short)(vv.z >> 16); vt[6 * (VSTR / 2)] = (unsigned short)(vv.w & 0xffffu); vt[7 * (VSTR / 2)] = (unsigned short)(vv.w >> 16); }
        __syncthreads();
        const int h = kh * 4 + (w >> 1);
        const float slope2 = exp2f(-(float)(h + 1)) * LOG2E, sink2 = sinks[h] * LOG2E;
        const bool qedge = (qb == 0) || (qb == 15);
        for (int qi2 = 0; qi2 < 2; ++qi2) {
            const int q0 = ((w & 1) * 2 + qi2) * 32, t = qb * 128 + q0 + r;
            bf16x8 qf[4];
            { const bf16* qp = QKV + (size_t)(b * SEQ + t) * 768 + h * 64 + hi * 8;
#pragma unroll
              for (int ks = 0; ks < 4; ++ks) qf[ks] = *(const bf16x8*)(qp + ks * 16); }
            float m2 = sink2, l = 0.f;
            f32x16 o0, o1;
#pragma unroll
            for (int i = 0; i < 16; ++i) { o0[i] = 0.f; o1[i] = 0.f; }
            for (int kb = 0; kb < 9; ++kb) {
                const int jj0 = q0 + kb * 32;
                f32x16 s;
#pragma unroll
                for (int i = 0; i < 16; ++i) s[i] = 0.f;
#pragma unroll
                for (int ks = 0; ks < 4; ++ks) { const bf16x8 kf = *(const LAS bf16x8*)(lds + (jj0 + r) * KSTR + ks * 32 + hi * 16); s = __builtin_amdgcn_mfma_f32_32x32x16_bf16(kf, qf[ks], s, 0, 0, 0); }
                const float relbf = (float)(kb * 32 - 128 - r + 4 * hi);
#pragma unroll
                for (int i = 0; i < 16; ++i) { const float ci = (float)((i & 3) + 8 * (i >> 2)); s[i] = s[i] * K1 - slope2 * fabsf(relbf + ci); }
                if (kb == 0 || kb == 8 || qedge) {
                    const float kpf = (float)(kp0 + jj0 + 4 * hi);
#pragma unroll
                    for (int i = 0; i < 16; ++i) { const float ci = (float)((i & 3) + 8 * (i >> 2)); const bool valid = (fabsf(relbf + ci) <= 128.f) && (kpf + ci >= 0.f) && (kpf + ci < (float)SEQ); s[i] = valid ? s[i] : -1e30f; }
                }
                float bm = s[0];
#pragma unroll
                for (int i = 1; i < 16; ++i) bm = fmaxf(bm, s[i]);
                bm = fmaxf(bm, __shfl_xor(bm, 32));
                const float mn = fmaxf(m2, bm), corr = __builtin_amdgcn_exp2f(m2 - mn);
                m2 = mn;
                float ps = 0.f;
#pragma unroll
                for (int i = 0; i < 16; ++i) { s[i] = __builtin_amdgcn_exp2f(s[i] - mn); ps += s[i]; }
                l = l * corr + ps;
#pragma unroll
                for (int i = 0; i < 16; ++i) { o0[i] *= corr; o1[i] *= corr; }
#pragma unroll
                for (int st = 0; st < 2; ++st) {
                    v4u pw; pw.x = cvtpk(s[8 * st + 0], s[8 * st + 1]); pw.y = cvtpk(s[8 * st + 2], s[8 * st + 3]); pw.z = cvtpk(s[8 * st + 4], s[8 * st + 5]); pw.w = cvtpk(s[8 * st + 6], s[8 * st + 7]);
                    const bf16x8 pf = __builtin_bit_cast(bf16x8, pw);
                    const bf16x8 v0 = *(const LAS bf16x8*)(lds + VT_OFF + r * VSTR + (jj0 + 16 * st + 8 * hi) * 2);
                    const bf16x8 v1 = *(const LAS bf16x8*)(lds + VT_OFF + (32 + r) * VSTR + (jj0 + 16 * st + 8 * hi) * 2);
                    o0 = __builtin_amdgcn_mfma_f32_32x32x16_bf16(v0, pf, o0, 0, 0, 0);
                    o1 = __builtin_amdgcn_mfma_f32_32x32x16_bf16(v1, pf, o1, 0, 0, 0);
                }
            }
            const float ltot = l + __shfl_xor(l, 32) + __builtin_amdgcn_exp2f(sink2 - m2), inv = 1.f / ltot;
            bf16* op = MIXB + (size_t)(b * SEQ + t) * 1024 + h * 64 + 4 * hi;
            const float* gp = ga + h * 64 + 4 * hi;
            float ssq = 0.f;
#pragma unroll
            for (int gq = 0; gq < 4; ++gq) {
                const f32x4 g0 = *(const f32x4*)(gp + 8 * gq), g1 = *(const f32x4*)(gp + 32 + 8 * gq);
                const float a0 = o0[4 * gq] * inv, a1 = o0[4 * gq + 1] * inv, a2 = o0[4 * gq + 2] * inv, a3 = o0[4 * gq + 3] * inv;
                const float c0 = o1[4 * gq] * inv, c1 = o1[4 * gq + 1] * inv, c2 = o1[4 * gq + 2] * inv, c3 = o1[4 * gq + 3] * inv;
                ssq += (a0 * a0 + a1 * a1) + (a2 * a2 + a3 * a3) + (c0 * c0 + c1 * c1) + (c2 * c2 + c3 * c3);
                v2u a; a.x = cvtpk(a0 * g0.x, a1 * g0.y); a.y = cvtpk(a2 * g0.z, a3 * g0.w); *(v2u*)(op + 8 * gq) = a;
                v2u c; c.x = cvtpk(c0 * g1.x, c1 * g1.y); c.y = cvtpk(c2 * g1.z, c3 * g1.w); *(v2u*)(op + 32 + 8 * gq) = c; }
            ssq += __shfl_xor(ssq, 32);
            if (hi == 0) SSA[(size_t)(b * SEQ + t) * 8 + h] = ssq;
        }
    }
}

struct SsmP { const float *lam_re, *lam_im, *log_dt, *b_re, *b_im, *c_re, *c_im, *dskip; };
__device__ __forceinline__ float gelu_tanh(float x) { const float z = 1.5957691216f * (x + 0.044715f * x * x * x); return x * __builtin_amdgcn_rcpf(1.f + __expf(-z)); }
__device__ __forceinline__ void lam_of(const SsmP& P, int dg, int p, float& lrdt, float& lidt, float& cr, float& ci) {
    const float lr = fminf(P.lam_re[dg * PS + p], -1e-4f), li = P.lam_im[dg * PS + p], dt = expf(P.log_dt[dg]);
    lrdt = lr * dt; lidt = li * dt;
    const float mag = expf(lrdt), ar = mag * cosf(lidt), ai = mag * sinf(lidt), den = lr * lr + li * li;
    cr = ((ar - 1.f) * lr + ai * li) / den; ci = (ai * lr - (ar - 1.f) * li) / den;
}
__device__ __forceinline__ void apow(float lrdt, float lidt, float k, float& pr, float& pi) { const float m = expf(lrdt * k), a = lidt * k; pr = m * cosf(a); pi = m * sinf(a); }

__device__ __forceinline__ void gen_states_item(const SsmP& P, bf16* MATS, int it, int lane) {
    const int p = it & 63, dir = (it >> 6) & 1, g = it >> 7, dg = dir * NG + g, s = lane >> 1, hh = lane & 1;
    float lrdt, lidt, cr, ci, pr, pi; lam_of(P, dg, p, lrdt, lidt, cr, ci); apow(lrdt, lidt, (float)(dir ? s : TC - 1 - s), pr, pi);
    const float wr = pr * cr - pi * ci, wi = pr * ci + pi * cr;
    const float* brp = P.b_re + (size_t)(dg * PS + p) * HC + hh * 8; const float* bip = P.b_im + (size_t)(dg * PS + p) * HC + hh * 8;
    const f32x4 br0 = *(const f32x4*)brp, br1 = *(const f32x4*)(brp + 4), bi0 = *(const f32x4*)bip, bi1 = *(const f32x4*)(bip + 4);
    const f32x4 re0 = br0 * wr - bi0 * wi, re1 = br1 * wr - bi1 * wi, im0 = bi0 * wr + br0 * wi, im1 = bi1 * wr + br1 * wi;
    v4u o; bf16* dst = MATS + (size_t)(g * 256 + dir * 128 + p) * KS + s * 16 + hh * 8;
    o.x = pk2(re0.x, re0.y); o.y = pk2(re0.z, re0.w); o.z = pk2(re1.x, re1.y); o.w = pk2(re1.z, re1.w); *(v4u*)dst = o;
    o.x = pk2(im0.x, im0.y); o.y = pk2(im0.z, im0.w); o.z = pk2(im1.x, im1.y); o.w = pk2(im1.z, im1.w); *(v4u*)(dst + (size_t)64 * KS) = o;
}
__device__ __forceinline__ void gen_carry_item(const SsmP& P, bf16* MATY, int it, int lane) {
    const int tau = it & 31, dir = (it >> 5) & 1, g = it >> 6, dg = dir * NG + g;
    float lrdt, lidt, cr, ci, pr, pi; lam_of(P, dg, lane, lrdt, lidt, cr, ci); apow(lrdt, lidt, (float)(dir ? TC - tau : tau + 1), pr, pi);
#pragma unroll
    for (int h = 0; h < HC; ++h) { const float c_r = P.c_re[(size_t)(dg * HC + h) * PS + lane], c_i = P.c_im[(size_t)(dg * HC + h) * PS + lane];
        bf16* dst = MATY + (size_t)(g * 512 + tau * 16 + h) * KY + 512 + dir * 128 + lane;
        dst[0] = (bf16)f2bf(c_r * pr - c_i * pi); dst[64] = (bf16)f2bf(-(c_r * pi + c_i * pr)); }
}
__device__ __forceinline__ void gen_toep_item(const SsmP& P, bf16* MATY, LAS float* scr, int it, int lane) {
    const int g = it / 63, dl = it % 63 - 31, k = dl < 0 ? -dl : dl;
    LAS float* Wr = scr; LAS float* Wi = scr + 64; LAS float* Cr = scr + 128; LAS float* Ci = Cr + 16 * 65; LAS float* Br = Ci + 16 * 65; LAS float* Bi = Br + 1024;
    const int h = lane >> 2, q = lane & 3;
    float val[4] = {0.f, 0.f, 0.f, 0.f};
    for (int dir = 0; dir < 2; ++dir) {
        if ((dl > 0 && dir == 1) || (dl < 0 && dir == 0)) continue;
        const int dg = dir * NG + g;
        float lrdt, lidt, cr, ci, pr, pi; lam_of(P, dg, lane, lrdt, lidt, cr, ci); apow(lrdt, lidt, (float)k, pr, pi);
        Wr[lane] = pr * cr - pi * ci; Wi[lane] = pr * ci + pi * cr;
#pragma unroll
        for (int i = 0; i < 16; ++i) { Cr[i * 65 + lane] = P.c_re[(size_t)(dg * HC + i) * PS + lane]; Ci[i * 65 + lane] = P.c_im[(size_t)(dg * HC + i) * PS + lane];
            Br[i * 64 + lane] = P.b_re[(size_t)dg * 1024 + i * 64 + lane]; Bi[i * 64 + lane] = P.b_im[(size_t)dg * 1024 + i * 64 + lane]; }
        LDS_WAIT(); asm volatile("" ::: "memory");
        for (int p = 0; p < 64; ++p) { const float wr = Wr[p], wi = Wi[p], c_r = Cr[h * 65 + p], c_i = Ci[h * 65 + p], tr = c_r * wr - c_i * wi, ti = c_r * wi + c_i * wr;
            const f32x4 b_r = *(const LAS f32x4*)(Br + p * 16 + 4 * q), b_i = *(const LAS f32x4*)(Bi + p * 16 + 4 * q);
            val[0] += tr * b_r.x - ti * b_i.x; val[1] += tr * b_r.y - ti * b_i.y; val[2] += tr * b_r.z - ti * b_i.z; val[3] += tr * b_r.w - ti * b_i.w; }
        LDS_WAIT(); asm volatile("" ::: "memory");
    }
    if (dl == 0) { const float dsk = P.dskip[g * HC + h];
#pragma unroll
        for (int j = 0; j < 4; ++j) if (4 * q + j == h) val[j] += dsk; }
    v2u o; o.x = pk2(val[0], val[1]); o.y = pk2(val[2], val[3]);
    const int t_lo = dl > 0 ? dl : 0, t_hi = dl < 0 ? TC - 1 + dl : TC - 1;
    for (int tau = t_lo; tau <= t_hi; ++tau) { const int s = tau - dl; *(v2u*)(MATY + (size_t)(g * 512 + tau * 16 + h) * KY + s * 16 + 4 * q) = o; }
}

namespace pg8 {
struct GroupOrder {
    int rm, rn, nwg, G, c;
    __device__ void init(int ng, int rm_, int rn_, int G_, int c_) { rm = rm_; rn = rn_; nwg = ng * rm * rn; G = G_; c = c_; }
    __device__ bool next(int i, Unit& u) const { const long L = (long)i * G + c; if (L >= nwg) return false; const int per = rm * rn, gi = (int)L / per, r = (int)L % per; u.pm = gi * rm + r % rm; u.pn = gi * rn + r / rm; return true; }
    __device__ __forceinline__ void a_ready(const Unit&) const {}
    __device__ __forceinline__ void done(const Unit&) const {}
};
struct EpiWin {
    static constexpr bool PERM = true, AFTER_DRAIN = false, MIDK = false;
    bf16_t* QKV; bf16_t* UA; const float* SS;
    __device__ __forceinline__ void operator()(const f32x4 (&acc)[2][2][4][2], const Unit& u, int wr, int wc, int fr, int fq) const {
        const int row0 = u.pm * BM + wr * 64 + fr;
#pragma unroll
        for (int ai = 0; ai < 2; ++ai)
#pragma unroll
            for (int m = 0; m < 4; ++m) { const int r = row0 + ai * HALF + m * 16; const float rs = rstd16(SS + (size_t)r * 16);
#pragma unroll
                for (int bj = 0; bj < 2; ++bj) { const f32x4 v0 = acc[ai][bj][m][0] * rs, v1 = acc[ai][bj][m][1] * rs;
                    u32x4 w; w.x = cvt_pk_bf16(v0[0], v0[1]); w.y = cvt_pk_bf16(v0[2], v0[3]); w.z = cvt_pk_bf16(v1[0], v1[1]); w.w = cvt_pk_bf16(v1[2], v1[3]);
                    if (u.pn < 3) { *(u32x4*)(QKV + (size_t)r * 768 + u.pn * BM + bj * HALF + wc * 32 + 8 * fq) = w; }
                    else { const int ucol = (u.pn - 3) * BM + bj * HALF + wc * 32 + 8 * fq, gi = ucol >> 4, h0 = ucol & 15, b = r >> 11, t = r & 2047, c = t >> 5, tau = t & 31;
                        *(u32x4*)(UA + (size_t)(gi * 512 + b * 64 + c) * KY + tau * 16 + h0) = w; } } }
    }
};
struct EpiStates {
    static constexpr bool PERM = false, AFTER_DRAIN = true, MIDK = false;
    float* SST; bf16_t* UA; const float *lam_re, *lam_im, *log_dt;
    __device__ __forceinline__ void fused(f32x4 (&acc)[2][2][4][2], const Unit& u, int wr, int wc, int fr, int fq, PG8_LAS unsigned char* lds, int wid, int lane) const {
#pragma unroll
        for (int ai = 0; ai < 2; ++ai)
#pragma unroll
            for (int m = 0; m < 4; ++m) { float* rowp = SST + (size_t)(u.pm * BM + ai * HALF + wr * 64 + m * 16 + fr) * 256 + wc * 32 + 4 * fq;
#pragma unroll
                for (int bj = 0; bj < 2; ++bj)
#pragma unroll
                    for (int n = 0; n < 2; ++n) *(f32x4*)(rowp + bj * HALF + n * 16) = acc[ai][bj][m][n]; }
        __threadfence(); __syncthreads();
        const int gi = u.pm >> 1, bl = wid >> 1, dir = wid & 1, dg = dir * NG + gi;
        const float lr = fminf(lam_re[dg * PS + lane], -1e-4f), li = lam_im[dg * PS + lane], dt = expf(log_dt[dg]);
        const float mg = expf(lr * dt * (float)TC), ang = li * dt * (float)TC, a_r = mg * cosf(ang), a_i = mg * sinf(ang);
        const size_t rowbase = (size_t)u.pm * BM + bl * 64;
        const float* sre = SST + rowbase * 256 + dir * 128 + lane;
        bf16_t* cre = UA + rowbase * KY + 512 + dir * 128 + lane;
        float xr = 0.f, xi = 0.f;
#pragma unroll 8
        for (int i = 0; i < NC; ++i) { const int c = dir ? NC - 1 - i : i;
            cre[(size_t)c * KY] = (bf16_t)f2bf(xr); cre[(size_t)c * KY + 64] = (bf16_t)f2bf(xi);
            const float sr = __hip_atomic_load(sre + (size_t)c * 256, __ATOMIC_RELAXED, __HIP_MEMORY_SCOPE_AGENT), si = __hip_atomic_load(sre + (size_t)c * 256 + 64, __ATOMIC_RELAXED, __HIP_MEMORY_SCOPE_AGENT);
            const float nr = a_r * xr - a_i * xi + sr; xi = a_r * xi + a_i * xr + si; xr = nr; }
    }
};
struct EpiSsmOut {
    static constexpr bool PERM = true, AFTER_DRAIN = false, MIDK = false;
    bf16_t* YG;
    __device__ __forceinline__ void operator()(const f32x4 (&acc)[2][2][4][2], const Unit& u, int wr, int wc, int fr, int fq) const {
        const int gi = u.pm >> 1;
#pragma unroll
        for (int ai = 0; ai < 2; ++ai)
#pragma unroll
            for (int m = 0; m < 4; ++m) { const int bc = ((u.pm & 1) * BM + ai * HALF + wr * 64 + m * 16 + fr), b = bc >> 6, c = bc & 63;
#pragma unroll
                for (int bj = 0; bj < 2; ++bj) { const int col = (u.pn & 1) * BM + bj * HALF + wc * 32 + 8 * fq, tau = col >> 4, h0 = col & 15;
                    const f32x4 v0 = acc[ai][bj][m][0], v1 = acc[ai][bj][m][1];
                    u32x4 w; w.x = cvt_pk_bf16(gelu_tanh(v0[0]), gelu_tanh(v0[1])); w.y = cvt_pk_bf16(gelu_tanh(v0[2]), gelu_tanh(v0[3]));
                    w.z = cvt_pk_bf16(gelu_tanh(v1[0]), gelu_tanh(v1[1])); w.w = cvt_pk_bf16(gelu_tanh(v1[2]), gelu_tanh(v1[3]));
                    *(u32x4*)(YG + (size_t)(b * SEQ + c * TC + tau) * SWD + gi * 16 + h0) = w; } }
    }
};
}

struct Args { const float* in[26]; float* out; unsigned char* ws; int ph_lo, ph_hi; };
constexpr int N_PHASES = 11;
__global__ void __launch_bounds__(512, 2) mk_fwd(Args args) {
    extern __shared__ __attribute__((aligned(16))) unsigned char lds_raw[];
    LAS unsigned char* lds = (LAS unsigned char*)lds_raw;
    cg::grid_group grid = cg::this_grid();
    const int tid = threadIdx.x, lane = tid & 63, wave = __builtin_amdgcn_readfirstlane(tid >> 6);
    const int G = gridDim.x, bid = blockIdx.x;
    const int gw = bid * 8 + wave, NGW = G * 8;
    unsigned char* ws = args.ws;
    const float* x = args.in[0];
    float* X = args.out;
    bf16* WT1 = (bf16*)(ws + WS_WT1); bf16* WD1 = (bf16*)(ws + WS_WD1); bf16* WT2 = (bf16*)(ws + WS_WT2); bf16* WD2 = (bf16*)(ws + WS_WD2);
    bf16* WIN = (bf16*)(ws + WS_WIN); bf16* WOUT = (bf16*)(ws + WS_WOUT); bf16* WGLU = (bf16*)(ws + WS_WGLU);
    bf16* XA = (bf16*)(ws + WS_XA); bf16* HB = (bf16*)(ws + WS_H); bf16* QKV = (bf16*)(ws + WS_QKV); bf16* YG = (bf16*)(ws + WS_YG);
    float* SS1 = (float*)(ws + WS_SS1); float* SS2 = (float*)(ws + WS_SS2); float* SSA = (float*)(ws + WS_SSA); float* SSS = (float*)(ws + WS_SSS); bf16* MIX = (bf16*)(ws + WS_MIX); bf16* MATS = (bf16*)(ws + WS_MATS); bf16* MATY = (bf16*)(ws + WS_MATY); bf16* UA = (bf16*)(ws + WS_UA); float* SST = (float*)(ws + WS_SST);
    const SsmP SP{args.in[8], args.in[9], args.in[10], args.in[11], args.in[12], args.in[13], args.in[14], args.in[15]};
    const int lo = args.ph_lo, hi = args.ph_hi;
    volatile LAS unsigned* MISC = (volatile LAS unsigned*)(lds + MISC_OFF);
    if (tid < 32) MISC[tid] = 0u;
    __syncthreads();
    XcdBarrier bar = xcd_barrier_post((unsigned*)ws, MISC + 8);
    if (lo < 0) grid.sync();
#define IN(k) (lo <= (k) && (k) < hi)
#define SEAM(k) do { if (IN(k) && IN((k) + 1)) xcd_barrier(bar); } while (0)

    if (IN(0)) {
        LAS float* scr = (LAS float*)(lds + wave * 17024);
        constexpr int I_UP = (DM / 64) * (FF / 32), I_DN = (FF / 64) * (DM / 32), I_IN = (DM / 64) * (INW / 32), I_GLU = (SWD / 64) * (SWD / 32), I_OUT = (DM / 64) * (DM / 32);
        constexpr int NITEMS = 6 * I_UP + I_IN + I_GLU + I_OUT; static_assert(I_UP == I_DN, "");
        for (int it = gw; it < NITEMS; it += NGW) {
            int r = it;
            if (r < I_UP) { p0_transpose_item<1>(args.in[2], DM, FF, WT1, scr, r, lane); continue; } r -= I_UP;
            if (r < I_UP) { p0_transpose_item<2>(args.in[3], DM, FF, WT1, scr, r, lane); continue; } r -= I_UP;
            if (r < I_DN) { p0_transpose_item<0>(args.in[4], FF, DM, WD1, scr, r, lane); continue; } r -= I_DN;
            if (r < I_UP) { p0_transpose_item<1>(args.in[22], DM, FF, WT2, scr, r, lane); continue; } r -= I_UP;
            if (r < I_UP) { p0_transpose_item<2>(args.in[23], DM, FF, WT2, scr, r, lane); continue; } r -= I_UP;
            if (r < I_DN) { p0_transpose_item<0>(args.in[24], FF, DM, WD2, scr, r, lane); continue; } r -= I_DN;
            if (r < I_IN) { p0_transpose_item<0>(args.in[6], DM, INW, WIN, scr, r, lane); continue; } r -= I_IN;
            if (r < I_GLU) { p0_transpose_item<0>(args.in[16], SWD, SWD, WGLU, scr, r, lane); continue; } r -= I_GLU;
            p0_transpose_item<0>(args.in[20], DM, DM, WOUT, scr, r, lane);
        }
        for (int it = gw; it < 32 * 63; it += NGW) gen_toep_item(SP, MATY, scr, it, lane);
        for (int it = gw; it < 32 * 2 * 64; it += NGW) gen_states_item(SP, MATS, it, lane);
        for (int it = gw; it < 32 * 2 * 32; it += NGW) gen_carry_item(SP, MATY, it, lane);
        for (int m = gw; m < M; m += NGW) rms_row_to_bf16(x + (size_t)m * DM, args.in[1], XA + (size_t)m * DM, lane);
    }
    SEAM(0);
    if (IN(1)) { pg8::Gemm g{XA, WT1, M, 2 * FF, DM, DM, DM}; pg8::StaticOrder S; S.init(M, 2 * FF, G, bid); pg8::EpiSwiglu<false> E{HB, FF, nullptr};
        pg8::gemm_phase<pg8::EpiSwiglu<false>, pg8::StaticOrder, true, true>(lds, g, S, E); }
    SEAM(1);
    if (IN(2)) { pg8::Gemm g{HB, WD1, M, DM, FF, FF, FF}; pg8::StaticOrder S; S.init(M, DM, G, bid); pg8::EpiResidNorm<false> E{x, X, 0.5f, args.in[5], XA, SS1, nullptr};
        pg8::gemm_phase<pg8::EpiResidNorm<false>, pg8::StaticOrder, true, true>(lds, g, S, E); }
    SEAM(2);
    if (IN(3)) { pg8::Gemm g{XA, WIN, M, INW, DM, DM, DM}; pg8::StaticOrder S; S.init(M, INW, G, bid); pg8::EpiWin E{QKV, UA, SS1};
        pg8::gemm_phase<pg8::EpiWin, pg8::StaticOrder, true, true>(lds, g, S, E); }
    SEAM(3);
    if (IN(4)) {
        { pg8::Gemm g{UA, MATS, 32 * 512, 32 * 256, KS, KY, KS}; pg8::GroupOrder S; S.init(32, 2, 1, G, bid); pg8::EpiStates E{SST, UA, SP.lam_re, SP.lam_im, SP.log_dt};
          if (G >= 64) pg8::gemm_phase<pg8::EpiStates, pg8::GroupOrder, false, true>(lds, g, S, E); }
        attn_mfma(lds, QKV, MIX, SSA, args.in[18], args.in[7], G, bid);
    }
    SEAM(4);
    if (IN(5)) { pg8::Gemm g{UA, MATY, 32 * 512, 32 * 512, KY, KY, KY}; pg8::GroupOrder S; S.init(32, 2, 2, G, bid); pg8::EpiSsmOut E{YG};
        pg8::gemm_phase<pg8::EpiSsmOut, pg8::GroupOrder, true, true>(lds, g, S, E); }
    SEAM(5);
    if (IN(6)) { pg8::Gemm g{YG, WGLU, M, SWD, SWD, SWD, SWD}; pg8::StaticOrder S; S.init(M, SWD, G, bid); pg8::EpiGlu E{YG, MIX, args.in[17], args.in[19], SSS};
        pg8::gemm_phase<pg8::EpiGlu, pg8::StaticOrder, true, true>(lds, g, S, E); }
    SEAM(6);
    if (IN(7)) { pg8::Gemm g{MIX, WOUT, M, DM, DM, DM, DM}; pg8::StaticOrder S; S.init(M, DM, G, bid);
        LAS float* TAB = (LAS float*)(lds + 131072);
        { pg8::Unit u0; if (S.next(0, u0) && tid < 256) { const int row = u0.pm * 256 + tid; const float ra = pg8::rstd8(SSA + (size_t)row * 8), rs = pg8::rstd8(SSS + (size_t)row * 8); TAB[tid * 2] = ra / rs; TAB[tid * 2 + 1] = rs; } }
        __syncthreads();
        pg8::EpiResidNorm<true> E{X, X, 1.0f, args.in[21], XA, SS2, TAB};
        pg8::gemm_phase<pg8::EpiResidNorm<true>, pg8::StaticOrder, true, true>(lds, g, S, E); }
    SEAM(7);
    if (IN(8)) { pg8::Gemm g{XA, WT2, M, 2 * FF, DM, DM, DM}; pg8::StaticOrder S; S.init(M, 2 * FF, G, bid); pg8::EpiSwiglu<true> E{HB, FF, SS2};
        pg8::gemm_phase<pg8::EpiSwiglu<true>, pg8::StaticOrder, true, true>(lds, g, S, E); }
    SEAM(8);
    if (IN(9)) { pg8::Gemm g{HB, WD2, M, DM, FF, FF, FF}; pg8::StaticOrder S; S.init(M, DM, G, bid); pg8::EpiResid E{X, X, 0.5f};
        pg8::gemm_phase<pg8::EpiResid, pg8::StaticOrder, true, true>(lds, g, S, E); }
    SEAM(9);
    if (IN(10)) { for (int m = gw; m < M; m += NGW) rms_row_f32(X + (size_t)m * DM, args.in[25], lane); }
#undef IN
#undef SEAM
}

extern "C" void kernel_launch(void* const* d_in, const int* in_sizes, int n_in, void* d_out, int out_size, void* d_ws, size_t ws_size, hipStream_t stream) {
    static int grid = 0;
    if (grid == 0) {
        if (n_in != 26 || in_sizes[0] != M * DM || out_size != M * DM || ws_size < WS_END) { fprintf(stderr, "kernel_launch: unexpected shapes n_in %d in0 %d out %d ws %zu\n", n_in, n_in > 0 ? in_sizes[0] : -1, out_size, ws_size); grid = -1; return; }
        int dev = 0, cus = 0, per_cu = 0;
        (void)hipGetDevice(&dev); (void)hipDeviceGetAttribute(&cus, hipDeviceAttributeMultiprocessorCount, dev);
        if (hipFuncSetAttribute((const void*)mk_fwd, hipFuncAttributeMaxDynamicSharedMemorySize, LDS_BYTES) != hipSuccess) { fprintf(stderr, "kernel_launch: hipFuncSetAttribute failed\n"); grid = -1; return; }
        if (hipOccupancyMaxActiveBlocksPerMultiprocessor(&per_cu, (const void*)mk_fwd, 512, LDS_BYTES) != hipSuccess || per_cu < 1) { fprintf(stderr, "kernel_launch: occupancy query says %d\n", per_cu); per_cu = 1; }
        (void)hipGetLastError();
        grid = cus * per_cu;
        if (grid != 256) { fprintf(stderr, "kernel_launch: this kernel is built for a 256-workgroup grid (one per CU of a 256-CU device), got %d; nothing launched\n", grid); grid = -1; return; }
        fprintf(stderr, "kernel_launch: grid %d (cus %d per_cu %d)\n", grid, cus, per_cu);
    }
    if (grid < 0) return;
    if (hipMemsetAsync(d_ws, 0, CTL_ZERO_BYTES, stream) != hipSuccess) { fprintf(stderr, "kernel_launch: hipMemsetAsync failed\n"); return; }
    Args a{};
    for (int i = 0; i < 26; ++i) a.in[i] = (const float*)d_in[i];
    a.out = (float*)d_out; a.ws = (unsigned char*)d_ws;
#if MK_MULTI
    for (int ph = 0; ph < N_PHASES; ++ph) { a.ph_lo = ph; a.ph_hi = ph + 1; hipLaunchKernelGGL(mk_fwd, dim3(grid), dim3(512), LDS_BYTES, stream, a); }
#else
    a.ph_lo = 0; a.ph_hi = N_PHASES;
    void* kargs[] = {&a};
    hipError_t e = hipLaunchCooperativeKernel((const void*)mk_fwd, dim3(grid), dim3(512), kargs, LDS_BYTES, stream);
    if (e != hipSuccess) fprintf(stderr, "cooperative launch failed: %s (grid %d)\n", hipGetErrorString(e), grid);
#endif
}
```

```cpp
#include <hip/hip_runtime.h>
#include <hip/hip_cooperative_groups.h>
#include <cstdio>
#include <cstdint>
namespace cg = cooperative_groups;
#define MK_MULTI 0
namespace pg8 {
#define PG8_LAS __attribute__((address_space(3)))
typedef unsigned short bf16_t;
typedef short bf16x8 __attribute__((ext_vector_type(8)));
typedef float f32x4 __attribute__((ext_vector_type(4)));
typedef unsigned u32x4 __attribute__((ext_vector_type(4)));
constexpr int BM = 256, BK = 64, HALF = 128, HTB = HALF * BK * 2  , STAGE_BYTES = 8 * HTB, NXCD = 8, WGM = 8;

__host__ __device__ __forceinline__ int lds_byte(int r, int c) { const int st = (r >> 4) * 2 + (c >> 5), rr = r & 15, cc = c & 31, ob = rr * 64 + cc * 2; return st * 1024 + (ob ^ (((ob >> 9) & 1) << 5)); }
__host__ __device__ __forceinline__ void stage_rc(int b, int& R, int& C) { const int st = b / 1024, sb = b % 1024, swz = sb ^ (((sb >> 9) & 1) << 5); R = (st >> 1) * 16 + swz / 64; C = (st & 1) * 32 + (swz % 64) / 2; }
__host__ __device__ __forceinline__ int perm32(int rho) { const int n = rho >> 4, i = rho & 15; return 8 * (i >> 2) + 4 * n + (i & 3); }

struct Unit { int pm, pn; };
struct Gemm { const bf16_t* A; const bf16_t* Bt; int M, N, K, lda, ldb; };

struct StaticOrder {
    int nM, nN, nwg, G, c;
    __host__ __device__ void init(int M, int N, int G_, int c_) { nM = M / BM; nN = N / BM; nwg = nM * nN; G = G_; c = c_; }
    __host__ __device__ bool next(int i, Unit& u) const {
        const long L = (long)i * G + c; if (L >= nwg) return false;
        int wgid = (int)L; { const int q = nwg / NXCD, r = nwg % NXCD, xcd = wgid % NXCD, off = wgid / NXCD; wgid = (xcd < r ? xcd * (q + 1) : r * (q + 1) + (xcd - r) * q) + off; }
        const int nig = WGM * nN, gid = wgid / nig, fm = gid * WGM, gsz = (nM - fm) < WGM ? (nM - fm) : WGM;
        u.pm = fm + ((wgid % nig) % gsz); u.pn = (wgid % nig) / gsz; return true;
    }
    __device__ __forceinline__ void a_ready(const Unit&) const {}
    __device__ __forceinline__ void done(const Unit&) const {}
};

__device__ __forceinline__ unsigned cvt_pk_bf16(float lo, float hi) { unsigned r; asm volatile("v_cvt_pk_bf16_f32 %0, %1, %2" : "=v"(r) : "v"(lo), "v"(hi)); return r; }
typedef float f32x2 __attribute__((ext_vector_type(2)));
__device__ __forceinline__ f32x2 gelu_pk(f32x2 v) {
    const f32x2 av = __builtin_elementwise_abs(v), d = av * 0.2316418882f + 1.0f;
    f32x2 t; t.x = __builtin_amdgcn_rcpf(d.x); t.y = __builtin_amdgcn_rcpf(d.y);
    f32x2 q = t * 0.5307027145f + (-0.7265760135f); q = q * t + 0.7107068705f; q = q * t + (-0.142248368f); q = q * t + 0.127414796f; q = q * t;
    const f32x2 s = (v * v) * (-0.72134752044f);
    f32x2 e; e.x = __builtin_amdgcn_exp2f(s.x); e.y = __builtin_amdgcn_exp2f(s.y);
    const f32x2 m = v * (q * e), r = v - m;
    f32x2 o; o.x = v.x < 0.f ? m.x : r.x; o.y = v.y < 0.f ? m.y : r.y; return o;
}

template <int ACT  > struct EpiBf16 {
    static constexpr bool PERM = true, AFTER_DRAIN = false; static_assert(ACT == 0 || ACT == 1, "EpiBf16: ACT is 0 (none) or 1 (gelu_pk)");
    bf16_t* O; int ldc; const float* bias; int split_cols; size_t split_stride; float scale0;
    __device__ __forceinline__ void operator()(const f32x4 (&acc)[2][2][4][2], const Unit& u, int wr, int wc, int fr, int fq) const {
        const int row0 = u.pm * BM + wr * 64 + fr; int colt = u.pn * BM; bf16_t* base = O;
        float sc = 1.f; if (split_cols) { const int t = colt / split_cols; base += (size_t)t * split_stride; colt -= t * split_cols; if (t == 0) sc = scale0; }
        const int col0 = colt + wc * 32 + 8 * fq, bcol0 = u.pn * BM + wc * 32 + 8 * fq;
        f32x4 bv[2][2];
#pragma unroll
        for (int bj = 0; bj < 2; ++bj)
#pragma unroll
            for (int n = 0; n < 2; ++n) bv[bj][n] = bias ? *(const f32x4*)(bias + bcol0 + bj * HALF + 4 * n) : (f32x4){0.f, 0.f, 0.f, 0.f};
#pragma unroll
        for (int ai = 0; ai < 2; ++ai)
#pragma unroll
            for (int m = 0; m < 4; ++m) { bf16_t* rowp = base + (size_t)(row0 + ai * HALF + m * 16) * ldc + col0;
#pragma unroll
                for (int bj = 0; bj < 2; ++bj) { f32x4 v0 = acc[ai][bj][m][0] + bv[bj][0], v1 = acc[ai][bj][m][1] + bv[bj][1];
                    if (ACT == 1) { f32x2 a = gelu_pk((f32x2){v0[0], v0[1]}), b = gelu_pk((f32x2){v0[2], v0[3]}), c = gelu_pk((f32x2){v1[0], v1[1]}), d = gelu_pk((f32x2){v1[2], v1[3]});
                        v0 = (f32x4){a.x, a.y, b.x, b.y}; v1 = (f32x4){c.x, c.y, d.x, d.y}; }
                    v0 = v0 * sc; v1 = v1 * sc; u32x4 w; w.x = cvt_pk_bf16(v0[0], v0[1]); w.y = cvt_pk_bf16(v0[2], v0[3]); w.z = cvt_pk_bf16(v1[0], v1[1]); w.w = cvt_pk_bf16(v1[2], v1[3]);
                    *(u32x4*)(rowp + bj * HALF) = w; } }
    }
};
template <class Epi, class Sched, bool ALIGN_EPI = false, bool SP2 = false>
__device__ __forceinline__ void gemm_phase(PG8_LAS unsigned char* lds, const Gemm g, const Sched& S, const Epi& E) {
    const int tid = threadIdx.x, wid = __builtin_amdgcn_readfirstlane(tid >> 6), lane = tid & 63, wr = wid >> 2, wc = wid & 3, fr = lane & 15, fq = lane >> 4;
    const int K = g.K, nt = K / BK;
    unsigned voffA[2], voffB[2];
#pragma unroll
    for (int i = 0; i < 2; ++i) { int R, C; stage_rc(tid * 16 + i * 8192, R, C); const int Rb = Epi::PERM ? ((R & ~31) + perm32(R & 31)) : R;
        voffA[i] = (unsigned)(R * g.lda + C) * 2u; voffB[i] = (unsigned)(Rb * g.ldb + C) * 2u; }
    const size_t kstep = (size_t)(BK * 2);
    const size_t hstepA = (size_t)HALF * g.lda * 2, hstepB = (size_t)HALF * g.ldb * 2;
    const size_t tstepA = 2 * hstepA, tstepB = 2 * hstepB;
    const unsigned ldsw = (unsigned)wid * 1024u;
    const int aoff = lds_byte(wr * 64 + fr, fq * 8), boff = lds_byte(wc * 32 + fr, fq * 8);
#define PG8_SA(b, h) (((b) * 2 + (h)) * HTB)
#define PG8_SB(b, h) ((4 + (b) * 2 + (h)) * HTB)
#define PG8_STAGE(bufoff, gbase, voff) do { _Pragma("unroll") for (int _i = 0; _i < 2; ++_i) \
        __builtin_amdgcn_global_load_lds((const unsigned*)((const char*)(gbase) + (voff)[_i]), (PG8_LAS unsigned*)(lds + (bufoff) + ldsw + _i * 8192), 16, 0, 0); } while (0)
#define PG8_LDA(dst, b, h) do { _Pragma("unroll") for (int m = 0; m < 4; ++m) _Pragma("unroll") for (int k = 0; k < 2; ++k) dst[m][k] = *(const PG8_LAS bf16x8*)(lds + PG8_SA(b, h) + aoff + m * 2048 + k * 1024); } while (0)
#define PG8_LDB(dst, b, h) do { _Pragma("unroll") for (int n = 0; n < 2; ++n) _Pragma("unroll") for (int k = 0; k < 2; ++k) dst[n][k] = *(const PG8_LAS bf16x8*)(lds + PG8_SB(b, h) + boff + n * 2048 + k * 1024); } while (0)
#define PG8_MMA(ai, bj, At, Bt) do { __builtin_amdgcn_s_setprio(1); _Pragma("unroll") for (int m = 0; m < 4; ++m) _Pragma("unroll") for (int n = 0; n < 2; ++n) _Pragma("unroll") for (int k = 0; k < 2; ++k) \
        acc[ai][bj][m][n] = __builtin_amdgcn_mfma_f32_16x16x32_bf16(Bt[n][k], At[m][k], acc[ai][bj][m][n], 0, 0, 0); __builtin_amdgcn_s_setprio(0); } while (0)
#define PG8_WAIT_V(n) asm volatile("s_waitcnt vmcnt(" #n ")" ::: "memory")
#define PG8_WAIT_L(n) asm volatile("s_waitcnt lgkmcnt(" #n ")" ::: "memory")
#define PG8_BAR __builtin_amdgcn_s_barrier()
#define PG8_SCHED __builtin_amdgcn_sched_barrier(0)
    Unit cur, nxt; int ui = 0;
    if (!S.next(0, cur)) return;
    f32x4 acc[2][2][4][2];
#pragma unroll
    for (int a = 0; a < 2; ++a)
#pragma unroll
        for (int b = 0; b < 2; ++b)
#pragma unroll
            for (int m = 0; m < 4; ++m)
#pragma unroll
                for (int n = 0; n < 2; ++n) acc[a][b][m][n] = (f32x4){0.f, 0.f, 0.f, 0.f};
    bf16x8 At[4][2], B0[2][2], B1[2][2];
    const char* cA = (const char*)g.A + (size_t)cur.pm * tstepA; const char* cB = (const char*)g.Bt + (size_t)cur.pn * tstepB;
    S.a_ready(cur);
    if constexpr (SP2) {
        PG8_STAGE(PG8_SB(0, 0), cB, voffB); PG8_STAGE(PG8_SB(0, 1), cB + hstepB, voffB); PG8_STAGE(PG8_SA(0, 0), cA, voffA); PG8_STAGE(PG8_SA(0, 1), cA + hstepA, voffA);
        if (wr == 1) PG8_BAR;
        PG8_WAIT_V(2); PG8_BAR;
        PG8_STAGE(PG8_SB(1, 0), cB + kstep, voffB); PG8_STAGE(PG8_SA(1, 0), cA + kstep, voffA); PG8_STAGE(PG8_SB(1, 1), cB + hstepB + kstep, voffB);
        PG8_WAIT_V(6); PG8_BAR;
    } else {
        PG8_STAGE(PG8_SB(0, 0), cB, voffB); PG8_STAGE(PG8_SA(0, 0), cA, voffA); PG8_STAGE(PG8_SB(0, 1), cB + hstepB, voffB); PG8_STAGE(PG8_SA(0, 1), cA + hstepA, voffA);
        if (wr == 1) PG8_BAR;
        PG8_WAIT_V(4); PG8_BAR;
        PG8_STAGE(PG8_SB(1, 0), cB + kstep, voffB); PG8_STAGE(PG8_SA(1, 0), cA + kstep, voffA); PG8_STAGE(PG8_SB(1, 1), cB + hstepB + kstep, voffB);
        PG8_WAIT_V(6); PG8_BAR;
    }
    for (;;) {
        const bool has_next = S.next(ui + 1, nxt);
        const char* nA = has_next ? (const char*)g.A + (size_t)nxt.pm * tstepA : cA; const char* nB = has_next ? (const char*)g.Bt + (size_t)nxt.pn * tstepB : cB;
        for (int t = 0; t < nt; t += 2) {
            if constexpr (Epi::MIDK) { if (t == nt / 2) E.midk(acc, cur, wr, fr); }
            const bool last = (t == nt - 2);
            const char* a1 = cA + (size_t)(t + 1) * kstep;
            const char* a2 = last ? nA : cA + (size_t)(t + 2) * kstep; const char* b2 = last ? nB : cB + (size_t)(t + 2) * kstep;
            const char* a3 = a2 + kstep; const char* b3 = b2 + kstep;
            if (last && has_next) S.a_ready(nxt);
            if constexpr (SP2) {
            PG8_LDB(B0, 0, 0); PG8_LDB(B1, 0, 1); PG8_SCHED; PG8_LDA(At, 0, 0); PG8_STAGE(PG8_SA(1, 1), a1 + hstepA, voffA);
            PG8_WAIT_V(8); PG8_WAIT_L(0); PG8_BAR; PG8_MMA(0, 0, At, B0); PG8_MMA(0, 1, At, B1); PG8_BAR; PG8_SCHED;
            PG8_LDA(At, 0, 1); PG8_STAGE(PG8_SB(0, 0), b2, voffB); PG8_STAGE(PG8_SB(0, 1), b2 + hstepB, voffB); PG8_STAGE(PG8_SA(0, 0), a2, voffA);
            PG8_WAIT_V(8); PG8_WAIT_L(0); PG8_BAR; PG8_MMA(1, 0, At, B0); PG8_MMA(1, 1, At, B1); PG8_BAR; PG8_SCHED;
            PG8_LDB(B0, 1, 0); PG8_LDB(B1, 1, 1); PG8_SCHED; PG8_LDA(At, 1, 0); PG8_STAGE(PG8_SA(0, 1), a2 + hstepA, voffA);
            PG8_WAIT_V(8); PG8_WAIT_L(0); PG8_BAR; PG8_MMA(0, 0, At, B0); PG8_MMA(0, 1, At, B1); PG8_BAR; PG8_SCHED;
            PG8_LDA(At, 1, 1); PG8_STAGE(PG8_SB(1, 0), b3, voffB); PG8_STAGE(PG8_SB(1, 1), b3 + hstepB, voffB); PG8_STAGE(PG8_SA(1, 0), a3, voffA);
            PG8_WAIT_V(8); PG8_WAIT_L(0); PG8_BAR; PG8_MMA(1, 0, At, B0); PG8_MMA(1, 1, At, B1); PG8_BAR; PG8_SCHED;
            } else {
            PG8_LDB(B0, 0, 0); PG8_SCHED; PG8_LDA(At, 0, 0); PG8_STAGE(PG8_SA(1, 1), a1 + hstepA, voffA);
            PG8_WAIT_L(8); PG8_BAR; PG8_WAIT_L(0); PG8_MMA(0, 0, At, B0); PG8_BAR; PG8_SCHED;
            PG8_LDB(B1, 0, 1); PG8_STAGE(PG8_SB(0, 0), b2, voffB);
            PG8_BAR; PG8_WAIT_L(0); PG8_MMA(0, 1, At, B1); PG8_BAR;
            PG8_LDA(At, 0, 1); PG8_STAGE(PG8_SA(0, 0), a2, voffA);
            PG8_BAR; PG8_WAIT_L(0); PG8_MMA(1, 0, At, B0); PG8_BAR; PG8_SCHED;
            PG8_STAGE(PG8_SB(0, 1), b2 + hstepB, voffB);
            PG8_WAIT_V(6); PG8_BAR; PG8_MMA(1, 1, At, B1); PG8_BAR;
            PG8_LDB(B0, 1, 0); PG8_SCHED; PG8_LDA(At, 1, 0); PG8_STAGE(PG8_SA(0, 1), a2 + hstepA, voffA);
            PG8_WAIT_L(8); PG8_BAR; PG8_WAIT_L(0); PG8_MMA(0, 0, At, B0); PG8_BAR; PG8_SCHED;
            PG8_LDB(B1, 1, 1); PG8_STAGE(PG8_SB(1, 0), b3, voffB);
            PG8_BAR; PG8_WAIT_L(0); PG8_MMA(0, 1, At, B1); PG8_BAR;
            PG8_LDA(At, 1, 1); PG8_STAGE(PG8_SA(1, 0), a3, voffA);
            PG8_BAR; PG8_WAIT_L(0); PG8_MMA(1, 0, At, B0); PG8_BAR; PG8_SCHED;
            PG8_STAGE(PG8_SB(1, 1), b3 + hstepB, voffB);
            PG8_WAIT_V(6); PG8_BAR; PG8_MMA(1, 1, At, B1); PG8_BAR;
            }
        }
        if constexpr (ALIGN_EPI) { if (wr == 0) PG8_BAR; }
        if constexpr (!Epi::AFTER_DRAIN) { E(acc, cur, wr, wc, fr, fq); S.done(cur); }
        if (!has_next) break;
#pragma unroll
        for (int a = 0; a < 2; ++a)
#pragma unroll
            for (int b = 0; b < 2; ++b)
#pragma unroll
                for (int m = 0; m < 4; ++m)
#pragma unroll
                    for (int n = 0; n < 2; ++n) acc[a][b][m][n] = (f32x4){0.f, 0.f, 0.f, 0.f};
        cur = nxt; cA = nA; cB = nB; ++ui;
        if constexpr (ALIGN_EPI) { if (wr == 1) PG8_BAR; }
    }
    PG8_WAIT_V(0);
    if constexpr (!ALIGN_EPI) { if (wr == 0) PG8_BAR; }
    PG8_BAR;
    if constexpr (Epi::AFTER_DRAIN) { E.fused(acc, cur, wr, wc, fr, fq, lds, wid, lane); S.done(cur); }
#undef PG8_SA
#undef PG8_SB
#undef PG8_STAGE
#undef PG8_LDA
#undef PG8_LDB
#undef PG8_MMA
#undef PG8_WAIT_V
#undef PG8_WAIT_L
#undef PG8_BAR
#undef PG8_SCHED
}
}

#define GAS __attribute__((address_space(1)))
#define LAS __attribute__((address_space(3)))
typedef unsigned short bf16;
typedef unsigned v4u __attribute__((ext_vector_type(4)));
typedef unsigned v2u __attribute__((ext_vector_type(2)));
typedef float f32x4 __attribute__((ext_vector_type(4)));

#ifndef MK_MULTI
#define MK_MULTI 0
#endif

constexpr int BATCH = 8, SEQ = 2048, DM = 1024, M = BATCH * SEQ;
constexpr int NH = 8, HD = 64, AW = 512, SWD = 512, NG = 32, HC = 16, PS = 64, INW = 1280, FF = 2816;
constexpr float EPS = 1e-6f;
constexpr size_t MiB = 1u << 20;
constexpr size_t WS_WT1 = 2 * MiB, WS_WD1 = 14 * MiB, WS_WT2 = 20 * MiB, WS_WD2 = 32 * MiB, WS_WIN = 38 * MiB, WS_WOUT = 41 * MiB, WS_WGLU = 43 * MiB;
constexpr size_t WS_MATS = 44 * MiB;
constexpr size_t WS_SS1 = 52 * MiB, WS_SS2 = 53 * MiB;
constexpr size_t WS_SSA = 54 * MiB, WS_SSS = 55 * MiB;
constexpr size_t WS_XA = 64 * MiB;
constexpr size_t WS_YG = 64 * MiB;
constexpr size_t WS_H = 96 * MiB;
constexpr size_t WS_SST = 96 * MiB;
constexpr size_t WS_MIX = 112 * MiB;
constexpr size_t WS_UA = 168 * MiB;
constexpr size_t WS_QKV = 192 * MiB;
constexpr size_t WS_MATY = 216 * MiB;
constexpr size_t WS_END = 256 * MiB;
constexpr int TC = 32, NC = SEQ / TC, KY = 16 * TC + 256, KS = 16 * TC;
constexpr int LDS_BYTES = 147456, MISC_OFF = 147328;
constexpr size_t CTL_ZERO_BYTES = 16384;

__device__ __forceinline__ unsigned f2bf(float f) { unsigned u = __builtin_bit_cast(unsigned, f); return (u + 0x7fffu + ((u >> 16) & 1u)) >> 16; }
__device__ __forceinline__ unsigned pk2(float lo, float hi) { return f2bf(lo) | (f2bf(hi) << 16); }
__device__ __forceinline__ float bflo(unsigned w) { return __builtin_bit_cast(float, w << 16); }
__device__ __forceinline__ float bfhi(unsigned w) { return __builtin_bit_cast(float, w & 0xffff0000u); }
#define LDS_WAIT() asm volatile("s_waitcnt lgkmcnt(0)" ::: "memory")
__device__ __forceinline__ float wave_sum(float v) {
#pragma unroll
    for (int o = 1; o < 64; o <<= 1) v += __shfl_xor(v, o);
    return v;
}
__device__ __forceinline__ float sigmoidf_(float x) { return __builtin_amdgcn_rcpf(1.f + __expf(-x)); }

#define XB_TMO      128
#define XB_XCNT(j)  (256  + 64 * (j))
#define XB_XSUB(j)  (1280 + 64 * (j))
#define XB_XGEN(j)  (2304 + 64 * (j))
#define XB_TOP      3328
#define XB_TOPGEN   3392
#define XCD_BAR_WORDS 3456
#define XB_SPIN_CAP (1u << 18)

__device__ __forceinline__ unsigned xb_ld(unsigned* p)              { return __hip_atomic_load(p, __ATOMIC_RELAXED, __HIP_MEMORY_SCOPE_AGENT); }
__device__ __forceinline__ unsigned xb_add(unsigned* p, unsigned v) { return __hip_atomic_fetch_add(p, v, __ATOMIC_RELAXED, __HIP_MEMORY_SCOPE_AGENT); }
__device__ __forceinline__ unsigned xb_xcc_id() { return (unsigned)__builtin_amdgcn_s_getreg((3 << 11) | 20) & 0xFu; }
#define XB_SPIN(cond, bar) do { unsigned _sp = 0; while (cond) { __builtin_amdgcn_s_sleep(1); \
    if ((++_sp & 255u) == 0u) { if (xb_ld(&(bar)[XB_TMO])) break; if (_sp > XB_SPIN_CAP) { atomicAdd(&(bar)[XB_TMO], 1u); break; } } } } while (0)

struct XcdBarrier {
    unsigned* bar; unsigned x;
    volatile LAS unsigned* st;
};

__device__ __forceinline__ XcdBarrier xcd_barrier_post(unsigned* bar, volatile LAS unsigned* st) {
    XcdBarrier b; b.bar = bar; b.x = xb_xcc_id(); b.st = st;
    if (threadIdx.x == 0) (void)xb_add(&bar[XB_XCNT(b.x)], 1u);
    return b;
}
__device__ __forceinline__ void xcd_barrier_complete(unsigned* bar, unsigned x, unsigned& nloc, unsigned& nx) {
    const unsigned G = gridDim.x * gridDim.y * gridDim.z;
    unsigned sum, cnt, mine, sp = 0u;
    for (;;) {
        sum = 0u; cnt = 0u; mine = 0u;
#pragma unroll
        for (unsigned j = 0; j < 16; ++j) { const unsigned c = xb_ld(&bar[XB_XCNT(j)]); sum += c; cnt += (c > 0u) ? 1u : 0u; mine = (j == x) ? c : mine; }
        if (sum == G) break;
        __builtin_amdgcn_s_sleep(1);
        if ((++sp & 255u) == 0u) { if (xb_ld(&bar[XB_TMO])) break; if (sp > XB_SPIN_CAP) { atomicAdd(&bar[XB_TMO], 1u); break; } }
    }
    nloc = mine > 0u ? mine : 1u; nx = cnt > 0u ? cnt : 1u;
}

__device__ __forceinline__ void xcd_barrier(const XcdBarrier& b) {
    asm volatile("s_waitcnt vmcnt(0)" ::: "memory");
    __syncthreads();
    if (threadIdx.x == 0) {
        unsigned* bar = b.bar;
        __builtin_amdgcn_s_waitcnt(0);
        unsigned nloc = b.st[0], nx = b.st[1];
        if (nloc == 0u) { xcd_barrier_complete(bar, b.x, nloc, nx); b.st[0] = nloc; b.st[1] = nx; }
        const unsigned old = xb_add(&bar[XB_XSUB(b.x)], 1u);
        const unsigned gen = old / nloc;
        if (old + 1u == (gen + 1u) * nloc) {
            __builtin_amdgcn_fence(__ATOMIC_RELEASE, "agent");
            asm volatile("s_waitcnt vmcnt(0)" ::: "memory");
            const unsigned og = xb_add(&bar[XB_TOP], 1u);
            const unsigned tg = og / nx;
            if (og + 1u == (tg + 1u) * nx) xb_add(&bar[XB_TOPGEN], 1u);
            else XB_SPIN(xb_ld(&bar[XB_TOPGEN]) == tg, bar);
            __builtin_amdgcn_fence(__ATOMIC_ACQUIRE, "agent");
            xb_add(&bar[XB_XGEN(b.x)], 1u);
            asm volatile("s_waitcnt vmcnt(0)" ::: "memory");
        } else {
            XB_SPIN(xb_ld(&bar[XB_XGEN(b.x)]) == gen, bar);
            __builtin_amdgcn_fence(__ATOMIC_ACQUIRE, "agent");
            asm volatile("s_waitcnt vmcnt(0)" ::: "memory");
        }
    }
    __syncthreads();
}

namespace pg8 {
__device__ __forceinline__ float rstd16(const float* ss) { const f32x4 a = *(const f32x4*)ss, b = *(const f32x4*)(ss + 4), c = *(const f32x4*)(ss + 8), d = *(const f32x4*)(ss + 12);
    return 1.f / sqrtf((((a.x + a.y) + (a.z + a.w)) + ((b.x + b.y) + (b.z + b.w)) + ((c.x + c.y) + (c.z + c.w)) + ((d.x + d.y) + (d.z + d.w))) * (1.f / 1024.f) + EPS); }
__device__ __forceinline__ float rstd8(const float* ss) { const f32x4 a = *(const f32x4*)ss, b = *(const f32x4*)(ss + 4);
    return 1.f / sqrtf((((a.x + a.y) + (a.z + a.w)) + ((b.x + b.y) + (b.z + b.w))) * (1.f / 512.f) + EPS); }
template <bool SCALE> struct EpiSwiglu {
    static constexpr bool PERM = true, AFTER_DRAIN = false, MIDK = false;
    bf16_t* H; int ldh; const float* SS;
    __device__ __forceinline__ void operator()(const f32x4 (&acc)[2][2][4][2], const Unit& u, int wr, int wc, int fr, int fq) const {
        const int row0 = u.pm * BM + wr * 64 + fr, col0 = u.pn * HALF + wc * 32 + 8 * fq;
#pragma unroll
        for (int ai = 0; ai < 2; ++ai)
#pragma unroll
            for (int m = 0; m < 4; ++m) {
                if (SCALE) asm volatile("" ::: "memory");
                const int row = row0 + ai * HALF + m * 16;
                const float rs = SCALE ? rstd16(SS + (size_t)row * 16) : 1.f;
                bf16_t* rowp = H + (size_t)row * ldh + col0;
                float hv[8];
#pragma unroll
                for (int n = 0; n < 2; ++n)
#pragma unroll
                    for (int i = 0; i < 4; ++i) { const float g = acc[ai][0][m][n][i] * rs, up = acc[ai][1][m][n][i] * rs; hv[n * 4 + i] = g * __builtin_amdgcn_rcpf(1.f + __expf(-g)) * up; }
                u32x4 w; w.x = cvt_pk_bf16(hv[0], hv[1]); w.y = cvt_pk_bf16(hv[2], hv[3]); w.z = cvt_pk_bf16(hv[4], hv[5]); w.w = cvt_pk_bf16(hv[6], hv[7]);
                *(u32x4*)rowp = w;
            }
    }
};
struct EpiResid {
    static constexpr bool PERM = false, AFTER_DRAIN = false, MIDK = false;
    const float* base; float* out; float alpha;
    __device__ __forceinline__ void operator()(const f32x4 (&acc)[2][2][4][2], const Unit& u, int wr, int wc, int fr, int fq) const {
        const int col0 = u.pn * BM + wc * 32 + 4 * fq;
#pragma unroll
        for (int ai = 0; ai < 2; ++ai)
#pragma unroll
            for (int m = 0; m < 4; ++m) {
                const size_t off = (size_t)(u.pm * BM + ai * HALF + wr * 64 + m * 16 + fr) * 1024 + col0;
#pragma unroll
                for (int bj = 0; bj < 2; ++bj)
#pragma unroll
                    for (int n = 0; n < 2; ++n) { const f32x4 b = *(const f32x4*)(base + off + bj * HALF + n * 16); *(f32x4*)(out + off + bj * HALF + n * 16) = b + acc[ai][bj][m][n] * alpha; }
            }
    }
};
template <bool WOUT> struct EpiResidNorm {
    static constexpr bool PERM = false, AFTER_DRAIN = false, MIDK = WOUT;
    const float* base; float* out; float alpha; const float* gain; bf16_t* XG; float* SS; const PG8_LAS float* TAB;
    __device__ __forceinline__ void midk(f32x4 (&acc)[2][2][4][2], const Unit& u, int wr, int fr) const {
#pragma unroll
        for (int ai = 0; ai < 2; ++ai)
#pragma unroll
            for (int m = 0; m < 4; ++m) { const float ratio = TAB[(ai * HALF + wr * 64 + m * 16 + fr) * 2];
#pragma unroll
                for (int bj = 0; bj < 2; ++bj)
#pragma unroll
                    for (int n = 0; n < 2; ++n) acc[ai][bj][m][n] *= ratio; }
    }
    __device__ __forceinline__ void operator()(const f32x4 (&acc)[2][2][4][2], const Unit& u, int wr, int wc, int fr, int fq) const {
        const int col0 = u.pn * BM + wc * 32 + 4 * fq;
#pragma unroll
        for (int ai = 0; ai < 2; ++ai)
#pragma unroll
            for (int m = 0; m < 4; ++m) {
                asm volatile("" ::: "memory");
                const int row = u.pm * BM + ai * HALF + wr * 64 + m * 16 + fr;
                const size_t off = (size_t)row * 1024 + col0;
                const float sc = WOUT ? alpha * TAB[(ai * HALF + wr * 64 + m * 16 + fr) * 2 + 1] : alpha;
                float ssq = 0.f;
#pragma unroll
                for (int bj = 0; bj < 2; ++bj)
#pragma unroll
                    for (int n = 0; n < 2; ++n) { const f32x4 b = *(const f32x4*)(base + off + bj * HALF + n * 16); const f32x4 v = b + acc[ai][bj][m][n] * sc;
                        *(f32x4*)(out + off + bj * HALF + n * 16) = v; ssq += (v.x * v.x + v.y * v.y) + (v.z * v.z + v.w * v.w);
                        const f32x4 xg = v * *(const f32x4*)(gain + col0 + bj * HALF + n * 16); typedef unsigned u32x2v __attribute__((ext_vector_type(2))); u32x2v w; w.x = cvt_pk_bf16(xg.x, xg.y); w.y = cvt_pk_bf16(xg.z, xg.w);
                        *(u32x2v*)(XG + off + bj * HALF + n * 16) = w; }
                ssq += __shfl_xor(ssq, 16); ssq += __shfl_xor(ssq, 32);
                if (fq == 0) SS[(size_t)row * 16 + u.pn * 4 + wc] = ssq;
            }
    }
};
struct EpiGlu {
    static constexpr bool PERM = true, AFTER_DRAIN = false, MIDK = false;
    const bf16_t* Y; bf16_t* MIXB; const float* bias; const float* gs; float* SSS;
    __device__ __forceinline__ void operator()(const f32x4 (&acc)[2][2][4][2], const Unit& u, int wr, int wc, int fr, int fq) const {
        const int row0 = u.pm * BM + wr * 64 + fr, col0 = u.pn * BM + wc * 32 + 8 * fq;
        f32x4 bv[2][2], gv[2][2];
#pragma unroll
        for (int bj = 0; bj < 2; ++bj)
#pragma unroll
            for (int n = 0; n < 2; ++n) { bv[bj][n] = *(const f32x4*)(bias + col0 + bj * HALF + 4 * n); gv[bj][n] = *(const f32x4*)(gs + col0 + bj * HALF + 4 * n); }
#pragma unroll
        for (int ai = 0; ai < 2; ++ai)
#pragma unroll
            for (int m = 0; m < 4; ++m) {
                const int row = row0 + ai * HALF + m * 16; float ssq = 0.f;
#pragma unroll
                for (int bj = 0; bj < 2; ++bj) {
                    const u32x4 yv = *(const u32x4*)(Y + (size_t)row * 512 + col0 + bj * HALF);
                    const f32x4 v0 = acc[ai][bj][m][0] + bv[bj][0], v1 = acc[ai][bj][m][1] + bv[bj][1];
                    float o[8];
                    o[0] = bflo(yv.x) * sigmoidf_(v0[0]); o[1] = bfhi(yv.x) * sigmoidf_(v0[1]); o[2] = bflo(yv.y) * sigmoidf_(v0[2]); o[3] = bfhi(yv.y) * sigmoidf_(v0[3]);
                    o[4] = bflo(yv.z) * sigmoidf_(v1[0]); o[5] = bfhi(yv.z) * sigmoidf_(v1[1]); o[6] = bflo(yv.w) * sigmoidf_(v1[2]); o[7] = bfhi(yv.w) * sigmoidf_(v1[3]);
#pragma unroll
                    for (int i = 0; i < 8; ++i) ssq += o[i] * o[i];
                    const f32x4 g0 = gv[bj][0], g1 = gv[bj][1];
                    u32x4 w; w.x = cvt_pk_bf16(o[0] * g0.x, o[1] * g0.y); w.y = cvt_pk_bf16(o[2] * g0.z, o[3] * g0.w); w.z = cvt_pk_bf16(o[4] * g1.x, o[5] * g1.y); w.w = cvt_pk_bf16(o[6] * g1.z, o[7] * g1.w);
                    *(u32x4*)(MIXB + (size_t)row * 1024 + 512 + col0 + bj * HALF) = w;
                }
                ssq += __shfl_xor(ssq, 16); ssq += __shfl_xor(ssq, 32);
                if (fq == 0) SSS[(size_t)row * 8 + u.pn * 4 + wc] = ssq;
            }
    }
};
}

template <int MODE>
__device__ __forceinline__ void p0_transpose_item(const float* W, int K, int N, bf16* WT, LAS float* scr, int item, int lane) {
    const int nblk = N / 32, kb = item / nblk, nb = item % nblk, k0 = 64 * kb, n0 = 32 * nb;
    f32x4 v[8];
#pragma unroll
    for (int i = 0; i < 8; ++i) v[i] = *(const f32x4*)(W + (size_t)(k0 + 8 * i + (lane >> 3)) * N + n0 + 4 * (lane & 7));
#pragma unroll
    for (int i = 0; i < 8; ++i) { LAS float* d = scr + (8 * i + (lane >> 3)) * 33 + 4 * (lane & 7); d[0] = v[i].x; d[1] = v[i].y; d[2] = v[i].z; d[3] = v[i].w; }
    LDS_WAIT(); asm volatile("" ::: "memory");
    const int c = lane & 7;
    const int r0 = MODE == 0 ? n0 : ((n0 >> 7) * 256 + (n0 & 127) + (MODE == 2 ? 128 : 0));
#pragma unroll
    for (int j = 0; j < 4; ++j) { const int n = (lane >> 3) + 8 * j; const LAS float* s = scr + (8 * c) * 33 + n;
        v4u o; o.x = pk2(s[0 * 33], s[1 * 33]); o.y = pk2(s[2 * 33], s[3 * 33]); o.z = pk2(s[4 * 33], s[5 * 33]); o.w = pk2(s[6 * 33], s[7 * 33]);
        *(v4u*)(WT + (size_t)(r0 + n) * K + k0 + 8 * c) = o; }
    LDS_WAIT(); asm volatile("" ::: "memory");
}

__device__ __forceinline__ void rms_row_to_bf16(const float* xrow, const float* gain, bf16* orow, int lane) {
    const f32x4* xr = (const f32x4*)xrow + lane; const f32x4* gr = (const f32x4*)gain + lane;
    f32x4 v[4]; float s = 0.f;
#pragma unroll
    for (int j = 0; j < 4; ++j) { v[j] = xr[64 * j]; s += (v[j].x * v[j].x + v[j].y * v[j].y) + (v[j].z * v[j].z + v[j].w * v[j].w); }
    const float rstd = 1.f / sqrtf(wave_sum(s) * (1.f / DM) + EPS);
    unsigned long long* o8 = (unsigned long long*)orow + lane;
#pragma unroll
    for (int j = 0; j < 4; ++j) { const f32x4 g = gr[64 * j];
        o8[64 * j] = (unsigned long long)pk2(v[j].x * rstd * g.x, v[j].y * rstd * g.y) | ((unsigned long long)pk2(v[j].z * rstd * g.z, v[j].w * rstd * g.w) << 32); }
}
__device__ __forceinline__ void rms_row_f32(float* xrow, const float* gain, int lane) {
    f32x4* xr = (f32x4*)xrow + lane; const f32x4* gr = (const f32x4*)gain + lane;
    f32x4 v[4]; float s = 0.f;
#pragma unroll
    for (int j = 0; j < 4; ++j) { v[j] = xr[64 * j]; s += (v[j].x * v[j].x + v[j].y * v[j].y) + (v[j].z * v[j].z + v[j].w * v[j].w); }
    const float rstd = 1.f / sqrtf(wave_sum(s) * (1.f / DM) + EPS);
#pragma unroll
    for (int j = 0; j < 4; ++j) { const f32x4 g = gr[64 * j]; xr[64 * j] = v[j] * rstd * g; }
}
__device__ __forceinline__ void mix_row(const bf16* arow, const bf16* srow, const float* ga, const float* gs, bf16* orow, int lane) {
    const v4u a = *((const v4u*)arow + lane), s = *((const v4u*)srow + lane);
    float av[8] = {bflo(a.x), bfhi(a.x), bflo(a.y), bfhi(a.y), bflo(a.z), bfhi(a.z), bflo(a.w), bfhi(a.w)};
    float sv[8] = {bflo(s.x), bfhi(s.x), bflo(s.y), bfhi(s.y), bflo(s.z), bfhi(s.z), bflo(s.w), bfhi(s.w)};
    float sa = 0.f, ss = 0.f;
#pragma unroll
    for (int i = 0; i < 8; ++i) { sa += av[i] * av[i]; ss += sv[i] * sv[i]; }
    const float ra = 1.f / sqrtf(wave_sum(sa) * (1.f / 512.f) + EPS), rs = 1.f / sqrtf(wave_sum(ss) * (1.f / 512.f) + EPS);
    const f32x4 ga0 = *((const f32x4*)ga + 2 * lane), ga1 = *((const f32x4*)ga + 2 * lane + 1), gs0 = *((const f32x4*)gs + 2 * lane), gs1 = *((const f32x4*)gs + 2 * lane + 1);
    v4u oa, os;
    oa.x = pk2(av[0] * ra * ga0.x, av[1] * ra * ga0.y); oa.y = pk2(av[2] * ra * ga0.z, av[3] * ra * ga0.w); oa.z = pk2(av[4] * ra * ga1.x, av[5] * ra * ga1.y); oa.w = pk2(av[6] * ra * ga1.z, av[7] * ra * ga1.w);
    os.x = pk2(sv[0] * rs * gs0.x, sv[1] * rs * gs0.y); os.y = pk2(sv[2] * rs * gs0.z, sv[3] * rs * gs0.w); os.z = pk2(sv[4] * rs * gs1.x, sv[5] * rs * gs1.y); os.w = pk2(sv[6] * rs * gs1.z, sv[7] * rs * gs1.w);
    *((v4u*)orow + lane) = oa; *((v4u*)(orow + 512) + lane) = os;
}

typedef float f32x16 __attribute__((ext_vector_type(16)));
typedef short bf16x8 __attribute__((ext_vector_type(8)));
typedef __bf16 bf16x2_t __attribute__((ext_vector_type(2)));
typedef float f32x2_t __attribute__((ext_vector_type(2)));
__device__ __forceinline__ unsigned cvtpk(float lo, float hi) { f32x2_t v = {lo, hi}; bf16x2_t b = __builtin_convertvector(v, bf16x2_t); return __builtin_bit_cast(unsigned, b); }
__device__ __forceinline__ void attn_mfma(LAS unsigned char* lds, const bf16* QKV  , bf16* MIXB  , float* SSA, const float* ga, const float* sinks, int ubeg, int uend, int ustep) {
    constexpr int KSTR = 144, VSTR = 784, VT_OFF = 384 * KSTR;
    constexpr float LOG2E = 1.4426950408889634f, K1 = 0.125f * LOG2E;
    const int tid = threadIdx.x, lane = tid & 63, w = tid >> 6, r = lane & 31, hi = lane >> 5;
    for (int unit = ubeg; unit < uend; unit += ustep) {
        const int kh = unit & 1, qb = (unit >> 1) & 15, b = unit >> 5, kp0 = qb * 128 - 128;
        __syncthreads();
        for (int c = tid; c < 3072; c += 512) { const int rr = c >> 3, ch = c & 7, kp = kp0 + rr; v4u kv = (v4u){0u, 0u, 0u, 0u}, vv = kv;
            if (kp >= 0 && kp < SEQ) { const bf16* src = QKV + (size_t)(b * SEQ + kp) * 768; kv = *(const v4u*)(src + 512 + kh * 64 + ch * 8); vv = *(const v4u*)(src + 640 + kh * 64 + ch * 8); }
            *(LAS v4u*)(lds + rr * KSTR + ch * 16) = kv;
            const int pos = (rr & ~15) | (((rr >> 2) & 1) << 3) | (((rr >> 3) & 1) << 2) | (rr & 3);
            LAS unsigned short* vt = (LAS unsigned short*)(lds + VT_OFF + (ch * 8) * VSTR + pos * 2);
            vt[0 * (VSTR / 2)] = (unsigned short)(vv.x & 0xffffu); vt[1 * (VSTR / 2)] = (unsigned short)(vv.x >> 16); vt[2 * (VSTR / 2)] = (unsigned short)(vv.y & 0xffffu); vt[3 * (VSTR / 2)] = (unsigned short)(vv.y >> 16);
            vt[4 * (VSTR / 2)] = (unsigned short)(vv.z & 0xffffu); vt[5 * (VSTR / 2)] = (unsigned short)(vv.z >> 16); vt[6 * (VSTR / 2)] = (unsigned short)(vv.w & 0xffffu); vt[7 * (VSTR / 2)] = (unsigned short)(vv.w >> 16); }
        __syncthreads();
        const int h = kh * 4 + (w >> 1);
        const float slope2 = exp2f(-(float)(h + 1)) * LOG2E, sink2 = sinks[h] * LOG2E;
        const bool qedge = (qb == 0) || (qb == 15);
        for (int qi2 = 0; qi2 < 2; ++qi2) {
            const int q0 = ((w & 1) * 2 + qi2) * 32, t = qb * 128 + q0 + r;
            bf16x8 qf[4];
            { const bf16* qp = QKV + (size_t)(b * SEQ + t) * 768 + h * 64 + hi * 8;
#pragma unroll
              for (int ks = 0; ks < 4; ++ks) qf[ks] = *(const bf16x8*)(qp + ks * 16); }
            float m2 = sink2, l = 0.f;
            f32x16 o0, o1;
#pragma unroll
            for (int i = 0; i < 16; ++i) { o0[i] = 0.f; o1[i] = 0.f; }
            for (int kb = 0; kb < 9; ++kb) {
                const int jj0 = q0 + kb * 32;
                f32x16 s;
#pragma unroll
                for (int i = 0; i < 16; ++i) s[i] = 0.f;
#pragma unroll
                for (int ks = 0; ks < 4; ++ks) { const bf16x8 kf = *(const LAS bf16x8*)(lds + (jj0 + r) * KSTR + ks * 32 + hi * 16); s = __builtin_amdgcn_mfma_f32_32x32x16_bf16(kf, qf[ks], s, 0, 0, 0); }
                const float relbf = (float)(kb * 32 - 128 - r + 4 * hi);
#pragma unroll
                for (int i = 0; i < 16; ++i) { const float ci = (float)((i & 3) + 8 * (i >> 2)); s[i] = s[i] * K1 - slope2 * fabsf(relbf + ci); }
                if (kb == 0 || kb == 8 || qedge) {
                    const float kpf = (float)(kp0 + jj0 + 4 * hi);
#pragma unroll
                    for (int i = 0; i < 16; ++i) { const float ci = (float)((i & 3) + 8 * (i >> 2)); const bool valid = (fabsf(relbf + ci) <= 128.f) && (kpf + ci >= 0.f) && (kpf + ci < (float)SEQ); s[i] = valid ? s[i] : -1e30f; }
                }
                float bm = s[0];
#pragma unroll
                for (int i = 1; i < 16; ++i) bm = fmaxf(bm, s[i]);
                bm = fmaxf(bm, __shfl_xor(bm, 32));
                const float mn = fmaxf(m2, bm), corr = __builtin_amdgcn_exp2f(m2 - mn);
                m2 = mn;
                float ps = 0.f;
#pragma unroll
                for (int i = 0; i < 16; ++i) { s[i] = __builtin_amdgcn_exp2f(s[i] - mn); ps += s[i]; }
                l = l * corr + ps;
#pragma unroll
                for (int i = 0; i < 16; ++i) { o0[i] *= corr; o1[i] *= corr; }
#pragma unroll
                for (int st = 0; st < 2; ++st) {
                    v4u pw; pw.x = cvtpk(s[8 * st + 0], s[8 * st + 1]); pw.y = cvtpk(s[8 * st + 2], s[8 * st + 3]); pw.z = cvtpk(s[8 * st + 4], s[8 * st + 5]); pw.w = cvtpk(s[8 * st + 6], s[8 * st + 7]);
                    const bf16x8 pf = __builtin_bit_cast(bf16x8, pw);
                    const bf16x8 v0 = *(const LAS bf16x8*)(lds + VT_OFF + r * VSTR + (jj0 + 16 * st + 8 * hi) * 2);
                    const bf16x8 v1 = *(const LAS bf16x8*)(lds + VT_OFF + (32 + r) * VSTR + (jj0 + 16 * st + 8 * hi) * 2);
                    o0 = __builtin_amdgcn_mfma_f32_32x32x16_bf16(v0, pf, o0, 0, 0, 0);
                    o1 = __builtin_amdgcn_mfma_f32_32x32x16_bf16(v1, pf, o1, 0, 0, 0);
                }
            }
            const float ltot = l + __shfl_xor(l, 32) + __builtin_amdgcn_exp2f(sink2 - m2), inv = 1.f / ltot;
            bf16* op = MIXB + (size_t)(b * SEQ + t) * 1024 + h * 64 + 4 * hi;
            const float* gp = ga + h * 64 + 4 * hi;
            float ssq = 0.f;
#pragma unroll
            for (int gq = 0; gq < 4; ++gq) {
                const f32x4 g0 = *(const f32x4*)(gp + 8 * gq), g1 = *(const f32x4*)(gp + 32 + 8 * gq);
                const float a0 = o0[4 * gq] * inv, a1 = o0[4 * gq + 1] * inv, a2 = o0[4 * gq + 2] * inv, a3 = o0[4 * gq + 3] * inv;
                const float c0 = o1[4 * gq] * inv, c1 = o1[4 * gq + 1] * inv, c2 = o1[4 * gq + 2] * inv, c3 = o1[4 * gq + 3] * inv;
                ssq += (a0 * a0 + a1 * a1) + (a2 * a2 + a3 * a3) + (c0 * c0 + c1 * c1) + (c2 * c2 + c3 * c3);
                v2u a; a.x = cvtpk(a0 * g0.x, a1 * g0.y); a.y = cvtpk(a2 * g0.z, a3 * g0.w); *(v2u*)(op + 8 * gq) = a;
                v2u c; c.x = cvtpk(c0 * g1.x, c1 * g1.y); c.y = cvtpk(c2 * g1.z, c3 * g1.w); *(v2u*)(op + 32 + 8 * gq) = c; }
            ssq += __shfl_xor(ssq, 32);
            if (hi == 0) SSA[(size_t)(b * SEQ + t) * 8 + h] = ssq;
        }
    }
}

struct SsmP { const float *lam_re, *lam_im, *log_dt, *b_re, *b_im, *c_re, *c_im, *dskip; };
__device__ __forceinline__ float gelu_tanh(float x) { const float z = 1.5957691216f * (x + 0.044715f * x * x * x); return x * __builtin_amdgcn_rcpf(1.f + __expf(-z)); }
__device__ __forceinline__ void lam_of(const SsmP& P, int dg, int p, float& lrdt, float& lidt, float& cr, float& ci) {
    const float lr = fminf(P.lam_re[dg * PS + p], -1e-4f), li = P.lam_im[dg * PS + p], dt = expf(P.log_dt[dg]);
    lrdt = lr * dt; lidt = li * dt;
    const float mag = expf(lrdt), ar = mag * cosf(lidt), ai = mag * sinf(lidt), den = lr * lr + li * li;
    cr = ((ar - 1.f) * lr + ai * li) / den; ci = (ai * lr - (ar - 1.f) * li) / den;
}
__device__ __forceinline__ void apow(float lrdt, float lidt, float k, float& pr, float& pi) { const float m = expf(lrdt * k), a = lidt * k; pr = m * cosf(a); pi = m * sinf(a); }

__device__ __forceinline__ void gen_states_item(const SsmP& P, bf16* MATS, int it, int lane) {
    const int p = it & 63, dir = (it >> 6) & 1, g = it >> 7, dg = dir * NG + g, s = lane >> 1, hh = lane & 1;
    float lrdt, lidt, cr, ci, pr, pi; lam_of(P, dg, p, lrdt, lidt, cr, ci); apow(lrdt, lidt, (float)(dir ? s : TC - 1 - s), pr, pi);
    const float wr = pr * cr - pi * ci, wi = pr * ci + pi * cr;
    const float* brp = P.b_re + (size_t)(dg * PS + p) * HC + hh * 8; const float* bip = P.b_im + (size_t)(dg * PS + p) * HC + hh * 8;
    const f32x4 br0 = *(const f32x4*)brp, br1 = *(const f32x4*)(brp + 4), bi0 = *(const f32x4*)bip, bi1 = *(const f32x4*)(bip + 4);
    const f32x4 re0 = br0 * wr - bi0 * wi, re1 = br1 * wr - bi1 * wi, im0 = bi0 * wr + br0 * wi, im1 = bi1 * wr + br1 * wi;
    v4u o; bf16* dst = MATS + (size_t)(g * 256 + dir * 128 + p) * KS + s * 16 + hh * 8;
    o.x = pk2(re0.x, re0.y); o.y = pk2(re0.z, re0.w); o.z = pk2(re1.x, re1.y); o.w = pk2(re1.z, re1.w); *(v4u*)dst = o;
    o.x = pk2(im0.x, im0.y); o.y = pk2(im0.z, im0.w); o.z = pk2(im1.x, im1.y); o.w = pk2(im1.z, im1.w); *(v4u*)(dst + (size_t)64 * KS) = o;
}
__device__ __forceinline__ void gen_carry_item(const SsmP& P, bf16* MATY, int it, int lane) {
    const int tau = it & 31, dir = (it >> 5) & 1, g = it >> 6, dg = dir * NG + g;
    float lrdt, lidt, cr, ci, pr, pi; lam_of(P, dg, lane, lrdt, lidt, cr, ci); apow(lrdt, lidt, (float)(dir ? TC - tau : tau + 1), pr, pi);
#pragma unroll
    for (int h = 0; h < HC; ++h) { const float c_r = P.c_re[(size_t)(dg * HC + h) * PS + lane], c_i = P.c_im[(size_t)(dg * HC + h) * PS + lane];
        bf16* dst = MATY + (size_t)(g * 512 + tau * 16 + h) * KY + 512 + dir * 128 + lane;
        dst[0] = (bf16)f2bf(c_r * pr - c_i * pi); dst[64] = (bf16)f2bf(-(c_r * pi + c_i * pr)); }
}
__device__ __forceinline__ void gen_toep_item(const SsmP& P, bf16* MATY, LAS float* scr, int it, int lane) {
    const int g = it / 63, dl = it % 63 - 31, k = dl < 0 ? -dl : dl;
    LAS float* Wr = scr; LAS float* Wi = scr + 64; LAS float* Cr = scr + 128; LAS float* Ci = Cr + 16 * 65; LAS float* Br = Ci + 16 * 65; LAS float* Bi = Br + 1024;
    const int h = lane >> 2, q = lane & 3;
    float val[4] = {0.f, 0.f, 0.f, 0.f};
    for (int dir = 0; dir < 2; ++dir) {
        if ((dl > 0 && dir == 1) || (dl < 0 && dir == 0)) continue;
        const int dg = dir * NG + g;
        float lrdt, lidt, cr, ci, pr, pi; lam_of(P, dg, lane, lrdt, lidt, cr, ci); apow(lrdt, lidt, (float)k, pr, pi);
        Wr[lane] = pr * cr - pi * ci; Wi[lane] = pr * ci + pi * cr;
#pragma unroll
        for (int i = 0; i < 16; ++i) { Cr[i * 65 + lane] = P.c_re[(size_t)(dg * HC + i) * PS + lane]; Ci[i * 65 + lane] = P.c_im[(size_t)(dg * HC + i) * PS + lane];
            Br[i * 64 + lane] = P.b_re[(size_t)dg * 1024 + i * 64 + lane]; Bi[i * 64 + lane] = P.b_im[(size_t)dg * 1024 + i * 64 + lane]; }
        LDS_WAIT(); asm volatile("" ::: "memory");
        for (int p = 0; p < 64; ++p) { const float wr = Wr[p], wi = Wi[p], c_r = Cr[h * 65 + p], c_i = Ci[h * 65 + p], tr = c_r * wr - c_i * wi, ti = c_r * wi + c_i * wr;
            const f32x4 b_r = *(const LAS f32x4*)(Br + p * 16 + 4 * q), b_i = *(const LAS f32x4*)(Bi + p * 16 + 4 * q);
            val[0] += tr * b_r.x - ti * b_i.x; val[1] += tr * b_r.y - ti * b_i.y; val[2] += tr * b_r.z - ti * b_i.z; val[3] += tr * b_r.w - ti * b_i.w; }
        LDS_WAIT(); asm volatile("" ::: "memory");
    }
    if (dl == 0) { const float dsk = P.dskip[g * HC + h];
#pragma unroll
        for (int j = 0; j < 4; ++j) if (4 * q + j == h) val[j] += dsk; }
    v2u o; o.x = pk2(val[0], val[1]); o.y = pk2(val[2], val[3]);
    const int t_lo = dl > 0 ? dl : 0, t_hi = dl < 0 ? TC - 1 + dl : TC - 1;
    for (int tau = t_lo; tau <= t_hi; ++tau) { const int s = tau - dl; *(v2u*)(MATY + (size_t)(g * 512 + tau * 16 + h) * KY + s * 16 + 4 * q) = o; }
}

namespace pg8 {
struct GroupOrder {
    int rm, rn, nwg, G, c;
    __device__ void init(int ng, int rm_, int rn_, int G_, int c_) { rm = rm_; rn = rn_; nwg = ng * rm * rn; G = G_; c = c_; }
    __device__ bool next(int i, Unit& u) const { const long L = (long)i * G + c; if (L >= nwg) return false; const int per = rm * rn, gi = (int)L / per, r = (int)L % per; u.pm = gi * rm + r % rm; u.pn = gi * rn + r / rm; return true; }
    __device__ __forceinline__ void a_ready(const Unit&) const {}
    __device__ __forceinline__ void done(const Unit&) const {}
};
struct EpiWin {
    static constexpr bool PERM = true, AFTER_DRAIN = false, MIDK = false;
    bf16_t* QKV; bf16_t* UA; const float* SS;
    __device__ __forceinline__ void operator()(const f32x4 (&acc)[2][2][4][2], const Unit& u, int wr, int wc, int fr, int fq) const {
        const int row0 = u.pm * BM + wr * 64 + fr;
#pragma unroll
        for (int ai = 0; ai < 2; ++ai)
#pragma unroll
            for (int m = 0; m < 4; ++m) { const int r = row0 + ai * HALF + m * 16; const float rs = rstd16(SS + (size_t)r * 16);
#pragma unroll
                for (int bj = 0; bj < 2; ++bj) { const f32x4 v0 = acc[ai][bj][m][0] * rs, v1 = acc[ai][bj][m][1] * rs;
                    u32x4 w; w.x = cvt_pk_bf16(v0[0], v0[1]); w.y = cvt_pk_bf16(v0[2], v0[3]); w.z = cvt_pk_bf16(v1[0], v1[1]); w.w = cvt_pk_bf16(v1[2], v1[3]);
                    if (u.pn < 3) { *(u32x4*)(QKV + (size_t)r * 768 + u.pn * BM + bj * HALF + wc * 32 + 8 * fq) = w; }
                    else { const int ucol = (u.pn - 3) * BM + bj * HALF + wc * 32 + 8 * fq, gi = ucol >> 4, h0 = ucol & 15, b = r >> 11, t = r & 2047, c = t >> 5, tau = t & 31;
                        *(u32x4*)(UA + (size_t)(gi * 512 + b * 64 + c) * KY + tau * 16 + h0) = w; } } }
    }
};
struct EpiStates {
    static constexpr bool PERM = false, AFTER_DRAIN = true, MIDK = false;
    float* SST; bf16_t* UA; const float *lam_re, *lam_im, *log_dt;
    __device__ __forceinline__ void fused(f32x4 (&acc)[2][2][4][2], const Unit& u, int wr, int wc, int fr, int fq, PG8_LAS unsigned char* lds, int wid, int lane) const {
#pragma unroll
        for (int ai = 0; ai < 2; ++ai)
#pragma unroll
            for (int m = 0; m < 4; ++m) { float* rowp = SST + (size_t)(u.pm * BM + ai * HALF + wr * 64 + m * 16 + fr) * 256 + wc * 32 + 4 * fq;
#pragma unroll
                for (int bj = 0; bj < 2; ++bj)
#pragma unroll
                    for (int n = 0; n < 2; ++n) *(f32x4*)(rowp + bj * HALF + n * 16) = acc[ai][bj][m][n]; }
        __threadfence(); __syncthreads();
        __builtin_amdgcn_fence(__ATOMIC_ACQUIRE, "agent");
        const int gi = u.pm >> 1, bl = wid >> 1, dir = wid & 1, dg = dir * NG + gi;
        const float lr = fminf(lam_re[dg * PS + lane], -1e-4f), li = lam_im[dg * PS + lane], dt = expf(log_dt[dg]);
        const float mg = expf(lr * dt * (float)TC), ang = li * dt * (float)TC, a_r = mg * cosf(ang), a_i = mg * sinf(ang);
        const size_t rowbase = (size_t)u.pm * BM + bl * 64;
        const float* sre = SST + rowbase * 256 + dir * 128 + lane;
        bf16_t* cre = UA + rowbase * KY + 512 + dir * 128 + lane;
        float xr = 0.f, xi = 0.f;
        for (int bt = 0; bt < NC / 16; ++bt) {
            float sr[16], si[16];
#pragma unroll
            for (int j = 0; j < 16; ++j) { const int i = bt * 16 + j, c = dir ? NC - 1 - i : i; sr[j] = sre[(size_t)c * 256]; si[j] = sre[(size_t)c * 256 + 64]; }
#pragma unroll
            for (int j = 0; j < 16; ++j) { const int i = bt * 16 + j, c = dir ? NC - 1 - i : i;
                cre[(size_t)c * KY] = (bf16_t)f2bf(xr); cre[(size_t)c * KY + 64] = (bf16_t)f2bf(xi);
                const float nr = a_r * xr - a_i * xi + sr[j]; xi = a_r * xi + a_i * xr + si[j]; xr = nr; }
        }
    }
};
struct EpiSsmOut {
    static constexpr bool PERM = true, AFTER_DRAIN = false, MIDK = false;
    bf16_t* YG;
    __device__ __forceinline__ void operator()(const f32x4 (&acc)[2][2][4][2], const Unit& u, int wr, int wc, int fr, int fq) const {
        const int gi = u.pm >> 1;
#pragma unroll
        for (int ai = 0; ai < 2; ++ai)
#pragma unroll
            for (int m = 0; m < 4; ++m) { const int bc = ((u.pm & 1) * BM + ai * HALF + wr * 64 + m * 16 + fr), b = bc >> 6, c = bc & 63;
#pragma unroll
                for (int bj = 0; bj < 2; ++bj) { const int col = (u.pn & 1) * BM + bj * HALF + wc * 32 + 8 * fq, tau = col >> 4, h0 = col & 15;
                    const f32x4 v0 = acc[ai][bj][m][0], v1 = acc[ai][bj][m][1];
                    u32x4 w; w.x = cvt_pk_bf16(gelu_tanh(v0[0]), gelu_tanh(v0[1])); w.y = cvt_pk_bf16(gelu_tanh(v0[2]), gelu_tanh(v0[3]));
                    w.z = cvt_pk_bf16(gelu_tanh(v1[0]), gelu_tanh(v1[1])); w.w = cvt_pk_bf16(gelu_tanh(v1[2]), gelu_tanh(v1[3]));
                    *(u32x4*)(YG + (size_t)(b * SEQ + c * TC + tau) * SWD + gi * 16 + h0) = w; } }
    }
};
}

struct Args { const float* in[26]; float* out; unsigned char* ws; int ph_lo, ph_hi; };
constexpr int N_PHASES = 11;
constexpr int F2_ITEMS = (DM / 64) * (FF / 32), F2_SPLIT = 1536;
__device__ __forceinline__ void ffn2_item(const Args& args, bf16* WT2, bf16* WD2, LAS float* scr, int it, int lane) {
    if (it < F2_ITEMS) p0_transpose_item<1>(args.in[22], DM, FF, WT2, scr, it, lane);
    else if (it < 2 * F2_ITEMS) p0_transpose_item<2>(args.in[23], DM, FF, WT2, scr, it - F2_ITEMS, lane);
    else p0_transpose_item<0>(args.in[24], FF, DM, WD2, scr, it - 2 * F2_ITEMS, lane);
}
__global__ void __launch_bounds__(512, 2) mk_fwd(Args args) {
    extern __shared__ __attribute__((aligned(16))) unsigned char lds_raw[];
    LAS unsigned char* lds = (LAS unsigned char*)lds_raw;
    cg::grid_group grid = cg::this_grid();
    const int tid = threadIdx.x, lane = tid & 63, wave = __builtin_amdgcn_readfirstlane(tid >> 6);
    const int G = gridDim.x, bid = blockIdx.x;
    const int gw = bid * 8 + wave, NGW = G * 8;
    unsigned char* ws = args.ws;
    const float* x = args.in[0];
    float* X = args.out;
    bf16* WT1 = (bf16*)(ws + WS_WT1); bf16* WD1 = (bf16*)(ws + WS_WD1); bf16* WT2 = (bf16*)(ws + WS_WT2); bf16* WD2 = (bf16*)(ws + WS_WD2);
    bf16* WIN = (bf16*)(ws + WS_WIN); bf16* WOUT = (bf16*)(ws + WS_WOUT); bf16* WGLU = (bf16*)(ws + WS_WGLU);
    bf16* XA = (bf16*)(ws + WS_XA); bf16* HB = (bf16*)(ws + WS_H); bf16* QKV = (bf16*)(ws + WS_QKV); bf16* YG = (bf16*)(ws + WS_YG);
    float* SS1 = (float*)(ws + WS_SS1); float* SS2 = (float*)(ws + WS_SS2); float* SSA = (float*)(ws + WS_SSA); float* SSS = (float*)(ws + WS_SSS); bf16* MIX = (bf16*)(ws + WS_MIX); bf16* MATS = (bf16*)(ws + WS_MATS); bf16* MATY = (bf16*)(ws + WS_MATY); bf16* UA = (bf16*)(ws + WS_UA); float* SST = (float*)(ws + WS_SST);
    const SsmP SP{args.in[8], args.in[9], args.in[10], args.in[11], args.in[12], args.in[13], args.in[14], args.in[15]};
    const int lo = args.ph_lo, hi = args.ph_hi;
    volatile LAS unsigned* MISC = (volatile LAS unsigned*)(lds + MISC_OFF);
    if (tid < 32) MISC[tid] = 0u;
    __syncthreads();
    XcdBarrier bar = xcd_barrier_post((unsigned*)ws, MISC + 8);
    if (lo < 0) grid.sync();
#define IN(k) (lo <= (k) && (k) < hi)
#define SEAM(k) do { if (IN(k) && IN((k) + 1)) xcd_barrier(bar); } while (0)

    if (IN(0)) {
        LAS float* scr = (LAS float*)(lds + wave * 17024);
        constexpr int I_UP = (DM / 64) * (FF / 32), I_DN = (FF / 64) * (DM / 32), I_IN = (DM / 64) * (INW / 32), I_GLU = (SWD / 64) * (SWD / 32), I_OUT = (DM / 64) * (DM / 32);
        constexpr int NITEMS = 3 * I_UP + I_IN + I_GLU + I_OUT;
        for (int it = gw; it < NITEMS; it += NGW) {
            int r = it;
            if (r < I_UP) { p0_transpose_item<1>(args.in[2], DM, FF, WT1, scr, r, lane); continue; } r -= I_UP;
            if (r < I_UP) { p0_transpose_item<2>(args.in[3], DM, FF, WT1, scr, r, lane); continue; } r -= I_UP;
            if (r < I_DN) { p0_transpose_item<0>(args.in[4], FF, DM, WD1, scr, r, lane); continue; } r -= I_DN;
            if (r < I_IN) { p0_transpose_item<0>(args.in[6], DM, INW, WIN, scr, r, lane); continue; } r -= I_IN;
            if (r < I_GLU) { p0_transpose_item<0>(args.in[16], SWD, SWD, WGLU, scr, r, lane); continue; } r -= I_GLU;
            p0_transpose_item<0>(args.in[20], DM, DM, WOUT, scr, r, lane);
        }
        for (int it = gw; it < 32 * 63; it += NGW) gen_toep_item(SP, MATY, scr, it, lane);
        for (int it = gw; it < 32 * 2 * 64; it += NGW) gen_states_item(SP, MATS, it, lane);
        for (int it = gw; it < 32 * 2 * 32; it += NGW) gen_carry_item(SP, MATY, it, lane);
        for (int m = gw; m < M; m += NGW) rms_row_to_bf16(x + (size_t)m * DM, args.in[1], XA + (size_t)m * DM, lane);
    }
    SEAM(0);
    if (IN(1)) { pg8::Gemm g{XA, WT1, M, 2 * FF, DM, DM, DM}; pg8::StaticOrder S; S.init(M, 2 * FF, G, bid); pg8::EpiSwiglu<false> E{HB, FF, nullptr};
        pg8::gemm_phase<pg8::EpiSwiglu<false>, pg8::StaticOrder, true, true>(lds, g, S, E); }
    SEAM(1);
    if (IN(2)) { pg8::Gemm g{HB, WD1, M, DM, FF, FF, FF}; pg8::StaticOrder S; S.init(M, DM, G, bid); pg8::EpiResidNorm<false> E{x, X, 0.5f, args.in[5], XA, SS1, nullptr};
        pg8::gemm_phase<pg8::EpiResidNorm<false>, pg8::StaticOrder, true, true>(lds, g, S, E); }
    SEAM(2);
    if (IN(3)) { pg8::Gemm g{XA, WIN, M, INW, DM, DM, DM}; pg8::StaticOrder S; S.init(M, INW, G, bid); pg8::EpiWin E{QKV, UA, SS1};
        pg8::gemm_phase<pg8::EpiWin, pg8::StaticOrder, true, true>(lds, g, S, E); }
    SEAM(3);
    if (IN(4)) {
        { pg8::Gemm g{UA, MATS, 32 * 512, 32 * 256, KS, KY, KS}; pg8::GroupOrder S; S.init(32, 2, 1, G, bid); pg8::EpiStates E{SST, UA, SP.lam_re, SP.lam_im, SP.log_dt};
          if (G >= 64) pg8::gemm_phase<pg8::EpiStates, pg8::GroupOrder, false, true>(lds, g, S, E); }
        if (bid >= 64) attn_mfma(lds, QKV, MIX, SSA, args.in[18], args.in[7], bid - 64, 192, 192);
    }
    SEAM(4);
    if (IN(5)) { pg8::Gemm g{UA, MATY, 32 * 512, 32 * 512, KY, KY, KY}; pg8::GroupOrder S; S.init(32, 2, 2, G, bid); pg8::EpiSsmOut E{YG};
        pg8::gemm_phase<pg8::EpiSsmOut, pg8::GroupOrder, true, true>(lds, g, S, E);
        if (bid >= 128 && bid < 192) attn_mfma(lds, QKV, MIX, SSA, args.in[18], args.in[7], 192 + (bid - 128), 256, 64);
        if (bid >= 192) { LAS float* scr = (LAS float*)(lds + wave * 17024);
            for (int it = (bid - 192) * 8 + wave; it < F2_SPLIT; it += 512) ffn2_item(args, WT2, WD2, scr, it, lane); } }
    SEAM(5);
    if (IN(6)) { pg8::Gemm g{YG, WGLU, M, SWD, SWD, SWD, SWD}; pg8::StaticOrder S; S.init(M, SWD, G, bid); pg8::EpiGlu E{YG, MIX, args.in[17], args.in[19], SSS};
        pg8::gemm_phase<pg8::EpiGlu, pg8::StaticOrder, true, true>(lds, g, S, E);
        if (bid >= 128) { LAS float* scr = (LAS float*)(lds + wave * 17024);
            for (int it = F2_SPLIT + (bid - 128) * 8 + wave; it < 3 * F2_ITEMS; it += 1024) ffn2_item(args, WT2, WD2, scr, it, lane); } }
    SEAM(6);
    if (IN(7)) { pg8::Gemm g{MIX, WOUT, M, DM, DM, DM, DM}; pg8::StaticOrder S; S.init(M, DM, G, bid);
        LAS float* TAB = (LAS float*)(lds + 131072);
        { pg8::Unit u0; if (S.next(0, u0) && tid < 256) { const int row = u0.pm * 256 + tid; const float ra = pg8::rstd8(SSA + (size_t)row * 8), rs = pg8::rstd8(SSS + (size_t)row * 8); TAB[tid * 2] = ra / rs; TAB[tid * 2 + 1] = rs; } }
        __syncthreads();
        pg8::EpiResidNorm<true> E{X, X, 1.0f, args.in[21], XA, SS2, TAB};
        pg8::gemm_phase<pg8::EpiResidNorm<true>, pg8::StaticOrder, true, true>(lds, g, S, E); }
    SEAM(7);
    if (IN(8)) { pg8::Gemm g{XA, WT2, M, 2 * FF, DM, DM, DM}; pg8::StaticOrder S; S.init(M, 2 * FF, G, bid); pg8::EpiSwiglu<true> E{HB, FF, SS2};
        pg8::gemm_phase<pg8::EpiSwiglu<true>, pg8::StaticOrder, true, true>(lds, g, S, E); }
    SEAM(8);
    if (IN(9)) { pg8::Gemm g{HB, WD2, M, DM, FF, FF, FF}; pg8::StaticOrder S; S.init(M, DM, G, bid); pg8::EpiResid E{X, X, 0.5f};
        pg8::gemm_phase<pg8::EpiResid, pg8::StaticOrder, true, true>(lds, g, S, E); }
    SEAM(9);
    if (IN(10)) { for (int m = gw; m < M; m += NGW) rms_row_f32(X + (size_t)m * DM, args.in[25], lane); }
#undef IN
#undef SEAM
}

extern "C" void kernel_launch(void* const* d_in, const int* in_sizes, int n_in, void* d_out, int out_size, void* d_ws, size_t ws_size, hipStream_t stream) {
    static int grid = 0;
    if (grid == 0) {
        if (n_in != 26 || in_sizes[0] != M * DM || out_size != M * DM || ws_size < WS_END) { fprintf(stderr, "kernel_launch: unexpected shapes n_in %d in0 %d out %d ws %zu\n", n_in, n_in > 0 ? in_sizes[0] : -1, out_size, ws_size); grid = -1; return; }
        int dev = 0, cus = 0, per_cu = 0;
        (void)hipGetDevice(&dev); (void)hipDeviceGetAttribute(&cus, hipDeviceAttributeMultiprocessorCount, dev);
        if (hipFuncSetAttribute((const void*)mk_fwd, hipFuncAttributeMaxDynamicSharedMemorySize, LDS_BYTES) != hipSuccess) { fprintf(stderr, "kernel_launch: hipFuncSetAttribute failed\n"); grid = -1; return; }
        if (hipOccupancyMaxActiveBlocksPerMultiprocessor(&per_cu, (const void*)mk_fwd, 512, LDS_BYTES) != hipSuccess || per_cu < 1) { fprintf(stderr, "kernel_launch: occupancy query says %d\n", per_cu); per_cu = 1; }
        (void)hipGetLastError();
        grid = cus * per_cu;
        if (grid != 256) { fprintf(stderr, "kernel_launch: this kernel is built for a 256-workgroup grid (one per CU of a 256-CU device), got %d; nothing launched\n", grid); grid = -1; return; }
        fprintf(stderr, "kernel_launch: grid %d (cus %d per_cu %d)\n", grid, cus, per_cu);
    }
    if (grid < 0) return;
    if (hipMemsetAsync(d_ws, 0, CTL_ZERO_BYTES, stream) != hipSuccess) { fprintf(stderr, "kernel_launch: hipMemsetAsync failed\n"); return; }
    Args a{};
    for (int i = 0; i < 26; ++i) a.in[i] = (const float*)d_in[i];
    a.out = (float*)d_out; a.ws = (unsigned char*)d_ws;
#if MK_MULTI
    for (int ph = 0; ph < N_PHASES; ++ph) { a.ph_lo = ph; a.ph_hi = ph + 1; hipLaunchKernelGGL(mk_fwd, dim3(grid), dim3(512), LDS_BYTES, stream, a); }
#else
    a.ph_lo = 0; a.ph_hi = N_PHASES;
    void* kargs[] = {&a};
    hipError_t e = hipLaunchCooperativeKernel((const void*)mk_fwd, dim3(grid), dim3(512), kargs, LDS_BYTES, stream);
    if (e != hipSuccess) fprintf(stderr, "cooperative launch failed: %s (grid %d)\n", hipGetErrorString(e), grid);
#endif
}
```

```cpp
#include <hip/hip_runtime.h>
#include <hip/hip_cooperative_groups.h>
#include <cstdio>
#include <cstdint>
namespace cg = cooperative_groups;
#define MK_MULTI 0
namespace pg8 {
#define PG8_LAS __attribute__((address_space(3)))
typedef unsigned short bf16_t;
typedef short bf16x8 __attribute__((ext_vector_type(8)));
typedef float f32x4 __attribute__((ext_vector_type(4)));
typedef unsigned u32x4 __attribute__((ext_vector_type(4)));
constexpr int BM = 256, BK = 64, HALF = 128, HTB = HALF * BK * 2  , STAGE_BYTES = 8 * HTB, NXCD = 8, WGM = 8;

__host__ __device__ __forceinline__ int lds_byte(int r, int c) { const int st = (r >> 4) * 2 + (c >> 5), rr = r & 15, cc = c & 31, ob = rr * 64 + cc * 2; return st * 1024 + (ob ^ (((ob >> 9) & 1) << 5)); }
__host__ __device__ __forceinline__ void stage_rc(int b, int& R, int& C) { const int st = b / 1024, sb = b % 1024, swz = sb ^ (((sb >> 9) & 1) << 5); R = (st >> 1) * 16 + swz / 64; C = (st & 1) * 32 + (swz % 64) / 2; }
__host__ __device__ __forceinline__ int perm32(int rho) { const int n = rho >> 4, i = rho & 15; return 8 * (i >> 2) + 4 * n + (i & 3); }

struct Unit { int pm, pn; };
struct Gemm { const bf16_t* A; const bf16_t* Bt; int M, N, K, lda, ldb; };

struct StaticOrder {
    int nM, nN, nwg, G, c;
    __host__ __device__ void init(int M, int N, int G_, int c_) { nM = M / BM; nN = N / BM; nwg = nM * nN; G = G_; c = c_; }
    __host__ __device__ bool next(int i, Unit& u) const {
        const long L = (long)i * G + c; if (L >= nwg) return false;
        int wgid = (int)L; { const int q = nwg / NXCD, r = nwg % NXCD, xcd = wgid % NXCD, off = wgid / NXCD; wgid = (xcd < r ? xcd * (q + 1) : r * (q + 1) + (xcd - r) * q) + off; }
        const int nig = WGM * nN, gid = wgid / nig, fm = gid * WGM, gsz = (nM - fm) < WGM ? (nM - fm) : WGM;
        u.pm = fm + ((wgid % nig) % gsz); u.pn = (wgid % nig) / gsz; return true;
    }
    __device__ __forceinline__ void a_ready(const Unit&) const {}
    __device__ __forceinline__ void done(const Unit&) const {}
};

__device__ __forceinline__ unsigned cvt_pk_bf16(float lo, float hi) { unsigned r; asm volatile("v_cvt_pk_bf16_f32 %0, %1, %2" : "=v"(r) : "v"(lo), "v"(hi)); return r; }
typedef float f32x2 __attribute__((ext_vector_type(2)));
__device__ __forceinline__ f32x2 gelu_pk(f32x2 v) {
    const f32x2 av = __builtin_elementwise_abs(v), d = av * 0.2316418882f + 1.0f;
    f32x2 t; t.x = __builtin_amdgcn_rcpf(d.x); t.y = __builtin_amdgcn_rcpf(d.y);
    f32x2 q = t * 0.5307027145f + (-0.7265760135f); q = q * t + 0.7107068705f; q = q * t + (-0.142248368f); q = q * t + 0.127414796f; q = q * t;
    const f32x2 s = (v * v) * (-0.72134752044f);
    f32x2 e; e.x = __builtin_amdgcn_exp2f(s.x); e.y = __builtin_amdgcn_exp2f(s.y);
    const f32x2 m = v * (q * e), r = v - m;
    f32x2 o; o.x = v.x < 0.f ? m.x : r.x; o.y = v.y < 0.f ? m.y : r.y; return o;
}

template <int ACT  > struct EpiBf16 {
    static constexpr bool PERM = true, AFTER_DRAIN = false; static_assert(ACT == 0 || ACT == 1, "EpiBf16: ACT is 0 (none) or 1 (gelu_pk)");
    bf16_t* O; int ldc; const float* bias; int split_cols; size_t split_stride; float scale0;
    __device__ __forceinline__ void operator()(const f32x4 (&acc)[2][2][4][2], const Unit& u, int wr, int wc, int fr, int fq) const {
        const int row0 = u.pm * BM + wr * 64 + fr; int colt = u.pn * BM; bf16_t* base = O;
        float sc = 1.f; if (split_cols) { const int t = colt / split_cols; base += (size_t)t * split_stride; colt -= t * split_cols; if (t == 0) sc = scale0; }
        const int col0 = colt + wc * 32 + 8 * fq, bcol0 = u.pn * BM + wc * 32 + 8 * fq;
        f32x4 bv[2][2];
#pragma unroll
        for (int bj = 0; bj < 2; ++bj)
#pragma unroll
            for (int n = 0; n < 2; ++n) bv[bj][n] = bias ? *(const f32x4*)(bias + bcol0 + bj * HALF + 4 * n) : (f32x4){0.f, 0.f, 0.f, 0.f};
#pragma unroll
        for (int ai = 0; ai < 2; ++ai)
#pragma unroll
            for (int m = 0; m < 4; ++m) { bf16_t* rowp = base + (size_t)(row0 + ai * HALF + m * 16) * ldc + col0;
#pragma unroll
                for (int bj = 0; bj < 2; ++bj) { f32x4 v0 = acc[ai][bj][m][0] + bv[bj][0], v1 = acc[ai][bj][m][1] + bv[bj][1];
                    if (ACT == 1) { f32x2 a = gelu_pk((f32x2){v0[0], v0[1]}), b = gelu_pk((f32x2){v0[2], v0[3]}), c = gelu_pk((f32x2){v1[0], v1[1]}), d = gelu_pk((f32x2){v1[2], v1[3]});
                        v0 = (f32x4){a.x, a.y, b.x, b.y}; v1 = (f32x4){c.x, c.y, d.x, d.y}; }
                    v0 = v0 * sc; v1 = v1 * sc; u32x4 w; w.x = cvt_pk_bf16(v0[0], v0[1]); w.y = cvt_pk_bf16(v0[2], v0[3]); w.z = cvt_pk_bf16(v1[0], v1[1]); w.w = cvt_pk_bf16(v1[2], v1[3]);
                    *(u32x4*)(rowp + bj * HALF) = w; } }
    }
};
template <class Epi, class Sched, bool ALIGN_EPI = false, bool SP2 = false>
__device__ __forceinline__ void gemm_phase(PG8_LAS unsigned char* lds, const Gemm g, const Sched& S, const Epi& E) {
    const int tid = threadIdx.x, wid = __builtin_amdgcn_readfirstlane(tid >> 6), lane = tid & 63, wr = wid >> 2, wc = wid & 3, fr = lane & 15, fq = lane >> 4;
    const int K = g.K, nt = K / BK;
    unsigned voffA[2], voffB[2];
#pragma unroll
    for (int i = 0; i < 2; ++i) { int R, C; stage_rc(tid * 16 + i * 8192, R, C); const int Rb = Epi::PERM ? ((R & ~31) + perm32(R & 31)) : R;
        voffA[i] = (unsigned)(R * g.lda + C) * 2u; voffB[i] = (unsigned)(Rb * g.ldb + C) * 2u; }
    const size_t kstep = (size_t)(BK * 2);
    const size_t hstepA = (size_t)HALF * g.lda * 2, hstepB = (size_t)HALF * g.ldb * 2;
    const size_t tstepA = 2 * hstepA, tstepB = 2 * hstepB;
    const unsigned ldsw = (unsigned)wid * 1024u;
    const int aoff = lds_byte(wr * 64 + fr, fq * 8), boff = lds_byte(wc * 32 + fr, fq * 8);
#define PG8_SA(b, h) (((b) * 2 + (h)) * HTB)
#define PG8_SB(b, h) ((4 + (b) * 2 + (h)) * HTB)
#define PG8_STAGE(bufoff, gbase, voff) do { _Pragma("unroll") for (int _i = 0; _i < 2; ++_i) \
        __builtin_amdgcn_global_load_lds((const unsigned*)((const char*)(gbase) + (voff)[_i]), (PG8_LAS unsigned*)(lds + (bufoff) + ldsw + _i * 8192), 16, 0, 0); } while (0)
#define PG8_LDA(dst, b, h) do { _Pragma("unroll") for (int m = 0; m < 4; ++m) _Pragma("unroll") for (int k = 0; k < 2; ++k) dst[m][k] = *(const PG8_LAS bf16x8*)(lds + PG8_SA(b, h) + aoff + m * 2048 + k * 1024); } while (0)
#define PG8_LDB(dst, b, h) do { _Pragma("unroll") for (int n = 0; n < 2; ++n) _Pragma("unroll") for (int k = 0; k < 2; ++k) dst[n][k] = *(const PG8_LAS bf16x8*)(lds + PG8_SB(b, h) + boff + n * 2048 + k * 1024); } while (0)
#define PG8_MMA(ai, bj, At, Bt) do { __builtin_amdgcn_s_setprio(1); _Pragma("unroll") for (int m = 0; m < 4; ++m) _Pragma("unroll") for (int n = 0; n < 2; ++n) _Pragma("unroll") for (int k = 0; k < 2; ++k) \
        acc[ai][bj][m][n] = __builtin_amdgcn_mfma_f32_16x16x32_bf16(Bt[n][k], At[m][k], acc[ai][bj][m][n], 0, 0, 0); __builtin_amdgcn_s_setprio(0); } while (0)
#define PG8_WAIT_V(n) asm volatile("s_waitcnt vmcnt(" #n ")" ::: "memory")
#define PG8_WAIT_L(n) asm volatile("s_waitcnt lgkmcnt(" #n ")" ::: "memory")
#define PG8_BAR __builtin_amdgcn_s_barrier()
#define PG8_SCHED __builtin_amdgcn_sched_barrier(0)
    Unit cur, nxt; int ui = 0;
    if (!S.next(0, cur)) return;
    f32x4 acc[2][2][4][2];
#pragma unroll
    for (int a = 0; a < 2; ++a)
#pragma unroll
        for (int b = 0; b < 2; ++b)
#pragma unroll
            for (int m = 0; m < 4; ++m)
#pragma unroll
                for (int n = 0; n < 2; ++n) acc[a][b][m][n] = (f32x4){0.f, 0.f, 0.f, 0.f};
    bf16x8 At[4][2], B0[2][2], B1[2][2];
    const char* cA = (const char*)g.A + (size_t)cur.pm * tstepA; const char* cB = (const char*)g.Bt + (size_t)cur.pn * tstepB;
    S.a_ready(cur);
    if constexpr (SP2) {
        PG8_STAGE(PG8_SB(0, 0), cB, voffB); PG8_STAGE(PG8_SB(0, 1), cB + hstepB, voffB); PG8_STAGE(PG8_SA(0, 0), cA, voffA); PG8_STAGE(PG8_SA(0, 1), cA + hstepA, voffA);
        if (wr == 1) PG8_BAR;
        PG8_WAIT_V(2); PG8_BAR;
        PG8_STAGE(PG8_SB(1, 0), cB + kstep, voffB); PG8_STAGE(PG8_SA(1, 0), cA + kstep, voffA); PG8_STAGE(PG8_SB(1, 1), cB + hstepB + kstep, voffB);
        PG8_WAIT_V(6); PG8_BAR;
    } else {
        PG8_STAGE(PG8_SB(0, 0), cB, voffB); PG8_STAGE(PG8_SA(0, 0), cA, voffA); PG8_STAGE(PG8_SB(0, 1), cB + hstepB, voffB); PG8_STAGE(PG8_SA(0, 1), cA + hstepA, voffA);
        if (wr == 1) PG8_BAR;
        PG8_WAIT_V(4); PG8_BAR;
        PG8_STAGE(PG8_SB(1, 0), cB + kstep, voffB); PG8_STAGE(PG8_SA(1, 0), cA + kstep, voffA); PG8_STAGE(PG8_SB(1, 1), cB + hstepB + kstep, voffB);
        PG8_WAIT_V(6); PG8_BAR;
    }
    for (;;) {
        const bool has_next = S.next(ui + 1, nxt);
        const char* nA = has_next ? (const char*)g.A + (size_t)nxt.pm * tstepA : cA; const char* nB = has_next ? (const char*)g.Bt + (size_t)nxt.pn * tstepB : cB;
        for (int t = 0; t < nt; t += 2) {
            if constexpr (Epi::MIDK) { if (t == nt / 2) E.midk(acc, cur, wr, fr); }
            const bool last = (t == nt - 2);
            const char* a1 = cA + (size_t)(t + 1) * kstep;
            const char* a2 = last ? nA : cA + (size_t)(t + 2) * kstep; const char* b2 = last ? nB : cB + (size_t)(t + 2) * kstep;
            const char* a3 = a2 + kstep; const char* b3 = b2 + kstep;
            if (last && has_next) S.a_ready(nxt);
            if constexpr (SP2) {
            PG8_LDB(B0, 0, 0); PG8_LDB(B1, 0, 1); PG8_SCHED; PG8_LDA(At, 0, 0); PG8_STAGE(PG8_SA(1, 1), a1 + hstepA, voffA);
            PG8_WAIT_V(8); PG8_WAIT_L(0); PG8_BAR; PG8_MMA(0, 0, At, B0); PG8_MMA(0, 1, At, B1); PG8_BAR; PG8_SCHED;
            PG8_LDA(At, 0, 1); PG8_STAGE(PG8_SB(0, 0), b2, voffB); PG8_STAGE(PG8_SB(0, 1), b2 + hstepB, voffB); PG8_STAGE(PG8_SA(0, 0), a2, voffA);
            PG8_WAIT_V(8); PG8_WAIT_L(0); PG8_BAR; PG8_MMA(1, 0, At, B0); PG8_MMA(1, 1, At, B1); PG8_BAR; PG8_SCHED;
            PG8_LDB(B0, 1, 0); PG8_LDB(B1, 1, 1); PG8_SCHED; PG8_LDA(At, 1, 0); PG8_STAGE(PG8_SA(0, 1), a2 + hstepA, voffA);
            PG8_WAIT_V(8); PG8_WAIT_L(0); PG8_BAR; PG8_MMA(0, 0, At, B0); PG8_MMA(0, 1, At, B1); PG8_BAR; PG8_SCHED;
            PG8_LDA(At, 1, 1); PG8_STAGE(PG8_SB(1, 0), b3, voffB); PG8_STAGE(PG8_SB(1, 1), b3 + hstepB, voffB); PG8_STAGE(PG8_SA(1, 0), a3, voffA);
            PG8_WAIT_V(8); PG8_WAIT_L(0); PG8_BAR; PG8_MMA(1, 0, At, B0); PG8_MMA(1, 1, At, B1); PG8_BAR; PG8_SCHED;
            } else {
            PG8_LDB(B0, 0, 0); PG8_SCHED; PG8_LDA(At, 0, 0); PG8_STAGE(PG8_SA(1, 1), a1 + hstepA, voffA);
            PG8_WAIT_L(8); PG8_BAR; PG8_WAIT_L(0); PG8_MMA(0, 0, At, B0); PG8_BAR; PG8_SCHED;
            PG8_LDB(B1, 0, 1); PG8_STAGE(PG8_SB(0, 0), b2, voffB);
            PG8_BAR; PG8_WAIT_L(0); PG8_MMA(0, 1, At, B1); PG8_BAR;
            PG8_LDA(At, 0, 1); PG8_STAGE(PG8_SA(0, 0), a2, voffA);
            PG8_BAR; PG8_WAIT_L(0); PG8_MMA(1, 0, At, B0); PG8_BAR; PG8_SCHED;
            PG8_STAGE(PG8_SB(0, 1), b2 + hstepB, voffB);
            PG8_WAIT_V(6); PG8_BAR; PG8_MMA(1, 1, At, B1); PG8_BAR;
            PG8_LDB(B0, 1, 0); PG8_SCHED; PG8_LDA(At, 1, 0); PG8_STAGE(PG8_SA(0, 1), a2 + hstepA, voffA);
            PG8_WAIT_L(8); PG8_BAR; PG8_WAIT_L(0); PG8_MMA(0, 0, At, B0); PG8_BAR; PG8_SCHED;
            PG8_LDB(B1, 1, 1); PG8_STAGE(PG8_SB(1, 0), b3, voffB);
            PG8_BAR; PG8_WAIT_L(0); PG8_MMA(0, 1, At, B1); PG8_BAR;
            PG8_LDA(At, 1, 1); PG8_STAGE(PG8_SA(1, 0), a3, voffA);
            PG8_BAR; PG8_WAIT_L(0); PG8_MMA(1, 0, At, B0); PG8_BAR; PG8_SCHED;
            PG8_STAGE(PG8_SB(1, 1), b3 + hstepB, voffB);
            PG8_WAIT_V(6); PG8_BAR; PG8_MMA(1, 1, At, B1); PG8_BAR;
            }
        }
        if constexpr (ALIGN_EPI) { if (wr == 0) PG8_BAR; }
        if constexpr (!Epi::AFTER_DRAIN) { E(acc, cur, wr, wc, fr, fq); S.done(cur); }
        if (!has_next) break;
#pragma unroll
        for (int a = 0; a < 2; ++a)
#pragma unroll
            for (int b = 0; b < 2; ++b)
#pragma unroll
                for (int m = 0; m < 4; ++m)
#pragma unroll
                    for (int n = 0; n < 2; ++n) acc[a][b][m][n] = (f32x4){0.f, 0.f, 0.f, 0.f};
        cur = nxt; cA = nA; cB = nB; ++ui;
        if constexpr (ALIGN_EPI) { if (wr == 1) PG8_BAR; }
    }
    PG8_WAIT_V(0);
    if constexpr (!ALIGN_EPI) { if (wr == 0) PG8_BAR; }
    PG8_BAR;
    if constexpr (Epi::AFTER_DRAIN) { E.fused(acc, cur, wr, wc, fr, fq, lds, wid, lane); S.done(cur); }
#undef PG8_SA
#undef PG8_SB
#undef PG8_STAGE
#undef PG8_LDA
#undef PG8_LDB
#undef PG8_MMA
#undef PG8_WAIT_V
#undef PG8_WAIT_L
#undef PG8_BAR
#undef PG8_SCHED
}
}

#define GAS __attribute__((address_space(1)))
#define LAS __attribute__((address_space(3)))
typedef unsigned short bf16;
typedef unsigned v4u __attribute__((ext_vector_type(4)));
typedef unsigned v2u __attribute__((ext_vector_type(2)));
typedef float f32x4 __attribute__((ext_vector_type(4)));

#ifndef MK_MULTI
#define MK_MULTI 0
#endif

constexpr int BATCH = 8, SEQ = 2048, DM = 1024, M = BATCH * SEQ;
constexpr int NH = 8, HD = 64, AW = 512, SWD = 512, NG = 32, HC = 16, PS = 64, INW = 1280, FF = 2816;
constexpr float EPS = 1e-6f;
constexpr size_t MiB = 1u << 20;
constexpr size_t WS_WT1 = 2 * MiB, WS_WD1 = 14 * MiB, WS_WT2 = 20 * MiB, WS_WD2 = 32 * MiB, WS_WIN = 38 * MiB, WS_WOUT = 41 * MiB, WS_WGLU = 43 * MiB;
constexpr size_t WS_MATS = 44 * MiB;
constexpr size_t WS_SS1 = 52 * MiB, WS_SS2 = 53 * MiB;
constexpr size_t WS_SSA = 54 * MiB, WS_SSS = 55 * MiB;
constexpr size_t WS_XA = 64 * MiB;
constexpr size_t WS_YG = 64 * MiB;
constexpr size_t WS_H = 96 * MiB;
constexpr size_t WS_SST = 96 * MiB;
constexpr size_t WS_MIX = 112 * MiB;
constexpr size_t WS_UA = 168 * MiB;
constexpr size_t WS_QKV = 192 * MiB;
constexpr size_t WS_MATY = 216 * MiB;
constexpr size_t WS_END = 256 * MiB;
constexpr int TC = 32, NC = SEQ / TC, KY = 16 * TC + 256, KS = 16 * TC;
constexpr int LDS_BYTES = 147456, MISC_OFF = 147328;
constexpr size_t CTL_ZERO_BYTES = 16384;

__device__ __forceinline__ unsigned f2bf(float f) { unsigned u = __builtin_bit_cast(unsigned, f); return (u + 0x7fffu + ((u >> 16) & 1u)) >> 16; }
__device__ __forceinline__ unsigned pk2(float lo, float hi) { return f2bf(lo) | (f2bf(hi) << 16); }
__device__ __forceinline__ float bflo(unsigned w) { return __builtin_bit_cast(float, w << 16); }
__device__ __forceinline__ float bfhi(unsigned w) { return __builtin_bit_cast(float, w & 0xffff0000u); }
#define LDS_WAIT() asm volatile("s_waitcnt lgkmcnt(0)" ::: "memory")
__device__ __forceinline__ float wave_sum(float v) {
#pragma unroll
    for (int o = 1; o < 64; o <<= 1) v += __shfl_xor(v, o);
    return v;
}
__device__ __forceinline__ float sigmoidf_(float x) { return __builtin_amdgcn_rcpf(1.f + __expf(-x)); }

#define XB_TMO      128
#define XB_XCNT(j)  (256  + 64 * (j))
#define XB_XSUB(j)  (1280 + 64 * (j))
#define XB_XGEN(j)  (2304 + 64 * (j))
#define XB_TOP      3328
#define XB_TOPGEN   3392
#define XCD_BAR_WORDS 3456
#define XB_SPIN_CAP (1u << 18)

__device__ __forceinline__ unsigned xb_ld(unsigned* p)              { return __hip_atomic_load(p, __ATOMIC_RELAXED, __HIP_MEMORY_SCOPE_AGENT); }
__device__ __forceinline__ unsigned xb_add(unsigned* p, unsigned v) { return __hip_atomic_fetch_add(p, v, __ATOMIC_RELAXED, __HIP_MEMORY_SCOPE_AGENT); }
__device__ __forceinline__ unsigned xb_xcc_id() { return (unsigned)__builtin_amdgcn_s_getreg((3 << 11) | 20) & 0xFu; }
#define XB_SPIN(cond, bar) do { unsigned _sp = 0; while (cond) { __builtin_amdgcn_s_sleep(1); \
    if ((++_sp & 255u) == 0u) { if (xb_ld(&(bar)[XB_TMO])) break; if (_sp > XB_SPIN_CAP) { atomicAdd(&(bar)[XB_TMO], 1u); break; } } } } while (0)

struct XcdBarrier {
    unsigned* bar; unsigned x;
    volatile LAS unsigned* st;
};

__device__ __forceinline__ XcdBarrier xcd_barrier_post(unsigned* bar, volatile LAS unsigned* st) {
    XcdBarrier b; b.bar = bar; b.x = xb_xcc_id(); b.st = st;
    if (threadIdx.x == 0) (void)xb_add(&bar[XB_XCNT(b.x)], 1u);
    return b;
}
__device__ __forceinline__ void xcd_barrier_complete(unsigned* bar, unsigned x, unsigned& nloc, unsigned& nx) {
    const unsigned G = gridDim.x * gridDim.y * gridDim.z;
    unsigned sum, cnt, mine, sp = 0u;
    for (;;) {
        sum = 0u; cnt = 0u; mine = 0u;
#pragma unroll
        for (unsigned j = 0; j < 16; ++j) { const unsigned c = xb_ld(&bar[XB_XCNT(j)]); sum += c; cnt += (c > 0u) ? 1u : 0u; mine = (j == x) ? c : mine; }
        if (sum == G) break;
        __builtin_amdgcn_s_sleep(1);
        if ((++sp & 255u) == 0u) { if (xb_ld(&bar[XB_TMO])) break; if (sp > XB_SPIN_CAP) { atomicAdd(&bar[XB_TMO], 1u); break; } }
    }
    nloc = mine > 0u ? mine : 1u; nx = cnt > 0u ? cnt : 1u;
}

__device__ __forceinline__ void xcd_barrier(const XcdBarrier& b) {
    asm volatile("s_waitcnt vmcnt(0)" ::: "memory");
    __syncthreads();
    if (threadIdx.x == 0) {
        unsigned* bar = b.bar;
        __builtin_amdgcn_s_waitcnt(0);
        unsigned nloc = b.st[0], nx = b.st[1];
        if (nloc == 0u) { xcd_barrier_complete(bar, b.x, nloc, nx); b.st[0] = nloc; b.st[1] = nx; }
        const unsigned old = xb_add(&bar[XB_XSUB(b.x)], 1u);
        const unsigned gen = old / nloc;
        if (old + 1u == (gen + 1u) * nloc) {
            __builtin_amdgcn_fence(__ATOMIC_RELEASE, "agent");
            asm volatile("s_waitcnt vmcnt(0)" ::: "memory");
            const unsigned og = xb_add(&bar[XB_TOP], 1u);
            const unsigned tg = og / nx;
            if (og + 1u == (tg + 1u) * nx) xb_add(&bar[XB_TOPGEN], 1u);
            else XB_SPIN(xb_ld(&bar[XB_TOPGEN]) == tg, bar);
            __builtin_amdgcn_fence(__ATOMIC_ACQUIRE, "agent");
            xb_add(&bar[XB_XGEN(b.x)], 1u);
            asm volatile("s_waitcnt vmcnt(0)" ::: "memory");
        } else {
            XB_SPIN(xb_ld(&bar[XB_XGEN(b.x)]) == gen, bar);
            __builtin_amdgcn_fence(__ATOMIC_ACQUIRE, "agent");
            asm volatile("s_waitcnt vmcnt(0)" ::: "memory");
        }
    }
    __syncthreads();
}

namespace pg8 {
__device__ __forceinline__ float rstd16(const float* ss) { const f32x4 a = *(const f32x4*)ss, b = *(const f32x4*)(ss + 4), c = *(const f32x4*)(ss + 8), d = *(const f32x4*)(ss + 12);
    return 1.f / sqrtf((((a.x + a.y) + (a.z + a.w)) + ((b.x + b.y) + (b.z + b.w)) + ((c.x + c.y) + (c.z + c.w)) + ((d.x + d.y) + (d.z + d.w))) * (1.f / 1024.f) + EPS); }
__device__ __forceinline__ float rstd8(const float* ss) { const f32x4 a = *(const f32x4*)ss, b = *(const f32x4*)(ss + 4);
    return 1.f / sqrtf((((a.x + a.y) + (a.z + a.w)) + ((b.x + b.y) + (b.z + b.w))) * (1.f / 512.f) + EPS); }
template <bool SCALE> struct EpiSwiglu {
    static constexpr bool PERM = true, AFTER_DRAIN = false, MIDK = false;
    bf16_t* H; int ldh; const float* SS;
    __device__ __forceinline__ void operator()(const f32x4 (&acc)[2][2][4][2], const Unit& u, int wr, int wc, int fr, int fq) const {
        const int row0 = u.pm * BM + wr * 64 + fr, col0 = u.pn * HALF + wc * 32 + 8 * fq;
#pragma unroll
        for (int ai = 0; ai < 2; ++ai)
#pragma unroll
            for (int m = 0; m < 4; ++m) {
                if (SCALE) asm volatile("" ::: "memory");
                const int row = row0 + ai * HALF + m * 16;
                const float rs = SCALE ? rstd16(SS + (size_t)row * 16) : 1.f;
                bf16_t* rowp = H + (size_t)row * ldh + col0;
                float hv[8];
#pragma unroll
                for (int n = 0; n < 2; ++n)
#pragma unroll
                    for (int i = 0; i < 4; ++i) { const float g = acc[ai][0][m][n][i] * rs, up = acc[ai][1][m][n][i] * rs; hv[n * 4 + i] = g * __builtin_amdgcn_rcpf(1.f + __expf(-g)) * up; }
                u32x4 w; w.x = cvt_pk_bf16(hv[0], hv[1]); w.y = cvt_pk_bf16(hv[2], hv[3]); w.z = cvt_pk_bf16(hv[4], hv[5]); w.w = cvt_pk_bf16(hv[6], hv[7]);
                *(u32x4*)rowp = w;
            }
    }
};
struct EpiResid {
    static constexpr bool PERM = false, AFTER_DRAIN = false, MIDK = false;
    const float* base; float* out; float alpha;
    __device__ __forceinline__ void operator()(const f32x4 (&acc)[2][2][4][2], const Unit& u, int wr, int wc, int fr, int fq) const {
        const int col0 = u.pn * BM + wc * 32 + 4 * fq;
#pragma unroll
        for (int ai = 0; ai < 2; ++ai)
#pragma unroll
            for (int m = 0; m < 4; ++m) {
                const size_t off = (size_t)(u.pm * BM + ai * HALF + wr * 64 + m * 16 + fr) * 1024 + col0;
#pragma unroll
                for (int bj = 0; bj < 2; ++bj)
#pragma unroll
                    for (int n = 0; n < 2; ++n) { const f32x4 b = *(const f32x4*)(base + off + bj * HALF + n * 16); *(f32x4*)(out + off + bj * HALF + n * 16) = b + acc[ai][bj][m][n] * alpha; }
            }
    }
};
template <bool WOUT> struct EpiResidNorm {
    static constexpr bool PERM = false, AFTER_DRAIN = false, MIDK = WOUT;
    const float* base; float* out; float alpha; const float* gain; bf16_t* XG; float* SS; const PG8_LAS float* TAB;
    __device__ __forceinline__ void midk(f32x4 (&acc)[2][2][4][2], const Unit& u, int wr, int fr) const {
#pragma unroll
        for (int ai = 0; ai < 2; ++ai)
#pragma unroll
            for (int m = 0; m < 4; ++m) { const float ratio = TAB[(ai * HALF + wr * 64 + m * 16 + fr) * 2];
#pragma unroll
                for (int bj = 0; bj < 2; ++bj)
#pragma unroll
                    for (int n = 0; n < 2; ++n) acc[ai][bj][m][n] *= ratio; }
    }
    __device__ __forceinline__ void operator()(const f32x4 (&acc)[2][2][4][2], const Unit& u, int wr, int wc, int fr, int fq) const {
        const int col0 = u.pn * BM + wc * 32 + 4 * fq;
#pragma unroll
        for (int ai = 0; ai < 2; ++ai)
#pragma unroll
            for (int m = 0; m < 4; ++m) {
                asm volatile("" ::: "memory");
                const int row = u.pm * BM + ai * HALF + wr * 64 + m * 16 + fr;
                const size_t off = (size_t)row * 1024 + col0;
                const float sc = WOUT ? alpha * TAB[(ai * HALF + wr * 64 + m * 16 + fr) * 2 + 1] : alpha;
                float ssq = 0.f;
#pragma unroll
                for (int bj = 0; bj < 2; ++bj)
#pragma unroll
                    for (int n = 0; n < 2; ++n) { const f32x4 b = *(const f32x4*)(base + off + bj * HALF + n * 16); const f32x4 v = b + acc[ai][bj][m][n] * sc;
                        *(f32x4*)(out + off + bj * HALF + n * 16) = v; ssq += (v.x * v.x + v.y * v.y) + (v.z * v.z + v.w * v.w);
                        const f32x4 xg = v * *(const f32x4*)(gain + col0 + bj * HALF + n * 16); typedef unsigned u32x2v __attribute__((ext_vector_type(2))); u32x2v w; w.x = cvt_pk_bf16(xg.x, xg.y); w.y = cvt_pk_bf16(xg.z, xg.w);
                        *(u32x2v*)(XG + off + bj * HALF + n * 16) = w; }
                ssq += __shfl_xor(ssq, 16); ssq += __shfl_xor(ssq, 32);
                if (fq == 0) SS[(size_t)row * 16 + u.pn * 4 + wc] = ssq;
            }
    }
};
struct EpiGlu {
    static constexpr bool PERM = true, AFTER_DRAIN = false, MIDK = false;
    const bf16_t* Y; bf16_t* MIXB; const float* bias; const float* gs; float* SSS;
    __device__ __forceinline__ void operator()(const f32x4 (&acc)[2][2][4][2], const Unit& u, int wr, int wc, int fr, int fq) const {
        const int row0 = u.pm * BM + wr * 64 + fr, col0 = u.pn * BM + wc * 32 + 8 * fq;
        f32x4 bv[2][2], gv[2][2];
#pragma unroll
        for (int bj = 0; bj < 2; ++bj)
#pragma unroll
            for (int n = 0; n < 2; ++n) { bv[bj][n] = *(const f32x4*)(bias + col0 + bj * HALF + 4 * n); gv[bj][n] = *(const f32x4*)(gs + col0 + bj * HALF + 4 * n); }
#pragma unroll
        for (int ai = 0; ai < 2; ++ai)
#pragma unroll
            for (int m = 0; m < 4; ++m) {
                const int row = row0 + ai * HALF + m * 16; float ssq = 0.f;
#pragma unroll
                for (int bj = 0; bj < 2; ++bj) {
                    const u32x4 yv = *(const u32x4*)(Y + (size_t)row * 512 + col0 + bj * HALF);
                    const f32x4 v0 = acc[ai][bj][m][0] + bv[bj][0], v1 = acc[ai][bj][m][1] + bv[bj][1];
                    float o[8];
                    o[0] = bflo(yv.x) * sigmoidf_(v0[0]); o[1] = bfhi(yv.x) * sigmoidf_(v0[1]); o[2] = bflo(yv.y) * sigmoidf_(v0[2]); o[3] = bfhi(yv.y) * sigmoidf_(v0[3]);
                    o[4] = bflo(yv.z) * sigmoidf_(v1[0]); o[5] = bfhi(yv.z) * sigmoidf_(v1[1]); o[6] = bflo(yv.w) * sigmoidf_(v1[2]); o[7] = bfhi(yv.w) * sigmoidf_(v1[3]);
#pragma unroll
                    for (int i = 0; i < 8; ++i) ssq += o[i] * o[i];
                    const f32x4 g0 = gv[bj][0], g1 = gv[bj][1];
                    u32x4 w; w.x = cvt_pk_bf16(o[0] * g0.x, o[1] * g0.y); w.y = cvt_pk_bf16(o[2] * g0.z, o[3] * g0.w); w.z = cvt_pk_bf16(o[4] * g1.x, o[5] * g1.y); w.w = cvt_pk_bf16(o[6] * g1.z, o[7] * g1.w);
                    *(u32x4*)(MIXB + (size_t)row * 1024 + 512 + col0 + bj * HALF) = w;
                }
                ssq += __shfl_xor(ssq, 16); ssq += __shfl_xor(ssq, 32);
                if (fq == 0) SSS[(size_t)row * 8 + u.pn * 4 + wc] = ssq;
            }
    }
};
}

template <int MODE>
__device__ __forceinline__ void p0_transpose_item(const float* W, int K, int N, bf16* WT, LAS float* scr, int item, int lane) {
    const int nblk = N / 32, kb = item / nblk, nb = item % nblk, k0 = 64 * kb, n0 = 32 * nb;
    f32x4 v[8];
#pragma unroll
    for (int i = 0; i < 8; ++i) v[i] = *(const f32x4*)(W + (size_t)(k0 + 8 * i + (lane >> 3)) * N + n0 + 4 * (lane & 7));
#pragma unroll
    for (int i = 0; i < 8; ++i) { LAS float* d = scr + (8 * i + (lane >> 3)) * 33 + 4 * (lane & 7); d[0] = v[i].x; d[1] = v[i].y; d[2] = v[i].z; d[3] = v[i].w; }
    LDS_WAIT(); asm volatile("" ::: "memory");
    const int c = lane & 7;
    const int r0 = MODE == 0 ? n0 : ((n0 >> 7) * 256 + (n0 & 127) + (MODE == 2 ? 128 : 0));
#pragma unroll
    for (int j = 0; j < 4; ++j) { const int n = (lane >> 3) + 8 * j; const LAS float* s = scr + (8 * c) * 33 + n;
        v4u o; o.x = pk2(s[0 * 33], s[1 * 33]); o.y = pk2(s[2 * 33], s[3 * 33]); o.z = pk2(s[4 * 33], s[5 * 33]); o.w = pk2(s[6 * 33], s[7 * 33]);
        *(v4u*)(WT + (size_t)(r0 + n) * K + k0 + 8 * c) = o; }
    LDS_WAIT(); asm volatile("" ::: "memory");
}

__device__ __forceinline__ void rms_row_to_bf16(const float* xrow, const float* gain, bf16* orow, int lane) {
    const f32x4* xr = (const f32x4*)xrow + lane; const f32x4* gr = (const f32x4*)gain + lane;
    f32x4 v[4]; float s = 0.f;
#pragma unroll
    for (int j = 0; j < 4; ++j) { v[j] = xr[64 * j]; s += (v[j].x * v[j].x + v[j].y * v[j].y) + (v[j].z * v[j].z + v[j].w * v[j].w); }
    const float rstd = 1.f / sqrtf(wave_sum(s) * (1.f / DM) + EPS);
    unsigned long long* o8 = (unsigned long long*)orow + lane;
#pragma unroll
    for (int j = 0; j < 4; ++j) { const f32x4 g = gr[64 * j];
        o8[64 * j] = (unsigned long long)pk2(v[j].x * rstd * g.x, v[j].y * rstd * g.y) | ((unsigned long long)pk2(v[j].z * rstd * g.z, v[j].w * rstd * g.w) << 32); }
}
__device__ __forceinline__ void rms_row_f32(float* xrow, const float* gain, int lane) {
    f32x4* xr = (f32x4*)xrow + lane; const f32x4* gr = (const f32x4*)gain + lane;
    f32x4 v[4]; float s = 0.f;
#pragma unroll
    for (int j = 0; j < 4; ++j) { v[j] = xr[64 * j]; s += (v[j].x * v[j].x + v[j].y * v[j].y) + (v[j].z * v[j].z + v[j].w * v[j].w); }
    const float rstd = 1.f / sqrtf(wave_sum(s) * (1.f / DM) + EPS);
#pragma unroll
    for (int j = 0; j < 4; ++j) { const f32x4 g = gr[64 * j]; xr[64 * j] = v[j] * rstd * g; }
}
__device__ __forceinline__ void mix_row(const bf16* arow, const bf16* srow, const float* ga, const float* gs, bf16* orow, int lane) {
    const v4u a = *((const v4u*)arow + lane), s = *((const v4u*)srow + lane);
    float av[8] = {bflo(a.x), bfhi(a.x), bflo(a.y), bfhi(a.y), bflo(a.z), bfhi(a.z), bflo(a.w), bfhi(a.w)};
    float sv[8] = {bflo(s.x), bfhi(s.x), bflo(s.y), bfhi(s.y), bflo(s.z), bfhi(s.z), bflo(s.w), bfhi(s.w)};
    float sa = 0.f, ss = 0.f;
#pragma unroll
    for (int i = 0; i < 8; ++i) { sa += av[i] * av[i]; ss += sv[i] * sv[i]; }
    const float ra = 1.f / sqrtf(wave_sum(sa) * (1.f / 512.f) + EPS), rs = 1.f / sqrtf(wave_sum(ss) * (1.f / 512.f) + EPS);
    const f32x4 ga0 = *((const f32x4*)ga + 2 * lane), ga1 = *((const f32x4*)ga + 2 * lane + 1), gs0 = *((const f32x4*)gs + 2 * lane), gs1 = *((const f32x4*)gs + 2 * lane + 1);
    v4u oa, os;
    oa.x = pk2(av[0] * ra * ga0.x, av[1] * ra * ga0.y); oa.y = pk2(av[2] * ra * ga0.z, av[3] * ra * ga0.w); oa.z = pk2(av[4] * ra * ga1.x, av[5] * ra * ga1.y); oa.w = pk2(av[6] * ra * ga1.z, av[7] * ra * ga1.w);
    os.x = pk2(sv[0] * rs * gs0.x, sv[1] * rs * gs0.y); os.y = pk2(sv[2] * rs * gs0.z, sv[3] * rs * gs0.w); os.z = pk2(sv[4] * rs * gs1.x, sv[5] * rs * gs1.y); os.w = pk2(sv[6] * rs * gs1.z, sv[7] * rs * gs1.w);
    *((v4u*)orow + lane) = oa; *((v4u*)(orow + 512) + lane) = os;
}

typedef float f32x16 __attribute__((ext_vector_type(16)));
typedef short bf16x8 __attribute__((ext_vector_type(8)));
typedef __bf16 bf16x2_t __attribute__((ext_vector_type(2)));
typedef float f32x2_t __attribute__((ext_vector_type(2)));
__device__ __forceinline__ unsigned cvtpk(float lo, float hi) { f32x2_t v = {lo, hi}; bf16x2_t b = __builtin_convertvector(v, bf16x2_t); return __builtin_bit_cast(unsigned, b); }
__device__ __forceinline__ void attn_mfma(LAS unsigned char* lds, const bf16* QKV  , bf16* MIXB  , float* SSA, const float* ga, const float* sinks, int ubeg, int uend, int ustep) {
    constexpr int KSTR = 144, VSTR = 784, VT_OFF = 384 * KSTR;
    constexpr float LOG2E = 1.4426950408889634f, K1 = 0.125f * LOG2E;
    const int tid = threadIdx.x, lane = tid & 63, w = tid >> 6, r = lane & 31, hi = lane >> 5;
    for (int unit = ubeg; unit < uend; unit += ustep) {
        const int kh = unit & 1, qb = (unit >> 1) & 15, b = unit >> 5, kp0 = qb * 128 - 128;
        __syncthreads();
        for (int c = tid; c < 3072; c += 512) { const int rr = c >> 3, ch = c & 7, kp = kp0 + rr; v4u kv = (v4u){0u, 0u, 0u, 0u}, vv = kv;
            if (kp >= 0 && kp < SEQ) { const bf16* src = QKV + (size_t)(b * SEQ + kp) * 768; kv = *(const v4u*)(src + 512 + kh * 64 + ch * 8); vv = *(const v4u*)(src + 640 + kh * 64 + ch * 8); }
            *(LAS v4u*)(lds + rr * KSTR + ch * 16) = kv;
            const int pos = (rr & ~15) | (((rr >> 2) & 1) << 3) | (((rr >> 3) & 1) << 2) | (rr & 3);
            LAS unsigned short* vt = (LAS unsigned short*)(lds + VT_OFF + (ch * 8) * VSTR + pos * 2);
            vt[0 * (VSTR / 2)] = (unsigned short)(vv.x & 0xffffu); vt[1 * (VSTR / 2)] = (unsigned short)(vv.x >> 16); vt[2 * (VSTR / 2)] = (unsigned short)(vv.y & 0xffffu); vt[3 * (VSTR / 2)] = (unsigned short)(vv.y >> 16);
            vt[4 * (VSTR / 2)] = (unsigned short)(vv.z & 0xffffu); vt[5 * (VSTR / 2)] = (unsigned short)(vv.z >> 16); vt[6 * (VSTR / 2)] = (unsigned short)(vv.w & 0xffffu); vt[7 * (VSTR / 2)] = (unsigned short)(vv.w >> 16); }
        __syncthreads();
        const int h = kh * 4 + (w >> 1);
        const float slope2 = exp2f(-(float)(h + 1)) * LOG2E, sink2 = sinks[h] * LOG2E;
        const bool qedge = (qb == 0) || (qb == 15);
        for (int qi2 = 0; qi2 < 2; ++qi2) {
            const int q0 = ((w & 1) * 2 + qi2) * 32, t = qb * 128 + q0 + r;
            bf16x8 qf[4];
            { const bf16* qp = QKV + (size_t)(b * SEQ + t) * 768 + h * 64 + hi * 8;
#pragma unroll
              for (int ks = 0; ks < 4; ++ks) qf[ks] = *(const bf16x8*)(qp + ks * 16); }
            float m2 = sink2, l = 0.f;
            f32x16 o0, o1;
#pragma unroll
            for (int i = 0; i < 16; ++i) { o0[i] = 0.f; o1[i] = 0.f; }
            for (int kb = 0; kb < 9; ++kb) {
                const int jj0 = q0 + kb * 32;
                f32x16 s;
#pragma unroll
                for (int i = 0; i < 16; ++i) s[i] = 0.f;
#pragma unroll
                for (int ks = 0; ks < 4; ++ks) { const bf16x8 kf = *(const LAS bf16x8*)(lds + (jj0 + r) * KSTR + ks * 32 + hi * 16); s = __builtin_amdgcn_mfma_f32_32x32x16_bf16(kf, qf[ks], s, 0, 0, 0); }
                const float relbf = (float)(kb * 32 - 128 - r + 4 * hi);
#pragma unroll
                for (int i = 0; i < 16; ++i) { const float ci = (float)((i & 3) + 8 * (i >> 2)); s[i] = s[i] * K1 - slope2 * fabsf(relbf + ci); }
                if (kb == 0 || kb == 8 || qedge) {
                    const float kpf = (float)(kp0 + jj0 + 4 * hi);
#pragma unroll
                    for (int i = 0; i < 16; ++i) { const float ci = (float)((i & 3) + 8 * (i >> 2)); const bool valid = (fabsf(relbf + ci) <= 128.f) && (kpf + ci >= 0.f) && (kpf + ci < (float)SEQ); s[i] = valid ? s[i] : -1e30f; }
                }
                float bm = s[0];
#pragma unroll
                for (int i = 1; i < 16; ++i) bm = fmaxf(bm, s[i]);
                bm = fmaxf(bm, __shfl_xor(bm, 32));
                const float mn = fmaxf(m2, bm), corr = __builtin_amdgcn_exp2f(m2 - mn);
                m2 = mn;
                float ps = 0.f;
#pragma unroll
                for (int i = 0; i < 16; ++i) { s[i] = __builtin_amdgcn_exp2f(s[i] - mn); ps += s[i]; }
                l = l * corr + ps;
#pragma unroll
                for (int i = 0; i < 16; ++i) { o0[i] *= corr; o1[i] *= corr; }
#pragma unroll
                for (int st = 0; st < 2; ++st) {
                    v4u pw; pw.x = cvtpk(s[8 * st + 0], s[8 * st + 1]); pw.y = cvtpk(s[8 * st + 2], s[8 * st + 3]); pw.z = cvtpk(s[8 * st + 4], s[8 * st + 5]); pw.w = cvtpk(s[8 * st + 6], s[8 * st + 7]);
                    const bf16x8 pf = __builtin_bit_cast(bf16x8, pw);
                    const bf16x8 v0 = *(const LAS bf16x8*)(lds + VT_OFF + r * VSTR + (jj0 + 16 * st + 8 * hi) * 2);
                    const bf16x8 v1 = *(const LAS bf16x8*)(lds + VT_OFF + (32 + r) * VSTR + (jj0 + 16 * st + 8 * hi) * 2);
                    o0 = __builtin_amdgcn_mfma_f32_32x32x16_bf16(v0, pf, o0, 0, 0, 0);
                    o1 = __builtin_amdgcn_mfma_f32_32x32x16_bf16(v1, pf, o1, 0, 0, 0);
                }
            }
            const float ltot = l + __shfl_xor(l, 32) + __builtin_amdgcn_exp2f(sink2 - m2), inv = 1.f / ltot;
            bf16* op = MIXB + (size_t)(b * SEQ + t) * 1024 + h * 64 + 4 * hi;
            const float* gp = ga + h * 64 + 4 * hi;
            float ssq = 0.f;
#pragma unroll
            for (int gq = 0; gq < 4; ++gq) {
                const f32x4 g0 = *(const f32x4*)(gp + 8 * gq), g1 = *(const f32x4*)(gp + 32 + 8 * gq);
                const float a0 = o0[4 * gq] * inv, a1 = o0[4 * gq + 1] * inv, a2 = o0[4 * gq + 2] * inv, a3 = o0[4 * gq + 3] * inv;
                const float c0 = o1[4 * gq] * inv, c1 = o1[4 * gq + 1] * inv, c2 = o1[4 * gq + 2] * inv, c3 = o1[4 * gq + 3] * inv;
                ssq += (a0 * a0 + a1 * a1) + (a2 * a2 + a3 * a3) + (c0 * c0 + c1 * c1) + (c2 * c2 + c3 * c3);
                v2u a; a.x = cvtpk(a0 * g0.x, a1 * g0.y); a.y = cvtpk(a2 * g0.z, a3 * g0.w); *(v2u*)(op + 8 * gq) = a;
                v2u c; c.x = cvtpk(c0 * g1.x, c1 * g1.y); c.y = cvtpk(c2 * g1.z, c3 * g1.w); *(v2u*)(op + 32 + 8 * gq) = c; }
            ssq += __shfl_xor(ssq, 32);
            if (hi == 0) SSA[(size_t)(b * SEQ + t) * 8 + h] = ssq;
        }
    }
}

struct SsmP { const float *lam_re, *lam_im, *log_dt, *b_re, *b_im, *c_re, *c_im, *dskip; };
__device__ __forceinline__ float gelu_tanh(float x) { const float z = 1.5957691216f * (x + 0.044715f * x * x * x); return x * __builtin_amdgcn_rcpf(1.f + __expf(-z)); }
__device__ __forceinline__ void lam_of(const SsmP& P, int dg, int p, float& lrdt, float& lidt, float& cr, float& ci) {
    const float lr = fminf(P.lam_re[dg * PS + p], -1e-4f), li = P.lam_im[dg * PS + p], dt = expf(P.log_dt[dg]);
    lrdt = lr * dt; lidt = li * dt;
    const float mag = expf(lrdt), ar = mag * cosf(lidt), ai = mag * sinf(lidt), den = lr * lr + li * li;
    cr = ((ar - 1.f) * lr + ai * li) / den; ci = (ai * lr - (ar - 1.f) * li) / den;
}
__device__ __forceinline__ void apow(float lrdt, float lidt, float k, float& pr, float& pi) { const float m = expf(lrdt * k), a = lidt * k; pr = m * cosf(a); pi = m * sinf(a); }

__device__ __forceinline__ void gen_states_item(const SsmP& P, bf16* MATS, int it, int lane) {
    const int p = it & 63, dir = (it >> 6) & 1, g = it >> 7, dg = dir * NG + g, s = lane >> 1, hh = lane & 1;
    float lrdt, lidt, cr, ci, pr, pi; lam_of(P, dg, p, lrdt, lidt, cr, ci); apow(lrdt, lidt, (float)(dir ? s : TC - 1 - s), pr, pi);
    const float wr = pr * cr - pi * ci, wi = pr * ci + pi * cr;
    const float* brp = P.b_re + (size_t)(dg * PS + p) * HC + hh * 8; const float* bip = P.b_im + (size_t)(dg * PS + p) * HC + hh * 8;
    const f32x4 br0 = *(const f32x4*)brp, br1 = *(const f32x4*)(brp + 4), bi0 = *(const f32x4*)bip, bi1 = *(const f32x4*)(bip + 4);
    const f32x4 re0 = br0 * wr - bi0 * wi, re1 = br1 * wr - bi1 * wi, im0 = bi0 * wr + br0 * wi, im1 = bi1 * wr + br1 * wi;
    v4u o; bf16* dst = MATS + (size_t)(g * 256 + dir * 128 + p) * KS + s * 16 + hh * 8;
    o.x = pk2(re0.x, re0.y); o.y = pk2(re0.z, re0.w); o.z = pk2(re1.x, re1.y); o.w = pk2(re1.z, re1.w); *(v4u*)dst = o;
    o.x = pk2(im0.x, im0.y); o.y = pk2(im0.z, im0.w); o.z = pk2(im1.x, im1.y); o.w = pk2(im1.z, im1.w); *(v4u*)(dst + (size_t)64 * KS) = o;
}
__device__ __forceinline__ void gen_carry_item(const SsmP& P, bf16* MATY, int it, int lane) {
    const int tau = it & 31, dir = (it >> 5) & 1, g = it >> 6, dg = dir * NG + g;
    float lrdt, lidt, cr, ci, pr, pi; lam_of(P, dg, lane, lrdt, lidt, cr, ci); apow(lrdt, lidt, (float)(dir ? TC - tau : tau + 1), pr, pi);
#pragma unroll
    for (int h = 0; h < HC; ++h) { const float c_r = P.c_re[(size_t)(dg * HC + h) * PS + lane], c_i = P.c_im[(size_t)(dg * HC + h) * PS + lane];
        bf16* dst = MATY + (size_t)(g * 512 + tau * 16 + h) * KY + 512 + dir * 128 + lane;
        dst[0] = (bf16)f2bf(c_r * pr - c_i * pi); dst[64] = (bf16)f2bf(-(c_r * pi + c_i * pr)); }
}
__device__ __forceinline__ void gen_toep_item(const SsmP& P, bf16* MATY, LAS float* scr, int it, int lane) {
    const int g = it / 63, dl = it % 63 - 31, k = dl < 0 ? -dl : dl;
    LAS float* Wr = scr; LAS float* Wi = scr + 64; LAS float* Cr = scr + 128; LAS float* Ci = Cr + 16 * 65; LAS float* Br = Ci + 16 * 65; LAS float* Bi = Br + 1024;
    const int h = lane >> 2, q = lane & 3;
    float val[4] = {0.f, 0.f, 0.f, 0.f};
    for (int dir = 0; dir < 2; ++dir) {
        if ((dl > 0 && dir == 1) || (dl < 0 && dir == 0)) continue;
        const int dg = dir * NG + g;
        float lrdt, lidt, cr, ci, pr, pi; lam_of(P, dg, lane, lrdt, lidt, cr, ci); apow(lrdt, lidt, (float)k, pr, pi);
        Wr[lane] = pr * cr - pi * ci; Wi[lane] = pr * ci + pi * cr;
#pragma unroll
        for (int i = 0; i < 16; ++i) { Cr[i * 65 + lane] = P.c_re[(size_t)(dg * HC + i) * PS + lane]; Ci[i * 65 + lane] = P.c_im[(size_t)(dg * HC + i) * PS + lane];
            Br[i * 64 + lane] = P.b_re[(size_t)dg * 1024 + i * 64 + lane]; Bi[i * 64 + lane] = P.b_im[(size_t)dg * 1024 + i * 64 + lane]; }
        LDS_WAIT(); asm volatile("" ::: "memory");
        for (int p = 0; p < 64; ++p) { const float wr = Wr[p], wi = Wi[p], c_r = Cr[h * 65 + p], c_i = Ci[h * 65 + p], tr = c_r * wr - c_i * wi, ti = c_r * wi + c_i * wr;
            const f32x4 b_r = *(const LAS f32x4*)(Br + p * 16 + 4 * q), b_i = *(const LAS f32x4*)(Bi + p * 16 + 4 * q);
            val[0] += tr * b_r.x - ti * b_i.x; val[1] += tr * b_r.y - ti * b_i.y; val[2] += tr * b_r.z - ti * b_i.z; val[3] += tr * b_r.w - ti * b_i.w; }
        LDS_WAIT(); asm volatile("" ::: "memory");
    }
    if (dl == 0) { const float dsk = P.dskip[g * HC + h];
#pragma unroll
        for (int j = 0; j < 4; ++j) if (4 * q + j == h) val[j] += dsk; }
    v2u o; o.x = pk2(val[0], val[1]); o.y = pk2(val[2], val[3]);
    const int t_lo = dl > 0 ? dl : 0, t_hi = dl < 0 ? TC - 1 + dl : TC - 1;
    for (int tau = t_lo; tau <= t_hi; ++tau) { const int s = tau - dl; *(v2u*)(MATY + (size_t)(g * 512 + tau * 16 + h) * KY + s * 16 + 4 * q) = o; }
}

namespace pg8 {
struct GroupOrder {
    int rm, rn, nwg, G, c;
    __device__ void init(int ng, int rm_, int rn_, int G_, int c_) { rm = rm_; rn = rn_; nwg = ng * rm * rn; G = G_; c = c_; }
    __device__ bool next(int i, Unit& u) const { const long L = (long)i * G + c; if (L >= nwg) return false; const int per = rm * rn, gi = (int)L / per, r = (int)L % per; u.pm = gi * rm + r % rm; u.pn = gi * rn + r / rm; return true; }
    __device__ __forceinline__ void a_ready(const Unit&) const {}
    __device__ __forceinline__ void done(const Unit&) const {}
};
struct EpiWin {
    static constexpr bool PERM = true, AFTER_DRAIN = false, MIDK = false;
    bf16_t* QKV; bf16_t* UA; const float* SS;
    __device__ __forceinline__ void operator()(const f32x4 (&acc)[2][2][4][2], const Unit& u, int wr, int wc, int fr, int fq) const {
        const int row0 = u.pm * BM + wr * 64 + fr;
#pragma unroll
        for (int ai = 0; ai < 2; ++ai)
#pragma unroll
            for (int m = 0; m < 4; ++m) { const int r = row0 + ai * HALF + m * 16; const float rs = rstd16(SS + (size_t)r * 16);
#pragma unroll
                for (int bj = 0; bj < 2; ++bj) { const f32x4 v0 = acc[ai][bj][m][0] * rs, v1 = acc[ai][bj][m][1] * rs;
                    u32x4 w; w.x = cvt_pk_bf16(v0[0], v0[1]); w.y = cvt_pk_bf16(v0[2], v0[3]); w.z = cvt_pk_bf16(v1[0], v1[1]); w.w = cvt_pk_bf16(v1[2], v1[3]);
                    if (u.pn < 3) { *(u32x4*)(QKV + (size_t)r * 768 + u.pn * BM + bj * HALF + wc * 32 + 8 * fq) = w; }
                    else { const int ucol = (u.pn - 3) * BM + bj * HALF + wc * 32 + 8 * fq, gi = ucol >> 4, h0 = ucol & 15, b = r >> 11, t = r & 2047, c = t >> 5, tau = t & 31;
                        *(u32x4*)(UA + (size_t)(gi * 512 + b * 64 + c) * KY + tau * 16 + h0) = w; } } }
    }
};
struct EpiStates {
    static constexpr bool PERM = false, AFTER_DRAIN = true, MIDK = false;
    float* SST; bf16_t* UA; const float *lam_re, *lam_im, *log_dt;
    __device__ __forceinline__ void fused(f32x4 (&acc)[2][2][4][2], const Unit& u, int wr, int wc, int fr, int fq, PG8_LAS unsigned char* lds, int wid, int lane) const {
#pragma unroll
        for (int ai = 0; ai < 2; ++ai)
#pragma unroll
            for (int m = 0; m < 4; ++m) { float* rowp = SST + (size_t)(u.pm * BM + ai * HALF + wr * 64 + m * 16 + fr) * 256 + wc * 32 + 4 * fq;
#pragma unroll
                for (int bj = 0; bj < 2; ++bj)
#pragma unroll
                    for (int n = 0; n < 2; ++n) *(f32x4*)(rowp + bj * HALF + n * 16) = acc[ai][bj][m][n]; }
        asm volatile("s_waitcnt vmcnt(0)" ::: "memory"); __syncthreads();
        __builtin_amdgcn_fence(__ATOMIC_ACQUIRE, "agent");
        const int gi = u.pm >> 1, bl = wid >> 1, dir = wid & 1, dg = dir * NG + gi;
        const float lr = fminf(lam_re[dg * PS + lane], -1e-4f), li = lam_im[dg * PS + lane], dt = expf(log_dt[dg]);
        const float mg = expf(lr * dt * (float)TC), ang = li * dt * (float)TC, a_r = mg * cosf(ang), a_i = mg * sinf(ang);
        const size_t rowbase = (size_t)u.pm * BM + bl * 64;
        const float* sre = SST + rowbase * 256 + dir * 128 + lane;
        bf16_t* cre = UA + rowbase * KY + 512 + dir * 128 + lane;
        float xr = 0.f, xi = 0.f;
        for (int bt = 0; bt < NC / 16; ++bt) {
            float sr[16], si[16];
#pragma unroll
            for (int j = 0; j < 16; ++j) { const int i = bt * 16 + j, c = dir ? NC - 1 - i : i; sr[j] = sre[(size_t)c * 256]; si[j] = sre[(size_t)c * 256 + 64]; }
#pragma unroll
            for (int j = 0; j < 16; ++j) { const int i = bt * 16 + j, c = dir ? NC - 1 - i : i;
                cre[(size_t)c * KY] = (bf16_t)f2bf(xr); cre[(size_t)c * KY + 64] = (bf16_t)f2bf(xi);
                const float nr = a_r * xr - a_i * xi + sr[j]; xi = a_r * xi + a_i * xr + si[j]; xr = nr; }
        }
    }
};
struct EpiSsmOut {
    static constexpr bool PERM = true, AFTER_DRAIN = false, MIDK = false;
    bf16_t* YG;
    __device__ __forceinline__ void operator()(const f32x4 (&acc)[2][2][4][2], const Unit& u, int wr, int wc, int fr, int fq) const {
        const int gi = u.pm >> 1;
#pragma unroll
        for (int ai = 0; ai < 2; ++ai)
#pragma unroll
            for (int m = 0; m < 4; ++m) { const int bc = ((u.pm & 1) * BM + ai * HALF + wr * 64 + m * 16 + fr), b = bc >> 6, c = bc & 63;
#pragma unroll
                for (int bj = 0; bj < 2; ++bj) { const int col = (u.pn & 1) * BM + bj * HALF + wc * 32 + 8 * fq, tau = col >> 4, h0 = col & 15;
                    const f32x4 v0 = acc[ai][bj][m][0], v1 = acc[ai][bj][m][1];
                    u32x4 w; w.x = cvt_pk_bf16(gelu_tanh(v0[0]), gelu_tanh(v0[1])); w.y = cvt_pk_bf16(gelu_tanh(v0[2]), gelu_tanh(v0[3]));
                    w.z = cvt_pk_bf16(gelu_tanh(v1[0]), gelu_tanh(v1[1])); w.w = cvt_pk_bf16(gelu_tanh(v1[2]), gelu_tanh(v1[3]));
                    *(u32x4*)(YG + (size_t)(b * SEQ + c * TC + tau) * SWD + gi * 16 + h0) = w; } }
    }
};
}

struct Args { const float* in[26]; float* out; unsigned char* ws; int ph_lo, ph_hi; };
constexpr int N_PHASES = 11;
constexpr int F2_ITEMS = (DM / 64) * (FF / 32), F2_SPLIT = 1536;
__device__ __forceinline__ void ffn2_item(const Args& args, bf16* WT2, bf16* WD2, LAS float* scr, int it, int lane) {
    if (it < F2_ITEMS) p0_transpose_item<1>(args.in[22], DM, FF, WT2, scr, it, lane);
    else if (it < 2 * F2_ITEMS) p0_transpose_item<2>(args.in[23], DM, FF, WT2, scr, it - F2_ITEMS, lane);
    else p0_transpose_item<0>(args.in[24], FF, DM, WD2, scr, it - 2 * F2_ITEMS, lane);
}
__global__ void __launch_bounds__(512, 2) mk_fwd(Args args) {
    extern __shared__ __attribute__((aligned(16))) unsigned char lds_raw[];
    LAS unsigned char* lds = (LAS unsigned char*)lds_raw;
    cg::grid_group grid = cg::this_grid();
    const int tid = threadIdx.x, lane = tid & 63, wave = __builtin_amdgcn_readfirstlane(tid >> 6);
    const int G = gridDim.x, bid = blockIdx.x;
    const int gw = bid * 8 + wave, NGW = G * 8;
    unsigned char* ws = args.ws;
    const float* x = args.in[0];
    float* X = args.out;
    bf16* WT1 = (bf16*)(ws + WS_WT1); bf16* WD1 = (bf16*)(ws + WS_WD1); bf16* WT2 = (bf16*)(ws + WS_WT2); bf16* WD2 = (bf16*)(ws + WS_WD2);
    bf16* WIN = (bf16*)(ws + WS_WIN); bf16* WOUT = (bf16*)(ws + WS_WOUT); bf16* WGLU = (bf16*)(ws + WS_WGLU);
    bf16* XA = (bf16*)(ws + WS_XA); bf16* HB = (bf16*)(ws + WS_H); bf16* QKV = (bf16*)(ws + WS_QKV); bf16* YG = (bf16*)(ws + WS_YG);
    float* SS1 = (float*)(ws + WS_SS1); float* SS2 = (float*)(ws + WS_SS2); float* SSA = (float*)(ws + WS_SSA); float* SSS = (float*)(ws + WS_SSS); bf16* MIX = (bf16*)(ws + WS_MIX); bf16* MATS = (bf16*)(ws + WS_MATS); bf16* MATY = (bf16*)(ws + WS_MATY); bf16* UA = (bf16*)(ws + WS_UA); float* SST = (float*)(ws + WS_SST);
    const SsmP SP{args.in[8], args.in[9], args.in[10], args.in[11], args.in[12], args.in[13], args.in[14], args.in[15]};
    const int lo = args.ph_lo, hi = args.ph_hi;
    volatile LAS unsigned* MISC = (volatile LAS unsigned*)(lds + MISC_OFF);
    if (tid < 32) MISC[tid] = 0u;
    __syncthreads();
    XcdBarrier bar = xcd_barrier_post((unsigned*)ws, MISC + 8);
    if (lo < 0) grid.sync();
#define IN(k) (lo <= (k) && (k) < hi)
#define SEAM(k) do { if (IN(k) && IN((k) + 1)) xcd_barrier(bar); } while (0)

    if (IN(0)) {
        LAS float* scr = (LAS float*)(lds + wave * 17024);
        constexpr int I_UP = (DM / 64) * (FF / 32), I_DN = (FF / 64) * (DM / 32), I_IN = (DM / 64) * (INW / 32), I_GLU = (SWD / 64) * (SWD / 32), I_OUT = (DM / 64) * (DM / 32);
        constexpr int NITEMS = 3 * I_UP + I_IN + I_GLU + I_OUT;
        for (int it = gw; it < NITEMS; it += NGW) {
            int r = it;
            if (r < I_UP) { p0_transpose_item<1>(args.in[2], DM, FF, WT1, scr, r, lane); continue; } r -= I_UP;
            if (r < I_UP) { p0_transpose_item<2>(args.in[3], DM, FF, WT1, scr, r, lane); continue; } r -= I_UP;
            if (r < I_DN) { p0_transpose_item<0>(args.in[4], FF, DM, WD1, scr, r, lane); continue; } r -= I_DN;
            if (r < I_IN) { p0_transpose_item<0>(args.in[6], DM, INW, WIN, scr, r, lane); continue; } r -= I_IN;
            if (r < I_GLU) { p0_transpose_item<0>(args.in[16], SWD, SWD, WGLU, scr, r, lane); continue; } r -= I_GLU;
            p0_transpose_item<0>(args.in[20], DM, DM, WOUT, scr, r, lane);
        }
        for (int it = gw; it < 32 * 63; it += NGW) gen_toep_item(SP, MATY, scr, it, lane);
        for (int it = gw; it < 32 * 2 * 64; it += NGW) gen_states_item(SP, MATS, it, lane);
        for (int it = gw; it < 32 * 2 * 32; it += NGW) gen_carry_item(SP, MATY, it, lane);
        for (int m = gw; m < M; m += NGW) rms_row_to_bf16(x + (size_t)m * DM, args.in[1], XA + (size_t)m * DM, lane);
    }
    SEAM(0);
    if (IN(1)) { pg8::Gemm g{XA, WT1, M, 2 * FF, DM, DM, DM}; pg8::StaticOrder S; S.init(M, 2 * FF, G, bid); pg8::EpiSwiglu<false> E{HB, FF, nullptr};
        pg8::gemm_phase<pg8::EpiSwiglu<false>, pg8::StaticOrder, true, true>(lds, g, S, E); }
    SEAM(1);
    if (IN(2)) { pg8::Gemm g{HB, WD1, M, DM, FF, FF, FF}; pg8::StaticOrder S; S.init(M, DM, G, bid); pg8::EpiResidNorm<false> E{x, X, 0.5f, args.in[5], XA, SS1, nullptr};
        pg8::gemm_phase<pg8::EpiResidNorm<false>, pg8::StaticOrder, true, true>(lds, g, S, E); }
    SEAM(2);
    if (IN(3)) { pg8::Gemm g{XA, WIN, M, INW, DM, DM, DM}; pg8::StaticOrder S; S.init(M, INW, G, bid); pg8::EpiWin E{QKV, UA, SS1};
        pg8::gemm_phase<pg8::EpiWin, pg8::StaticOrder, true, true>(lds, g, S, E); }
    SEAM(3);
    if (IN(4)) {
        { pg8::Gemm g{UA, MATS, 32 * 512, 32 * 256, KS, KY, KS}; pg8::GroupOrder S; S.init(32, 2, 1, G, bid); pg8::EpiStates E{SST, UA, SP.lam_re, SP.lam_im, SP.log_dt};
          if (G >= 64) pg8::gemm_phase<pg8::EpiStates, pg8::GroupOrder, false, true>(lds, g, S, E); }
        if (bid >= 64) attn_mfma(lds, QKV, MIX, SSA, args.in[18], args.in[7], bid - 64, 192, 192);
    }
    SEAM(4);
    if (IN(5)) { pg8::Gemm g{UA, MATY, 32 * 512, 32 * 512, KY, KY, KY}; pg8::GroupOrder S; S.init(32, 2, 2, G, bid); pg8::EpiSsmOut E{YG};
        pg8::gemm_phase<pg8::EpiSsmOut, pg8::GroupOrder, true, true>(lds, g, S, E);
        if (bid >= 128 && bid < 192) attn_mfma(lds, QKV, MIX, SSA, args.in[18], args.in[7], 192 + (bid - 128), 256, 64);
        if (bid >= 192) { LAS float* scr = (LAS float*)(lds + wave * 17024);
            for (int it = (bid - 192) * 8 + wave; it < F2_SPLIT; it += 512) ffn2_item(args, WT2, WD2, scr, it, lane); } }
    SEAM(5);
    if (IN(6)) { pg8::Gemm g{YG, WGLU, M, SWD, SWD, SWD, SWD}; pg8::StaticOrder S; S.init(M, SWD, G, bid); pg8::EpiGlu E{YG, MIX, args.in[17], args.in[19], SSS};
        pg8::gemm_phase<pg8::EpiGlu, pg8::StaticOrder, true, true>(lds, g, S, E);
        if (bid >= 128) { LAS float* scr = (LAS float*)(lds + wave * 17024);
            for (int it = F2_SPLIT + (bid - 128) * 8 + wave; it < 3 * F2_ITEMS; it += 1024) ffn2_item(args, WT2, WD2, scr, it, lane); } }
    SEAM(6);
    if (IN(7)) { pg8::Gemm g{MIX, WOUT, M, DM, DM, DM, DM}; pg8::StaticOrder S; S.init(M, DM, G, bid);
        LAS float* TAB = (LAS float*)(lds + 131072);
        { pg8::Unit u0; if (S.next(0, u0) && tid < 256) { const int row = u0.pm * 256 + tid; const float ra = pg8::rstd8(SSA + (size_t)row * 8), rs = pg8::rstd8(SSS + (size_t)row * 8); TAB[tid * 2] = ra / rs; TAB[tid * 2 + 1] = rs; } }
        __syncthreads();
        pg8::EpiResidNorm<true> E{X, X, 1.0f, args.in[21], XA, SS2, TAB};
        pg8::gemm_phase<pg8::EpiResidNorm<true>, pg8::StaticOrder, true, true>(lds, g, S, E); }
    SEAM(7);
    if (IN(8)) { pg8::Gemm g{XA, WT2, M, 2 * FF, DM, DM, DM}; pg8::StaticOrder S; S.init(M, 2 * FF, G, bid); pg8::EpiSwiglu<true> E{HB, FF, SS2};
        pg8::gemm_phase<pg8::EpiSwiglu<true>, pg8::StaticOrder, true, true>(lds, g, S, E); }
    SEAM(8);
    if (IN(9)) { pg8::Gemm g{HB, WD2, M, DM, FF, FF, FF}; pg8::StaticOrder S; S.init(M, DM, G, bid); pg8::EpiResid E{X, X, 0.5f};
        pg8::gemm_phase<pg8::EpiResid, pg8::StaticOrder, true, true>(lds, g, S, E); }
    SEAM(9);
    if (IN(10)) { for (int m = gw; m < M; m += NGW) rms_row_f32(X + (size_t)m * DM, args.in[25], lane); }
#undef IN
#undef SEAM
}

extern "C" void kernel_launch(void* const* d_in, const int* in_sizes, int n_in, void* d_out, int out_size, void* d_ws, size_t ws_size, hipStream_t stream) {
    static int grid = 0;
    if (grid == 0) {
        if (n_in != 26 || in_sizes[0] != M * DM || out_size != M * DM || ws_size < WS_END) { fprintf(stderr, "kernel_launch: unexpected shapes n_in %d in0 %d out %d ws %zu\n", n_in, n_in > 0 ? in_sizes[0] : -1, out_size, ws_size); grid = -1; return; }
        int dev = 0, cus = 0, per_cu = 0;
        (void)hipGetDevice(&dev); (void)hipDeviceGetAttribute(&cus, hipDeviceAttributeMultiprocessorCount, dev);
        if (hipFuncSetAttribute((const void*)mk_fwd, hipFuncAttributeMaxDynamicSharedMemorySize, LDS_BYTES) != hipSuccess) { fprintf(stderr, "kernel_launch: hipFuncSetAttribute failed\n"); grid = -1; return; }
        if (hipOccupancyMaxActiveBlocksPerMultiprocessor(&per_cu, (const void*)mk_fwd, 512, LDS_BYTES) != hipSuccess || per_cu < 1) { fprintf(stderr, "kernel_launch: occupancy query says %d\n", per_cu); per_cu = 1; }
        (void)hipGetLastError();
        grid = cus * per_cu;
        if (grid != 256) { fprintf(stderr, "kernel_launch: this kernel is built for a 256-workgroup grid (one per CU of a 256-CU device), got %d; nothing launched\n", grid); grid = -1; return; }
        fprintf(stderr, "kernel_launch: grid %d (cus %d per_cu %d)\n", grid, cus, per_cu);
    }
    if (grid < 0) return;
    if (hipMemsetAsync(d_ws, 0, CTL_ZERO_BYTES, stream) != hipSuccess) { fprintf(stderr, "kernel_launch: hipMemsetAsync failed\n"); return; }
    Args a{};
    for (int i = 0; i < 26; ++i) a.in[i] = (const float*)d_in[i];
    a.out = (float*)d_out; a.ws = (unsigned char*)d_ws;
#if MK_MULTI
    for (int ph = 0; ph < N_PHASES; ++ph) { a.ph_lo = ph; a.ph_hi = ph + 1; hipLaunchKernelGGL(mk_fwd, dim3(grid), dim3(512), LDS_BYTES, stream, a); }
#else
    a.ph_lo = 0; a.ph_hi = N_PHASES;
    void* kargs[] = {&a};
    hipError_t e = hipLaunchCooperativeKernel((const void*)mk_fwd, dim3(grid), dim3(512), kargs, LDS_BYTES, stream);
    if (e != hipSuccess) fprintf(stderr, "cooperative launch failed: %s (grid %d)\n", hipGetErrorString(e), grid);
#endif
}
```

```cpp
#include <hip/hip_runtime.h>
#include <hip/hip_cooperative_groups.h>
#include <cstdio>
#include <cstdint>
namespace cg = cooperative_groups;
#define MK_MULTI 0
namespace pg8 {
#define PG8_LAS __attribute__((address_space(3)))
typedef unsigned short bf16_t;
typedef short bf16x8 __attribute__((ext_vector_type(8)));
typedef float f32x4 __attribute__((ext_vector_type(4)));
typedef unsigned u32x4 __attribute__((ext_vector_type(4)));
constexpr int BM = 256, BK = 64, HALF = 128, HTB = HALF * BK * 2  , STAGE_BYTES = 8 * HTB, NXCD = 8, WGM = 8;

__host__ __device__ __forceinline__ int lds_byte(int r, int c) { const int st = (r >> 4) * 2 + (c >> 5), rr = r & 15, cc = c & 31, ob = rr * 64 + cc * 2; return st * 1024 + (ob ^ (((ob >> 9) & 1) << 5)); }
__host__ __device__ __forceinline__ void stage_rc(int b, int& R, int& C) { const int st = b / 1024, sb = b % 1024, swz = sb ^ (((sb >> 9) & 1) << 5); R = (st >> 1) * 16 + swz / 64; C = (st & 1) * 32 + (swz % 64) / 2; }
__host__ __device__ __forceinline__ int perm32(int rho) { const int n = rho >> 4, i = rho & 15; return 8 * (i >> 2) + 4 * n + (i & 3); }

struct Unit { int pm, pn; };
struct Gemm { const bf16_t* A; const bf16_t* Bt; int M, N, K, lda, ldb; };

struct StaticOrder {
    int nM, nN, nwg, G, c;
    __host__ __device__ void init(int M, int N, int G_, int c_) { nM = M / BM; nN = N / BM; nwg = nM * nN; G = G_; c = c_; }
    __host__ __device__ bool next(int i, Unit& u) const {
        const long L = (long)i * G + c; if (L >= nwg) return false;
        int wgid = (int)L; { const int q = nwg / NXCD, r = nwg % NXCD, xcd = wgid % NXCD, off = wgid / NXCD; wgid = (xcd < r ? xcd * (q + 1) : r * (q + 1) + (xcd - r) * q) + off; }
        const int nig = WGM * nN, gid = wgid / nig, fm = gid * WGM, gsz = (nM - fm) < WGM ? (nM - fm) : WGM;
        u.pm = fm + ((wgid % nig) % gsz); u.pn = (wgid % nig) / gsz; return true;
    }
    __device__ __forceinline__ void a_ready(const Unit&) const {}
    __device__ __forceinline__ void done(const Unit&) const {}
};

__device__ __forceinline__ unsigned cvt_pk_bf16(float lo, float hi) { unsigned r; asm volatile("v_cvt_pk_bf16_f32 %0, %1, %2" : "=v"(r) : "v"(lo), "v"(hi)); return r; }
typedef float f32x2 __attribute__((ext_vector_type(2)));
__device__ __forceinline__ f32x2 gelu_pk(f32x2 v) {
    const f32x2 av = __builtin_elementwise_abs(v), d = av * 0.2316418882f + 1.0f;
    f32x2 t; t.x = __builtin_amdgcn_rcpf(d.x); t.y = __builtin_amdgcn_rcpf(d.y);
    f32x2 q = t * 0.5307027145f + (-0.7265760135f); q = q * t + 0.7107068705f; q = q * t + (-0.142248368f); q = q * t + 0.127414796f; q = q * t;
    const f32x2 s = (v * v) * (-0.72134752044f);
    f32x2 e; e.x = __builtin_amdgcn_exp2f(s.x); e.y = __builtin_amdgcn_exp2f(s.y);
    const f32x2 m = v * (q * e), r = v - m;
    f32x2 o; o.x = v.x < 0.f ? m.x : r.x; o.y = v.y < 0.f ? m.y : r.y; return o;
}

template <int ACT  > struct EpiBf16 {
    static constexpr bool PERM = true, AFTER_DRAIN = false; static_assert(ACT == 0 || ACT == 1, "EpiBf16: ACT is 0 (none) or 1 (gelu_pk)");
    bf16_t* O; int ldc; const float* bias; int split_cols; size_t split_stride; float scale0;
    __device__ __forceinline__ void operator()(const f32x4 (&acc)[2][2][4][2], const Unit& u, int wr, int wc, int fr, int fq) const {
        const int row0 = u.pm * BM + wr * 64 + fr; int colt = u.pn * BM; bf16_t* base = O;
        float sc = 1.f; if (split_cols) { const int t = colt / split_cols; base += (size_t)t * split_stride; colt -= t * split_cols; if (t == 0) sc = scale0; }
        const int col0 = colt + wc * 32 + 8 * fq, bcol0 = u.pn * BM + wc * 32 + 8 * fq;
        f32x4 bv[2][2];
#pragma unroll
        for (int bj = 0; bj < 2; ++bj)
#pragma unroll
            for (int n = 0; n < 2; ++n) bv[bj][n] = bias ? *(const f32x4*)(bias + bcol0 + bj * HALF + 4 * n) : (f32x4){0.f, 0.f, 0.f, 0.f};
#pragma unroll
        for (int ai = 0; ai < 2; ++ai)
#pragma unroll
            for (int m = 0; m < 4; ++m) { bf16_t* rowp = base + (size_t)(row0 + ai * HALF + m * 16) * ldc + col0;
#pragma unroll
                for (int bj = 0; bj < 2; ++bj) { f32x4 v0 = acc[ai][bj][m][0] + bv[bj][0], v1 = acc[ai][bj][m][1] + bv[bj][1];
                    if (ACT == 1) { f32x2 a = gelu_pk((f32x2){v0[0], v0[1]}), b = gelu_pk((f32x2){v0[2], v0[3]}), c = gelu_pk((f32x2){v1[0], v1[1]}), d = gelu_pk((f32x2){v1[2], v1[3]});
                        v0 = (f32x4){a.x, a.y, b.x, b.y}; v1 = (f32x4){c.x, c.y, d.x, d.y}; }
                    v0 = v0 * sc; v1 = v1 * sc; u32x4 w; w.x = cvt_pk_bf16(v0[0], v0[1]); w.y = cvt_pk_bf16(v0[2], v0[3]); w.z = cvt_pk_bf16(v1[0], v1[1]); w.w = cvt_pk_bf16(v1[2], v1[3]);
                    *(u32x4*)(rowp + bj * HALF) = w; } }
    }
};
template <class Epi, class Sched, bool ALIGN_EPI = false, bool SP2 = false>
__device__ __forceinline__ void gemm_phase(PG8_LAS unsigned char* lds, const Gemm g, const Sched& S, const Epi& E) {
    const int tid = threadIdx.x, wid = __builtin_amdgcn_readfirstlane(tid >> 6), lane = tid & 63, wr = wid >> 2, wc = wid & 3, fr = lane & 15, fq = lane >> 4;
    const int K = g.K, nt = K / BK;
    unsigned voffA[2], voffB[2];
#pragma unroll
    for (int i = 0; i < 2; ++i) { int R, C; stage_rc(tid * 16 + i * 8192, R, C); const int Rb = Epi::PERM ? ((R & ~31) + perm32(R & 31)) : R;
        voffA[i] = (unsigned)(R * g.lda + C) * 2u; voffB[i] = (unsigned)(Rb * g.ldb + C) * 2u; }
    const size_t kstep = (size_t)(BK * 2);
    const size_t hstepA = (size_t)HALF * g.lda * 2, hstepB = (size_t)HALF * g.ldb * 2;
    const size_t tstepA = 2 * hstepA, tstepB = 2 * hstepB;
    const unsigned ldsw = (unsigned)wid * 1024u;
    const int aoff = lds_byte(wr * 64 + fr, fq * 8), boff = lds_byte(wc * 32 + fr, fq * 8);
#define PG8_SA(b, h) (((b) * 2 + (h)) * HTB)
#define PG8_SB(b, h) ((4 + (b) * 2 + (h)) * HTB)
#define PG8_STAGE(bufoff, gbase, voff) do { _Pragma("unroll") for (int _i = 0; _i < 2; ++_i) \
        __builtin_amdgcn_global_load_lds((const unsigned*)((const char*)(gbase) + (voff)[_i]), (PG8_LAS unsigned*)(lds + (bufoff) + ldsw + _i * 8192), 16, 0, 0); } while (0)
#define PG8_LDA(dst, b, h) do { _Pragma("unroll") for (int m = 0; m < 4; ++m) _Pragma("unroll") for (int k = 0; k < 2; ++k) dst[m][k] = *(const PG8_LAS bf16x8*)(lds + PG8_SA(b, h) + aoff + m * 2048 + k * 1024); } while (0)
#define PG8_LDB(dst, b, h) do { _Pragma("unroll") for (int n = 0; n < 2; ++n) _Pragma("unroll") for (int k = 0; k < 2; ++k) dst[n][k] = *(const PG8_LAS bf16x8*)(lds + PG8_SB(b, h) + boff + n * 2048 + k * 1024); } while (0)
#define PG8_MMA(ai, bj, At, Bt) do { __builtin_amdgcn_s_setprio(1); _Pragma("unroll") for (int m = 0; m < 4; ++m) _Pragma("unroll") for (int n = 0; n < 2; ++n) _Pragma("unroll") for (int k = 0; k < 2; ++k) \
        acc[ai][bj][m][n] = __builtin_amdgcn_mfma_f32_16x16x32_bf16(Bt[n][k], At[m][k], acc[ai][bj][m][n], 0, 0, 0); __builtin_amdgcn_s_setprio(0); } while (0)
#define PG8_WAIT_V(n) asm volatile("s_waitcnt vmcnt(" #n ")" ::: "memory")
#define PG8_WAIT_L(n) asm volatile("s_waitcnt lgkmcnt(" #n ")" ::: "memory")
#define PG8_BAR __builtin_amdgcn_s_barrier()
#define PG8_SCHED __builtin_amdgcn_sched_barrier(0)
    Unit cur, nxt; int ui = 0;
    if (!S.next(0, cur)) return;
    f32x4 acc[2][2][4][2];
#pragma unroll
    for (int a = 0; a < 2; ++a)
#pragma unroll
        for (int b = 0; b < 2; ++b)
#pragma unroll
            for (int m = 0; m < 4; ++m)
#pragma unroll
                for (int n = 0; n < 2; ++n) acc[a][b][m][n] = (f32x4){0.f, 0.f, 0.f, 0.f};
    bf16x8 At[4][2], B0[2][2], B1[2][2];
    const char* cA = (const char*)g.A + (size_t)cur.pm * tstepA; const char* cB = (const char*)g.Bt + (size_t)cur.pn * tstepB;
    S.a_ready(cur);
    if constexpr (SP2) {
        PG8_STAGE(PG8_SB(0, 0), cB, voffB); PG8_STAGE(PG8_SB(0, 1), cB + hstepB, voffB); PG8_STAGE(PG8_SA(0, 0), cA, voffA); PG8_STAGE(PG8_SA(0, 1), cA + hstepA, voffA);
        if (wr == 1) PG8_BAR;
        PG8_WAIT_V(2); PG8_BAR;
        PG8_STAGE(PG8_SB(1, 0), cB + kstep, voffB); PG8_STAGE(PG8_SA(1, 0), cA + kstep, voffA); PG8_STAGE(PG8_SB(1, 1), cB + hstepB + kstep, voffB);
        PG8_WAIT_V(6); PG8_BAR;
    } else {
        PG8_STAGE(PG8_SB(0, 0), cB, voffB); PG8_STAGE(PG8_SA(0, 0), cA, voffA); PG8_STAGE(PG8_SB(0, 1), cB + hstepB, voffB); PG8_STAGE(PG8_SA(0, 1), cA + hstepA, voffA);
        if (wr == 1) PG8_BAR;
        PG8_WAIT_V(4); PG8_BAR;
        PG8_STAGE(PG8_SB(1, 0), cB + kstep, voffB); PG8_STAGE(PG8_SA(1, 0), cA + kstep, voffA); PG8_STAGE(PG8_SB(1, 1), cB + hstepB + kstep, voffB);
        PG8_WAIT_V(6); PG8_BAR;
    }
    for (;;) {
        const bool has_next = S.next(ui + 1, nxt);
        const char* nA = has_next ? (const char*)g.A + (size_t)nxt.pm * tstepA : cA; const char* nB = has_next ? (const char*)g.Bt + (size_t)nxt.pn * tstepB : cB;
        for (int t = 0; t < nt; t += 2) {
            if constexpr (Epi::MIDK) { if (t == nt / 2) E.midk(acc, cur, wr, fr); }
            const bool last = (t == nt - 2);
            const char* a1 = cA + (size_t)(t + 1) * kstep;
            const char* a2 = last ? nA : cA + (size_t)(t + 2) * kstep; const char* b2 = last ? nB : cB + (size_t)(t + 2) * kstep;
            const char* a3 = a2 + kstep; const char* b3 = b2 + kstep;
            if (last && has_next) S.a_ready(nxt);
            if constexpr (SP2) {
            PG8_LDB(B0, 0, 0); PG8_LDB(B1, 0, 1); PG8_SCHED; PG8_LDA(At, 0, 0); PG8_STAGE(PG8_SA(1, 1), a1 + hstepA, voffA);
            PG8_WAIT_V(8); PG8_WAIT_L(0); PG8_BAR; PG8_MMA(0, 0, At, B0); PG8_MMA(0, 1, At, B1); PG8_BAR; PG8_SCHED;
            PG8_LDA(At, 0, 1); PG8_STAGE(PG8_SB(0, 0), b2, voffB); PG8_STAGE(PG8_SB(0, 1), b2 + hstepB, voffB); PG8_STAGE(PG8_SA(0, 0), a2, voffA);
            PG8_WAIT_V(8); PG8_WAIT_L(0); PG8_BAR; PG8_MMA(1, 0, At, B0); PG8_MMA(1, 1, At, B1); PG8_BAR; PG8_SCHED;
            PG8_LDB(B0, 1, 0); PG8_LDB(B1, 1, 1); PG8_SCHED; PG8_LDA(At, 1, 0); PG8_STAGE(PG8_SA(0, 1), a2 + hstepA, voffA);
            PG8_WAIT_V(8); PG8_WAIT_L(0); PG8_BAR; PG8_MMA(0, 0, At, B0); PG8_MMA(0, 1, At, B1); PG8_BAR; PG8_SCHED;
            PG8_LDA(At, 1, 1); PG8_STAGE(PG8_SB(1, 0), b3, voffB); PG8_STAGE(PG8_SB(1, 1), b3 + hstepB, voffB); PG8_STAGE(PG8_SA(1, 0), a3, voffA);
            PG8_WAIT_V(8); PG8_WAIT_L(0); PG8_BAR; PG8_MMA(1, 0, At, B0); PG8_MMA(1, 1, At, B1); PG8_BAR; PG8_SCHED;
            } else {
            PG8_LDB(B0, 0, 0); PG8_SCHED; PG8_LDA(At, 0, 0); PG8_STAGE(PG8_SA(1, 1), a1 + hstepA, voffA);
            PG8_WAIT_L(8); PG8_BAR; PG8_WAIT_L(0); PG8_MMA(0, 0, At, B0); PG8_BAR; PG8_SCHED;
            PG8_LDB(B1, 0, 1); PG8_STAGE(PG8_SB(0, 0), b2, voffB);
            PG8_BAR; PG8_WAIT_L(0); PG8_MMA(0, 1, At, B1); PG8_BAR;
            PG8_LDA(At, 0, 1); PG8_STAGE(PG8_SA(0, 0), a2, voffA);
            PG8_BAR; PG8_WAIT_L(0); PG8_MMA(1, 0, At, B0); PG8_BAR; PG8_SCHED;
            PG8_STAGE(PG8_SB(0, 1), b2 + hstepB, voffB);
            PG8_WAIT_V(6); PG8_BAR; PG8_MMA(1, 1, At, B1); PG8_BAR;
            PG8_LDB(B0, 1, 0); PG8_SCHED; PG8_LDA(At, 1, 0); PG8_STAGE(PG8_SA(0, 1), a2 + hstepA, voffA);
            PG8_WAIT_L(8); PG8_BAR; PG8_WAIT_L(0); PG8_MMA(0, 0, At, B0); PG8_BAR; PG8_SCHED;
            PG8_LDB(B1, 1, 1); PG8_STAGE(PG8_SB(1, 0), b3, voffB);
            PG8_BAR; PG8_WAIT_L(0); PG8_MMA(0, 1, At, B1); PG8_BAR;
            PG8_LDA(At, 1, 1); PG8_STAGE(PG8_SA(1, 0), a3, voffA);
            PG8_BAR; PG8_WAIT_L(0); PG8_MMA(1, 0, At, B0); PG8_BAR; PG8_SCHED;
            PG8_STAGE(PG8_SB(1, 1), b3 + hstepB, voffB);
            PG8_WAIT_V(6); PG8_BAR; PG8_MMA(1, 1, At, B1); PG8_BAR;
            }
        }
        if constexpr (ALIGN_EPI) { if (wr == 0) PG8_BAR; }
        if constexpr (!Epi::AFTER_DRAIN) { E(acc, cur, wr, wc, fr, fq); S.done(cur); }
        if (!has_next) break;
#pragma unroll
        for (int a = 0; a < 2; ++a)
#pragma unroll
            for (int b = 0; b < 2; ++b)
#pragma unroll
                for (int m = 0; m < 4; ++m)
#pragma unroll
                    for (int n = 0; n < 2; ++n) acc[a][b][m][n] = (f32x4){0.f, 0.f, 0.f, 0.f};
        cur = nxt; cA = nA; cB = nB; ++ui;
        if constexpr (ALIGN_EPI) { if (wr == 1) PG8_BAR; }
    }
    PG8_WAIT_V(0);
    if constexpr (!ALIGN_EPI) { if (wr == 0) PG8_BAR; }
    PG8_BAR;
    if constexpr (Epi::AFTER_DRAIN) { E.fused(acc, cur, wr, wc, fr, fq, lds, wid, lane); S.done(cur); }
#undef PG8_SA
#undef PG8_SB
#undef PG8_STAGE
#undef PG8_LDA
#undef PG8_LDB
#undef PG8_MMA
#undef PG8_WAIT_V
#undef PG8_WAIT_L
#undef PG8_BAR
#undef PG8_SCHED
}
}

#define GAS __attribute__((address_space(1)))
#define LAS __attribute__((address_space(3)))
typedef unsigned short bf16;
typedef unsigned v4u __attribute__((ext_vector_type(4)));
typedef unsigned v2u __attribute__((ext_vector_type(2)));
typedef float f32x4 __attribute__((ext_vector_type(4)));

#ifndef MK_MULTI
#define MK_MULTI 0
#endif

constexpr int BATCH = 8, SEQ = 2048, DM = 1024, M = BATCH * SEQ;
constexpr int NH = 8, HD = 64, AW = 512, SWD = 512, NG = 32, HC = 16, PS = 64, INW = 1280, FF = 2816;
constexpr float EPS = 1e-6f;
constexpr size_t MiB = 1u << 20;
constexpr size_t WS_WT1 = 2 * MiB, WS_WD1 = 14 * MiB, WS_WT2 = 20 * MiB, WS_WD2 = 32 * MiB, WS_WIN = 38 * MiB, WS_WOUT = 41 * MiB, WS_WGLU = 43 * MiB;
constexpr size_t WS_MATS = 44 * MiB;
constexpr size_t WS_SS0 = 56 * MiB, WS_SS1 = 52 * MiB, WS_SS2 = 53 * MiB;
constexpr size_t WS_SSA = 54 * MiB, WS_SSS = 55 * MiB;
constexpr size_t WS_XA = 64 * MiB;
constexpr size_t WS_YG = 240 * MiB;
constexpr size_t WS_H = 96 * MiB;
constexpr size_t WS_SST = 96 * MiB;
constexpr size_t WS_MIX = 112 * MiB;
constexpr size_t WS_UA = 168 * MiB;
constexpr size_t WS_QKV = 192 * MiB;
constexpr size_t WS_MATY = 216 * MiB;
constexpr size_t WS_END = 256 * MiB;
constexpr int TC = 32, NC = SEQ / TC, KY = 16 * TC + 256, KS = 16 * TC;
constexpr int LDS_BYTES = 147456, MISC_OFF = 147328;
constexpr size_t CTL_ZERO_BYTES = 16384;

__device__ __forceinline__ unsigned f2bf(float f) { unsigned u = __builtin_bit_cast(unsigned, f); return (u + 0x7fffu + ((u >> 16) & 1u)) >> 16; }
__device__ __forceinline__ unsigned pk2(float lo, float hi) { return f2bf(lo) | (f2bf(hi) << 16); }
__device__ __forceinline__ float bflo(unsigned w) { return __builtin_bit_cast(float, w << 16); }
__device__ __forceinline__ float bfhi(unsigned w) { return __builtin_bit_cast(float, w & 0xffff0000u); }
#define LDS_WAIT() asm volatile("s_waitcnt lgkmcnt(0)" ::: "memory")
__device__ __forceinline__ float wave_sum(float v) {
#pragma unroll
    for (int o = 1; o < 64; o <<= 1) v += __shfl_xor(v, o);
    return v;
}
__device__ __forceinline__ float sigmoidf_(float x) { return __builtin_amdgcn_rcpf(1.f + __expf(-x)); }

#define XB_TMO      128
#define XB_XCNT(j)  (256  + 64 * (j))
#define XB_XSUB(j)  (1280 + 64 * (j))
#define XB_XGEN(j)  (2304 + 64 * (j))
#define XB_TOP      3328
#define XB_TOPGEN   3392
#define XCD_BAR_WORDS 3456
#define XB_SPIN_CAP (1u << 18)

__device__ __forceinline__ unsigned xb_ld(unsigned* p)              { return __hip_atomic_load(p, __ATOMIC_RELAXED, __HIP_MEMORY_SCOPE_AGENT); }
__device__ __forceinline__ unsigned xb_add(unsigned* p, unsigned v) { return __hip_atomic_fetch_add(p, v, __ATOMIC_RELAXED, __HIP_MEMORY_SCOPE_AGENT); }
__device__ __forceinline__ unsigned xb_xcc_id() { return (unsigned)__builtin_amdgcn_s_getreg((3 << 11) | 20) & 0xFu; }
#define XB_SPIN(cond, bar) do { unsigned _sp = 0; while (cond) { __builtin_amdgcn_s_sleep(1); \
    if ((++_sp & 255u) == 0u) { if (xb_ld(&(bar)[XB_TMO])) break; if (_sp > XB_SPIN_CAP) { atomicAdd(&(bar)[XB_TMO], 1u); break; } } } } while (0)

struct XcdBarrier {
    unsigned* bar; unsigned x;
    volatile LAS unsigned* st;
};

__device__ __forceinline__ XcdBarrier xcd_barrier_post(unsigned* bar, volatile LAS unsigned* st) {
    XcdBarrier b; b.bar = bar; b.x = xb_xcc_id(); b.st = st;
    if (threadIdx.x == 0) (void)xb_add(&bar[XB_XCNT(b.x)], 1u);
    return b;
}
__device__ __forceinline__ void xcd_barrier_complete(unsigned* bar, unsigned x, unsigned& nloc, unsigned& nx) {
    const unsigned G = gridDim.x * gridDim.y * gridDim.z;
    unsigned sum, cnt, mine, sp = 0u;
    for (;;) {
        sum = 0u; cnt = 0u; mine = 0u;
#pragma unroll
        for (unsigned j = 0; j < 16; ++j) { const unsigned c = xb_ld(&bar[XB_XCNT(j)]); sum += c; cnt += (c > 0u) ? 1u : 0u; mine = (j == x) ? c : mine; }
        if (sum == G) break;
        __builtin_amdgcn_s_sleep(1);
        if ((++sp & 255u) == 0u) { if (xb_ld(&bar[XB_TMO])) break; if (sp > XB_SPIN_CAP) { atomicAdd(&bar[XB_TMO], 1u); break; } }
    }
    nloc = mine > 0u ? mine : 1u; nx = cnt > 0u ? cnt : 1u;
}

__device__ __forceinline__ void xcd_barrier(const XcdBarrier& b) {
    asm volatile("s_waitcnt vmcnt(0)" ::: "memory");
    __syncthreads();
    if (threadIdx.x == 0) {
        unsigned* bar = b.bar;
        __builtin_amdgcn_s_waitcnt(0);
        unsigned nloc = b.st[0], nx = b.st[1];
        if (nloc == 0u) { xcd_barrier_complete(bar, b.x, nloc, nx); b.st[0] = nloc; b.st[1] = nx; }
        const unsigned old = xb_add(&bar[XB_XSUB(b.x)], 1u);
        const unsigned gen = old / nloc;
        if (old + 1u == (gen + 1u) * nloc) {
            __builtin_amdgcn_fence(__ATOMIC_RELEASE, "agent");
            asm volatile("s_waitcnt vmcnt(0)" ::: "memory");
            const unsigned og = xb_add(&bar[XB_TOP], 1u);
            const unsigned tg = og / nx;
            if (og + 1u == (tg + 1u) * nx) xb_add(&bar[XB_TOPGEN], 1u);
            else XB_SPIN(xb_ld(&bar[XB_TOPGEN]) == tg, bar);
            __builtin_amdgcn_fence(__ATOMIC_ACQUIRE, "agent");
            xb_add(&bar[XB_XGEN(b.x)], 1u);
            asm volatile("s_waitcnt vmcnt(0)" ::: "memory");
        } else {
            XB_SPIN(xb_ld(&bar[XB_XGEN(b.x)]) == gen, bar);
            __builtin_amdgcn_fence(__ATOMIC_ACQUIRE, "agent");
            asm volatile("s_waitcnt vmcnt(0)" ::: "memory");
        }
    }
    __syncthreads();
}

namespace pg8 {
__device__ __forceinline__ float rstd16(const float* ss) { const f32x4 a = *(const f32x4*)ss, b = *(const f32x4*)(ss + 4), c = *(const f32x4*)(ss + 8), d = *(const f32x4*)(ss + 12);
    return 1.f / sqrtf((((a.x + a.y) + (a.z + a.w)) + ((b.x + b.y) + (b.z + b.w)) + ((c.x + c.y) + (c.z + c.w)) + ((d.x + d.y) + (d.z + d.w))) * (1.f / 1024.f) + EPS); }
__device__ __forceinline__ float rstd8(const float* ss) { const f32x4 a = *(const f32x4*)ss, b = *(const f32x4*)(ss + 4);
    return 1.f / sqrtf((((a.x + a.y) + (a.z + a.w)) + ((b.x + b.y) + (b.z + b.w))) * (1.f / 512.f) + EPS); }
template <bool SCALE> struct EpiSwiglu {
    static constexpr bool PERM = true, AFTER_DRAIN = false, MIDK = false;
    bf16_t* H; int ldh; const float* SS;
    __device__ __forceinline__ void operator()(const f32x4 (&acc)[2][2][4][2], const Unit& u, int wr, int wc, int fr, int fq) const {
        const int row0 = u.pm * BM + wr * 64 + fr, col0 = u.pn * HALF + wc * 32 + 8 * fq;
#pragma unroll
        for (int ai = 0; ai < 2; ++ai)
#pragma unroll
            for (int m = 0; m < 4; ++m) {
                if (SCALE) asm volatile("" ::: "memory");
                const int row = row0 + ai * HALF + m * 16;
                const float rs = SCALE ? rstd16(SS + (size_t)row * 16) : 1.f;
                bf16_t* rowp = H + (size_t)row * ldh + col0;
                float hv[8];
#pragma unroll
                for (int n = 0; n < 2; ++n)
#pragma unroll
                    for (int i = 0; i < 4; ++i) { const float g = acc[ai][0][m][n][i] * rs, up = acc[ai][1][m][n][i] * rs; hv[n * 4 + i] = g * __builtin_amdgcn_rcpf(1.f + __expf(-g)) * up; }
                u32x4 w; w.x = cvt_pk_bf16(hv[0], hv[1]); w.y = cvt_pk_bf16(hv[2], hv[3]); w.z = cvt_pk_bf16(hv[4], hv[5]); w.w = cvt_pk_bf16(hv[6], hv[7]);
                *(u32x4*)rowp = w;
            }
    }
};
struct EpiResid {
    static constexpr bool PERM = false, AFTER_DRAIN = false, MIDK = false;
    const float* base; float* out; float alpha;
    __device__ __forceinline__ void operator()(const f32x4 (&acc)[2][2][4][2], const Unit& u, int wr, int wc, int fr, int fq) const {
        const int col0 = u.pn * BM + wc * 32 + 4 * fq;
#pragma unroll
        for (int ai = 0; ai < 2; ++ai)
#pragma unroll
            for (int m = 0; m < 4; ++m) {
                const size_t off = (size_t)(u.pm * BM + ai * HALF + wr * 64 + m * 16 + fr) * 1024 + col0;
#pragma unroll
                for (int bj = 0; bj < 2; ++bj)
#pragma unroll
                    for (int n = 0; n < 2; ++n) { const f32x4 b = *(const f32x4*)(base + off + bj * HALF + n * 16); *(f32x4*)(out + off + bj * HALF + n * 16) = b + acc[ai][bj][m][n] * alpha; }
            }
    }
};
template <bool BASE_BF16, bool WOUT> struct EpiResidB {
    static constexpr bool PERM = false, AFTER_DRAIN = false, MIDK = WOUT;
    const void* base; bf16_t* XB; float alpha; float* SS; const PG8_LAS float* TAB;
    __device__ __forceinline__ void midk(f32x4 (&acc)[2][2][4][2], const Unit& u, int wr, int fr) const {
#pragma unroll
        for (int ai = 0; ai < 2; ++ai)
#pragma unroll
            for (int m = 0; m < 4; ++m) { const float ratio = TAB[(ai * HALF + wr * 64 + m * 16 + fr) * 2];
#pragma unroll
                for (int bj = 0; bj < 2; ++bj)
#pragma unroll
                    for (int n = 0; n < 2; ++n) acc[ai][bj][m][n] *= ratio; }
    }
    __device__ __forceinline__ void operator()(const f32x4 (&acc)[2][2][4][2], const Unit& u, int wr, int wc, int fr, int fq) const {
        typedef unsigned u32x2v __attribute__((ext_vector_type(2)));
        const int col0 = u.pn * BM + wc * 32 + 4 * fq;
#pragma unroll
        for (int ai = 0; ai < 2; ++ai)
#pragma unroll
            for (int m = 0; m < 4; ++m) {
                asm volatile("" ::: "memory");
                const int row = u.pm * BM + ai * HALF + wr * 64 + m * 16 + fr;
                const size_t off = (size_t)row * 1024 + col0;
                const float sc = WOUT ? alpha * TAB[(ai * HALF + wr * 64 + m * 16 + fr) * 2 + 1] : alpha;
                float ssq = 0.f;
#pragma unroll
                for (int bj = 0; bj < 2; ++bj)
#pragma unroll
                    for (int n = 0; n < 2; ++n) { const size_t o = off + bj * HALF + n * 16; f32x4 b;
                        if (BASE_BF16) { const u32x2v w = *(const u32x2v*)((const bf16_t*)base + o); b = (f32x4){bflo(w.x), bfhi(w.x), bflo(w.y), bfhi(w.y)}; }
                        else b = *(const f32x4*)((const float*)base + o);
                        const f32x4 v = b + acc[ai][bj][m][n] * sc;
                        ssq += (v.x * v.x + v.y * v.y) + (v.z * v.z + v.w * v.w);
                        u32x2v w2; w2.x = cvt_pk_bf16(v.x, v.y); w2.y = cvt_pk_bf16(v.z, v.w); *(u32x2v*)(XB + o) = w2; }
                ssq += __shfl_xor(ssq, 16); ssq += __shfl_xor(ssq, 32);
                if (fq == 0) SS[(size_t)row * 16 + u.pn * 4 + wc] = ssq;
            }
    }
};
struct EpiResidOut {
    static constexpr bool PERM = false, AFTER_DRAIN = false, MIDK = false;
    const bf16_t* XB; float* out; float alpha;
    __device__ __forceinline__ void operator()(const f32x4 (&acc)[2][2][4][2], const Unit& u, int wr, int wc, int fr, int fq) const {
        typedef unsigned u32x2v __attribute__((ext_vector_type(2)));
        const int col0 = u.pn * BM + wc * 32 + 4 * fq;
#pragma unroll
        for (int ai = 0; ai < 2; ++ai)
#pragma unroll
            for (int m = 0; m < 4; ++m) {
                const size_t off = (size_t)(u.pm * BM + ai * HALF + wr * 64 + m * 16 + fr) * 1024 + col0;
#pragma unroll
                for (int bj = 0; bj < 2; ++bj)
#pragma unroll
                    for (int n = 0; n < 2; ++n) { const size_t o = off + bj * HALF + n * 16; const u32x2v w = *(const u32x2v*)(XB + o);
                        *(f32x4*)(out + o) = (f32x4){bflo(w.x), bfhi(w.x), bflo(w.y), bfhi(w.y)} + acc[ai][bj][m][n] * alpha; }
            }
    }
};
struct EpiGlu {
    static constexpr bool PERM = true, AFTER_DRAIN = false, MIDK = false;
    const bf16_t* Y; bf16_t* MIXB; const float* bias; const float* gs; float* SSS;
    __device__ __forceinline__ void operator()(const f32x4 (&acc)[2][2][4][2], const Unit& u, int wr, int wc, int fr, int fq) const {
        const int row0 = u.pm * BM + wr * 64 + fr, col0 = u.pn * BM + wc * 32 + 8 * fq;
        f32x4 bv[2][2], gv[2][2];
#pragma unroll
        for (int bj = 0; bj < 2; ++bj)
#pragma unroll
            for (int n = 0; n < 2; ++n) { bv[bj][n] = *(const f32x4*)(bias + col0 + bj * HALF + 4 * n); gv[bj][n] = *(const f32x4*)(gs + col0 + bj * HALF + 4 * n); }
#pragma unroll
        for (int ai = 0; ai < 2; ++ai)
#pragma unroll
            for (int m = 0; m < 4; ++m) {
                const int row = row0 + ai * HALF + m * 16; float ssq = 0.f;
#pragma unroll
                for (int bj = 0; bj < 2; ++bj) {
                    const u32x4 yv = *(const u32x4*)(Y + (size_t)row * 512 + col0 + bj * HALF);
                    const f32x4 v0 = acc[ai][bj][m][0] + bv[bj][0], v1 = acc[ai][bj][m][1] + bv[bj][1];
                    float o[8];
                    o[0] = bflo(yv.x) * sigmoidf_(v0[0]); o[1] = bfhi(yv.x) * sigmoidf_(v0[1]); o[2] = bflo(yv.y) * sigmoidf_(v0[2]); o[3] = bfhi(yv.y) * sigmoidf_(v0[3]);
                    o[4] = bflo(yv.z) * sigmoidf_(v1[0]); o[5] = bfhi(yv.z) * sigmoidf_(v1[1]); o[6] = bflo(yv.w) * sigmoidf_(v1[2]); o[7] = bfhi(yv.w) * sigmoidf_(v1[3]);
#pragma unroll
                    for (int i = 0; i < 8; ++i) ssq += o[i] * o[i];
                    const f32x4 g0 = gv[bj][0], g1 = gv[bj][1];
                    u32x4 w; w.x = cvt_pk_bf16(o[0] * g0.x, o[1] * g0.y); w.y = cvt_pk_bf16(o[2] * g0.z, o[3] * g0.w); w.z = cvt_pk_bf16(o[4] * g1.x, o[5] * g1.y); w.w = cvt_pk_bf16(o[6] * g1.z, o[7] * g1.w);
                    *(u32x4*)(MIXB + (size_t)row * 1024 + 512 + col0 + bj * HALF) = w;
                }
                ssq += __shfl_xor(ssq, 16); ssq += __shfl_xor(ssq, 32);
                if (fq == 0) SSS[(size_t)row * 8 + u.pn * 4 + wc] = ssq;
            }
    }
};
}

template <int MODE>
__device__ __forceinline__ void p0_transpose_item(const float* W, const float* kgain, int K, int N, bf16* WT, LAS float* scr, int item, int lane) {
    const int nblk = N / 32, kb = item / nblk, nb = item % nblk, k0 = 64 * kb, n0 = 32 * nb;
    f32x4 v[8];
#pragma unroll
    for (int i = 0; i < 8; ++i) v[i] = *(const f32x4*)(W + (size_t)(k0 + 8 * i + (lane >> 3)) * N + n0 + 4 * (lane & 7));
    if (kgain) {
#pragma unroll
        for (int i = 0; i < 8; ++i) v[i] = v[i] * kgain[k0 + 8 * i + (lane >> 3)]; }
#pragma unroll
    for (int i = 0; i < 8; ++i) { LAS float* d = scr + (8 * i + (lane >> 3)) * 33 + 4 * (lane & 7); d[0] = v[i].x; d[1] = v[i].y; d[2] = v[i].z; d[3] = v[i].w; }
    LDS_WAIT(); asm volatile("" ::: "memory");
    const int c = lane & 7;
    const int r0 = MODE == 0 ? n0 : ((n0 >> 7) * 256 + (n0 & 127) + (MODE == 2 ? 128 : 0));
#pragma unroll
    for (int j = 0; j < 4; ++j) { const int n = (lane >> 3) + 8 * j; const LAS float* s = scr + (8 * c) * 33 + n;
        v4u o; o.x = pk2(s[0 * 33], s[1 * 33]); o.y = pk2(s[2 * 33], s[3 * 33]); o.z = pk2(s[4 * 33], s[5 * 33]); o.w = pk2(s[6 * 33], s[7 * 33]);
        *(v4u*)(WT + (size_t)(r0 + n) * K + k0 + 8 * c) = o; }
    LDS_WAIT(); asm volatile("" ::: "memory");
}

__device__ __forceinline__ void row_to_bf16_ss(const float* xrow, bf16* orow, float* ssrow, int lane) {
    const f32x4* xr = (const f32x4*)xrow + lane;
    f32x4 v[4]; float s = 0.f;
#pragma unroll
    for (int j = 0; j < 4; ++j) { v[j] = xr[64 * j]; s += (v[j].x * v[j].x + v[j].y * v[j].y) + (v[j].z * v[j].z + v[j].w * v[j].w); }
    s = wave_sum(s);
    unsigned long long* o8 = (unsigned long long*)orow + lane;
#pragma unroll
    for (int j = 0; j < 4; ++j) o8[64 * j] = (unsigned long long)pk2(v[j].x, v[j].y) | ((unsigned long long)pk2(v[j].z, v[j].w) << 32);
    if (lane < 16) ssrow[lane] = lane == 0 ? s : 0.f;
}
__device__ __forceinline__ void rms_row_f32(float* xrow, const float* gain, int lane) {
    f32x4* xr = (f32x4*)xrow + lane; const f32x4* gr = (const f32x4*)gain + lane;
    f32x4 v[4]; float s = 0.f;
#pragma unroll
    for (int j = 0; j < 4; ++j) { v[j] = xr[64 * j]; s += (v[j].x * v[j].x + v[j].y * v[j].y) + (v[j].z * v[j].z + v[j].w * v[j].w); }
    const float rstd = 1.f / sqrtf(wave_sum(s) * (1.f / DM) + EPS);
#pragma unroll
    for (int j = 0; j < 4; ++j) { const f32x4 g = gr[64 * j]; xr[64 * j] = v[j] * rstd * g; }
}
__device__ __forceinline__ void mix_row(const bf16* arow, const bf16* srow, const float* ga, const float* gs, bf16* orow, int lane) {
    const v4u a = *((const v4u*)arow + lane), s = *((const v4u*)srow + lane);
    float av[8] = {bflo(a.x), bfhi(a.x), bflo(a.y), bfhi(a.y), bflo(a.z), bfhi(a.z), bflo(a.w), bfhi(a.w)};
    float sv[8] = {bflo(s.x), bfhi(s.x), bflo(s.y), bfhi(s.y), bflo(s.z), bfhi(s.z), bflo(s.w), bfhi(s.w)};
    float sa = 0.f, ss = 0.f;
#pragma unroll
    for (int i = 0; i < 8; ++i) { sa += av[i] * av[i]; ss += sv[i] * sv[i]; }
    const float ra = 1.f / sqrtf(wave_sum(sa) * (1.f / 512.f) + EPS), rs = 1.f / sqrtf(wave_sum(ss) * (1.f / 512.f) + EPS);
    const f32x4 ga0 = *((const f32x4*)ga + 2 * lane), ga1 = *((const f32x4*)ga + 2 * lane + 1), gs0 = *((const f32x4*)gs + 2 * lane), gs1 = *((const f32x4*)gs + 2 * lane + 1);
    v4u oa, os;
    oa.x = pk2(av[0] * ra * ga0.x, av[1] * ra * ga0.y); oa.y = pk2(av[2] * ra * ga0.z, av[3] * ra * ga0.w); oa.z = pk2(av[4] * ra * ga1.x, av[5] * ra * ga1.y); oa.w = pk2(av[6] * ra * ga1.z, av[7] * ra * ga1.w);
    os.x = pk2(sv[0] * rs * gs0.x, sv[1] * rs * gs0.y); os.y = pk2(sv[2] * rs * gs0.z, sv[3] * rs * gs0.w); os.z = pk2(sv[4] * rs * gs1.x, sv[5] * rs * gs1.y); os.w = pk2(sv[6] * rs * gs1.z, sv[7] * rs * gs1.w);
    *((v4u*)orow + lane) = oa; *((v4u*)(orow + 512) + lane) = os;
}

typedef float f32x16 __attribute__((ext_vector_type(16)));
typedef short bf16x8 __attribute__((ext_vector_type(8)));
typedef __bf16 bf16x2_t __attribute__((ext_vector_type(2)));
typedef float f32x2_t __attribute__((ext_vector_type(2)));
__device__ __forceinline__ unsigned cvtpk(float lo, float hi) { f32x2_t v = {lo, hi}; bf16x2_t b = __builtin_convertvector(v, bf16x2_t); return __builtin_bit_cast(unsigned, b); }
__device__ __forceinline__ void attn_mfma(LAS unsigned char* lds, const bf16* QKV  , bf16* MIXB  , float* SSA, const float* ga, const float* sinks, int ubeg, int uend, int ustep) {
    constexpr int KSTR = 144, VSTR = 784, VT_OFF = 384 * KSTR;
    constexpr float LOG2E = 1.4426950408889634f, K1 = 0.125f * LOG2E;
    const int tid = threadIdx.x, lane = tid & 63, w = tid >> 6, r = lane & 31, hi = lane >> 5;
    for (int unit = ubeg; unit < uend; unit += ustep) {
        const int kh = unit & 1, qb = (unit >> 1) & 15, b = unit >> 5, kp0 = qb * 128 - 128;
        __syncthreads();
        for (int c = tid; c < 3072; c += 512) { const int rr = c >> 3, ch = c & 7, kp = kp0 + rr; v4u kv = (v4u){0u, 0u, 0u, 0u}, vv = kv;
            if (kp >= 0 && kp < SEQ) { const bf16* src = QKV + (size_t)(b * SEQ + kp) * 768; kv = *(const v4u*)(src + 512 + kh * 64 + ch * 8); vv = *(const v4u*)(src + 640 + kh * 64 + ch * 8); }
            *(LAS v4u*)(lds + rr * KSTR + ch * 16) = kv;
            const int pos = (rr & ~15) | (((rr >> 2) & 1) << 3) | (((rr >> 3) & 1) << 2) | (rr & 3);
            LAS unsigned short* vt = (LAS unsigned short*)(lds + VT_OFF + (ch * 8) * VSTR + pos * 2);
            vt[0 * (VSTR / 2)] = (unsigned short)(vv.x & 0xffffu); vt[1 * (VSTR / 2)] = (unsigned short)(vv.x >> 16); vt[2 * (VSTR / 2)] = (unsigned short)(vv.y & 0xffffu); vt[3 * (VSTR / 2)] = (unsigned short)(vv.y >> 16);
            vt[4 * (VSTR / 2)] = (unsigned short)(vv.z & 0xffffu); vt[5 * (VSTR / 2)] = (unsigned short)(vv.z >> 16); vt[6 * (VSTR / 2)] = (unsigned short)(vv.w & 0xffffu); vt[7 * (VSTR / 2)] = (unsigned short)(vv.w >> 16); }
        __syncthreads();
        const int h = kh * 4 + (w >> 1);
        const float slope2 = exp2f(-(float)(h + 1)) * LOG2E, sink2 = sinks[h] * LOG2E;
        const bool qedge = (qb == 0) || (qb == 15);
        for (int qi2 = 0; qi2 < 2; ++qi2) {
            const int q0 = ((w & 1) * 2 + qi2) * 32, t = qb * 128 + q0 + r;
            bf16x8 qf[4];
            { const bf16* qp = QKV + (size_t)(b * SEQ + t) * 768 + h * 64 + hi * 8;
#pragma unroll
              for (int ks = 0; ks < 4; ++ks) qf[ks] = *(const bf16x8*)(qp + ks * 16); }
            float m2 = sink2, l = 0.f;
            f32x16 o0, o1;
#pragma unroll
            for (int i = 0; i < 16; ++i) { o0[i] = 0.f; o1[i] = 0.f; }
            for (int kb = 0; kb < 9; ++kb) {
                const int jj0 = q0 + kb * 32;
                f32x16 s;
#pragma unroll
                for (int i = 0; i < 16; ++i) s[i] = 0.f;
#pragma unroll
                for (int ks = 0; ks < 4; ++ks) { const bf16x8 kf = *(const LAS bf16x8*)(lds + (jj0 + r) * KSTR + ks * 32 + hi * 16); s = __builtin_amdgcn_mfma_f32_32x32x16_bf16(kf, qf[ks], s, 0, 0, 0); }
                const float relbf = (float)(kb * 32 - 128 - r + 4 * hi);
#pragma unroll
                for (int i = 0; i < 16; ++i) { const float ci = (float)((i & 3) + 8 * (i >> 2)); s[i] = s[i] * K1 - slope2 * fabsf(relbf + ci); }
                if (kb == 0 || kb == 8 || qedge) {
                    const float kpf = (float)(kp0 + jj0 + 4 * hi);
#pragma unroll
                    for (int i = 0; i < 16; ++i) { const float ci = (float)((i & 3) + 8 * (i >> 2)); const bool valid = (fabsf(relbf + ci) <= 128.f) && (kpf + ci >= 0.f) && (kpf + ci < (float)SEQ); s[i] = valid ? s[i] : -1e30f; }
                }
                float bm = s[0];
#pragma unroll
                for (int i = 1; i < 16; ++i) bm = fmaxf(bm, s[i]);
                bm = fmaxf(bm, __shfl_xor(bm, 32));
                const float mn = fmaxf(m2, bm), corr = __builtin_amdgcn_exp2f(m2 - mn);
                m2 = mn;
                float ps = 0.f;
#pragma unroll
                for (int i = 0; i < 16; ++i) { s[i] = __builtin_amdgcn_exp2f(s[i] - mn); ps += s[i]; }
                l = l * corr + ps;
#pragma unroll
                for (int i = 0; i < 16; ++i) { o0[i] *= corr; o1[i] *= corr; }
#pragma unroll
                for (int st = 0; st < 2; ++st) {
                    v4u pw; pw.x = cvtpk(s[8 * st + 0], s[8 * st + 1]); pw.y = cvtpk(s[8 * st + 2], s[8 * st + 3]); pw.z = cvtpk(s[8 * st + 4], s[8 * st + 5]); pw.w = cvtpk(s[8 * st + 6], s[8 * st + 7]);
                    const bf16x8 pf = __builtin_bit_cast(bf16x8, pw);
                    const bf16x8 v0 = *(const LAS bf16x8*)(lds + VT_OFF + r * VSTR + (jj0 + 16 * st + 8 * hi) * 2);
                    const bf16x8 v1 = *(const LAS bf16x8*)(lds + VT_OFF + (32 + r) * VSTR + (jj0 + 16 * st + 8 * hi) * 2);
                    o0 = __builtin_amdgcn_mfma_f32_32x32x16_bf16(v0, pf, o0, 0, 0, 0);
                    o1 = __builtin_amdgcn_mfma_f32_32x32x16_bf16(v1, pf, o1, 0, 0, 0);
                }
            }
            const float ltot = l + __shfl_xor(l, 32) + __builtin_amdgcn_exp2f(sink2 - m2), inv = 1.f / ltot;
            bf16* op = MIXB + (size_t)(b * SEQ + t) * 1024 + h * 64 + 4 * hi;
            const float* gp = ga + h * 64 + 4 * hi;
            float ssq = 0.f;
#pragma unroll
            for (int gq = 0; gq < 4; ++gq) {
                const f32x4 g0 = *(const f32x4*)(gp + 8 * gq), g1 = *(const f32x4*)(gp + 32 + 8 * gq);
                const float a0 = o0[4 * gq] * inv, a1 = o0[4 * gq + 1] * inv, a2 = o0[4 * gq + 2] * inv, a3 = o0[4 * gq + 3] * inv;
                const float c0 = o1[4 * gq] * inv, c1 = o1[4 * gq + 1] * inv, c2 = o1[4 * gq + 2] * inv, c3 = o1[4 * gq + 3] * inv;
                ssq += (a0 * a0 + a1 * a1) + (a2 * a2 + a3 * a3) + (c0 * c0 + c1 * c1) + (c2 * c2 + c3 * c3);
                v2u a; a.x = cvtpk(a0 * g0.x, a1 * g0.y); a.y = cvtpk(a2 * g0.z, a3 * g0.w); *(v2u*)(op + 8 * gq) = a;
                v2u c; c.x = cvtpk(c0 * g1.x, c1 * g1.y); c.y = cvtpk(c2 * g1.z, c3 * g1.w); *(v2u*)(op + 32 + 8 * gq) = c; }
            ssq += __shfl_xor(ssq, 32);
            if (hi == 0) SSA[(size_t)(b * SEQ + t) * 8 + h] = ssq;
        }
    }
}

struct SsmP { const float *lam_re, *lam_im, *log_dt, *b_re, *b_im, *c_re, *c_im, *dskip; };
__device__ __forceinline__ float gelu_tanh(float x) { const float z = 1.5957691216f * (x + 0.044715f * x * x * x); return x * __builtin_amdgcn_rcpf(1.f + __expf(-z)); }
__device__ __forceinline__ void lam_of(const SsmP& P, int dg, int p, float& lrdt, float& lidt, float& cr, float& ci) {
    const float lr = fminf(P.lam_re[dg * PS + p], -1e-4f), li = P.lam_im[dg * PS + p], dt = expf(P.log_dt[dg]);
    lrdt = lr * dt; lidt = li * dt;
    const float mag = expf(lrdt), ar = mag * cosf(lidt), ai = mag * sinf(lidt), den = lr * lr + li * li;
    cr = ((ar - 1.f) * lr + ai * li) / den; ci = (ai * lr - (ar - 1.f) * li) / den;
}
__device__ __forceinline__ void apow(float lrdt, float lidt, float k, float& pr, float& pi) { const float m = expf(lrdt * k), a = lidt * k; pr = m * cosf(a); pi = m * sinf(a); }

__device__ __forceinline__ void gen_states_item(const SsmP& P, bf16* MATS, int it, int lane) {
    const int p = it & 63, dir = (it >> 6) & 1, g = it >> 7, dg = dir * NG + g, s = lane >> 1, hh = lane & 1;
    float lrdt, lidt, cr, ci, pr, pi; lam_of(P, dg, p, lrdt, lidt, cr, ci); apow(lrdt, lidt, (float)(dir ? s : TC - 1 - s), pr, pi);
    const float wr = pr * cr - pi * ci, wi = pr * ci + pi * cr;
    const float* brp = P.b_re + (size_t)(dg * PS + p) * HC + hh * 8; const float* bip = P.b_im + (size_t)(dg * PS + p) * HC + hh * 8;
    const f32x4 br0 = *(const f32x4*)brp, br1 = *(const f32x4*)(brp + 4), bi0 = *(const f32x4*)bip, bi1 = *(const f32x4*)(bip + 4);
    const f32x4 re0 = br0 * wr - bi0 * wi, re1 = br1 * wr - bi1 * wi, im0 = bi0 * wr + br0 * wi, im1 = bi1 * wr + br1 * wi;
    v4u o; bf16* dst = MATS + (size_t)(g * 256 + dir * 128 + p) * KS + s * 16 + hh * 8;
    o.x = pk2(re0.x, re0.y); o.y = pk2(re0.z, re0.w); o.z = pk2(re1.x, re1.y); o.w = pk2(re1.z, re1.w); *(v4u*)dst = o;
    o.x = pk2(im0.x, im0.y); o.y = pk2(im0.z, im0.w); o.z = pk2(im1.x, im1.y); o.w = pk2(im1.z, im1.w); *(v4u*)(dst + (size_t)64 * KS) = o;
}
__device__ __forceinline__ void gen_carry_item(const SsmP& P, bf16* MATY, int it, int lane) {
    const int tau = it & 31, dir = (it >> 5) & 1, g = it >> 6, dg = dir * NG + g;
    float lrdt, lidt, cr, ci, pr, pi; lam_of(P, dg, lane, lrdt, lidt, cr, ci); apow(lrdt, lidt, (float)(dir ? TC - tau : tau + 1), pr, pi);
#pragma unroll
    for (int h = 0; h < HC; ++h) { const float c_r = P.c_re[(size_t)(dg * HC + h) * PS + lane], c_i = P.c_im[(size_t)(dg * HC + h) * PS + lane];
        bf16* dst = MATY + (size_t)(g * 512 + tau * 16 + h) * KY + 512 + dir * 128 + lane;
        dst[0] = (bf16)f2bf(c_r * pr - c_i * pi); dst[64] = (bf16)f2bf(-(c_r * pi + c_i * pr)); }
}
__device__ __forceinline__ void gen_toep_item(const SsmP& P, bf16* MATY, LAS float* scr, int it, int lane) {
    const int g = it / 63, dl = it % 63 - 31, k = dl < 0 ? -dl : dl;
    LAS float* Wr = scr; LAS float* Wi = scr + 64; LAS float* Cr = scr + 128; LAS float* Ci = Cr + 16 * 65; LAS float* Br = Ci + 16 * 65; LAS float* Bi = Br + 1024;
    const int h = lane >> 2, q = lane & 3;
    float val[4] = {0.f, 0.f, 0.f, 0.f};
    for (int dir = 0; dir < 2; ++dir) {
        if ((dl > 0 && dir == 1) || (dl < 0 && dir == 0)) continue;
        const int dg = dir * NG + g;
        float lrdt, lidt, cr, ci, pr, pi; lam_of(P, dg, lane, lrdt, lidt, cr, ci); apow(lrdt, lidt, (float)k, pr, pi);
        Wr[lane] = pr * cr - pi * ci; Wi[lane] = pr * ci + pi * cr;
#pragma unroll
        for (int i = 0; i < 16; ++i) { Cr[i * 65 + lane] = P.c_re[(size_t)(dg * HC + i) * PS + lane]; Ci[i * 65 + lane] = P.c_im[(size_t)(dg * HC + i) * PS + lane];
            Br[i * 64 + lane] = P.b_re[(size_t)dg * 1024 + i * 64 + lane]; Bi[i * 64 + lane] = P.b_im[(size_t)dg * 1024 + i * 64 + lane]; }
        LDS_WAIT(); asm volatile("" ::: "memory");
        for (int p = 0; p < 64; ++p) { const float wr = Wr[p], wi = Wi[p], c_r = Cr[h * 65 + p], c_i = Ci[h * 65 + p], tr = c_r * wr - c_i * wi, ti = c_r * wi + c_i * wr;
            const f32x4 b_r = *(const LAS f32x4*)(Br + p * 16 + 4 * q), b_i = *(const LAS f32x4*)(Bi + p * 16 + 4 * q);
            val[0] += tr * b_r.x - ti * b_i.x; val[1] += tr * b_r.y - ti * b_i.y; val[2] += tr * b_r.z - ti * b_i.z; val[3] += tr * b_r.w - ti * b_i.w; }
        LDS_WAIT(); asm volatile("" ::: "memory");
    }
    if (dl == 0) { const float dsk = P.dskip[g * HC + h];
#pragma unroll
        for (int j = 0; j < 4; ++j) if (4 * q + j == h) val[j] += dsk; }
    v2u o; o.x = pk2(val[0], val[1]); o.y = pk2(val[2], val[3]);
    const int t_lo = dl > 0 ? dl : 0, t_hi = dl < 0 ? TC - 1 + dl : TC - 1;
    for (int tau = t_lo; tau <= t_hi; ++tau) { const int s = tau - dl; *(v2u*)(MATY + (size_t)(g * 512 + tau * 16 + h) * KY + s * 16 + 4 * q) = o; }
}

namespace pg8 {
struct GroupOrder {
    int rm, rn, nwg, G, c;
    __device__ void init(int ng, int rm_, int rn_, int G_, int c_) { rm = rm_; rn = rn_; nwg = ng * rm * rn; G = G_; c = c_; }
    __device__ bool next(int i, Unit& u) const { const long L = (long)i * G + c; if (L >= nwg) return false; const int per = rm * rn, gi = (int)L / per, r = (int)L % per; u.pm = gi * rm + r % rm; u.pn = gi * rn + r / rm; return true; }
    __device__ __forceinline__ void a_ready(const Unit&) const {}
    __device__ __forceinline__ void done(const Unit&) const {}
};
struct EpiWin {
    static constexpr bool PERM = true, AFTER_DRAIN = false, MIDK = false;
    bf16_t* QKV; bf16_t* UA; const float* SS;
    __device__ __forceinline__ void operator()(const f32x4 (&acc)[2][2][4][2], const Unit& u, int wr, int wc, int fr, int fq) const {
        const int row0 = u.pm * BM + wr * 64 + fr;
#pragma unroll
        for (int ai = 0; ai < 2; ++ai)
#pragma unroll
            for (int m = 0; m < 4; ++m) { const int r = row0 + ai * HALF + m * 16; const float rs = rstd16(SS + (size_t)r * 16);
#pragma unroll
                for (int bj = 0; bj < 2; ++bj) { const f32x4 v0 = acc[ai][bj][m][0] * rs, v1 = acc[ai][bj][m][1] * rs;
                    u32x4 w; w.x = cvt_pk_bf16(v0[0], v0[1]); w.y = cvt_pk_bf16(v0[2], v0[3]); w.z = cvt_pk_bf16(v1[0], v1[1]); w.w = cvt_pk_bf16(v1[2], v1[3]);
                    if (u.pn < 3) { *(u32x4*)(QKV + (size_t)r * 768 + u.pn * BM + bj * HALF + wc * 32 + 8 * fq) = w; }
                    else { const int ucol = (u.pn - 3) * BM + bj * HALF + wc * 32 + 8 * fq, gi = ucol >> 4, h0 = ucol & 15, b = r >> 11, t = r & 2047, c = t >> 5, tau = t & 31;
                        *(u32x4*)(UA + (size_t)(gi * 512 + b * 64 + c) * KY + tau * 16 + h0) = w; } } }
    }
};
struct EpiStates {
    static constexpr bool PERM = false, AFTER_DRAIN = true, MIDK = false;
    float* SST; bf16_t* UA; const float *lam_re, *lam_im, *log_dt;
    __device__ __forceinline__ void fused(f32x4 (&acc)[2][2][4][2], const Unit& u, int wr, int wc, int fr, int fq, PG8_LAS unsigned char* lds, int wid, int lane) const {
#pragma unroll
        for (int ai = 0; ai < 2; ++ai)
#pragma unroll
            for (int m = 0; m < 4; ++m) { float* rowp = SST + (size_t)(u.pm * BM + ai * HALF + wr * 64 + m * 16 + fr) * 256 + wc * 32 + 4 * fq;
#pragma unroll
                for (int bj = 0; bj < 2; ++bj)
#pragma unroll
                    for (int n = 0; n < 2; ++n) *(f32x4*)(rowp + bj * HALF + n * 16) = acc[ai][bj][m][n]; }
        asm volatile("s_waitcnt vmcnt(0)" ::: "memory"); __syncthreads();
        __builtin_amdgcn_fence(__ATOMIC_ACQUIRE, "agent");
        const int gi = u.pm >> 1, bl = wid >> 1, dir = wid & 1, dg = dir * NG + gi;
        const float lr = fminf(lam_re[dg * PS + lane], -1e-4f), li = lam_im[dg * PS + lane], dt = expf(log_dt[dg]);
        const float mg = expf(lr * dt * (float)TC), ang = li * dt * (float)TC, a_r = mg * cosf(ang), a_i = mg * sinf(ang);
        const size_t rowbase = (size_t)u.pm * BM + bl * 64;
        const float* sre = SST + rowbase * 256 + dir * 128 + lane;
        bf16_t* cre = UA + rowbase * KY + 512 + dir * 128 + lane;
        float xr = 0.f, xi = 0.f;
        for (int bt = 0; bt < NC / 16; ++bt) {
            float sr[16], si[16];
#pragma unroll
            for (int j = 0; j < 16; ++j) { const int i = bt * 16 + j, c = dir ? NC - 1 - i : i; sr[j] = sre[(size_t)c * 256]; si[j] = sre[(size_t)c * 256 + 64]; }
#pragma unroll
            for (int j = 0; j < 16; ++j) { const int i = bt * 16 + j, c = dir ? NC - 1 - i : i;
                cre[(size_t)c * KY] = (bf16_t)f2bf(xr); cre[(size_t)c * KY + 64] = (bf16_t)f2bf(xi);
                const float nr = a_r * xr - a_i * xi + sr[j]; xi = a_r * xi + a_i * xr + si[j]; xr = nr; }
        }
    }
};
struct EpiSsmOut {
    static constexpr bool PERM = true, AFTER_DRAIN = false, MIDK = false;
    bf16_t* YG;
    __device__ __forceinline__ void operator()(const f32x4 (&acc)[2][2][4][2], const Unit& u, int wr, int wc, int fr, int fq) const {
        const int gi = u.pm >> 1;
#pragma unroll
        for (int ai = 0; ai < 2; ++ai)
#pragma unroll
            for (int m = 0; m < 4; ++m) { const int bc = ((u.pm & 1) * BM + ai * HALF + wr * 64 + m * 16 + fr), b = bc >> 6, c = bc & 63;
#pragma unroll
                for (int bj = 0; bj < 2; ++bj) { const int col = (u.pn & 1) * BM + bj * HALF + wc * 32 + 8 * fq, tau = col >> 4, h0 = col & 15;
                    const f32x4 v0 = acc[ai][bj][m][0], v1 = acc[ai][bj][m][1];
                    u32x4 w; w.x = cvt_pk_bf16(gelu_tanh(v0[0]), gelu_tanh(v0[1])); w.y = cvt_pk_bf16(gelu_tanh(v0[2]), gelu_tanh(v0[3]));
                    w.z = cvt_pk_bf16(gelu_tanh(v1[0]), gelu_tanh(v1[1])); w.w = cvt_pk_bf16(gelu_tanh(v1[2]), gelu_tanh(v1[3]));
                    *(u32x4*)(YG + (size_t)(b * SEQ + c * TC + tau) * SWD + gi * 16 + h0) = w; } }
    }
};
}

struct Args { const float* in[26]; float* out; unsigned char* ws; int ph_lo, ph_hi; };
constexpr int N_PHASES = 11;
constexpr int F2_ITEMS = (DM / 64) * (FF / 32), F2_SPLIT = 1536;
__device__ __forceinline__ void ffn2_item(const Args& args, bf16* WT2, bf16* WD2, LAS float* scr, int it, int lane) {
    if (it < F2_ITEMS) p0_transpose_item<1>(args.in[22], args.in[21], DM, FF, WT2, scr, it, lane);
    else if (it < 2 * F2_ITEMS) p0_transpose_item<2>(args.in[23], args.in[21], DM, FF, WT2, scr, it - F2_ITEMS, lane);
    else p0_transpose_item<0>(args.in[24], nullptr, FF, DM, WD2, scr, it - 2 * F2_ITEMS, lane);
}
__global__ void __launch_bounds__(512, 2) mk_fwd(Args args) {
    extern __shared__ __attribute__((aligned(16))) unsigned char lds_raw[];
    LAS unsigned char* lds = (LAS unsigned char*)lds_raw;
    cg::grid_group grid = cg::this_grid();
    const int tid = threadIdx.x, lane = tid & 63, wave = __builtin_amdgcn_readfirstlane(tid >> 6);
    const int G = gridDim.x, bid = blockIdx.x;
    const int gw = bid * 8 + wave, NGW = G * 8;
    unsigned char* ws = args.ws;
    const float* x = args.in[0];
    float* X = args.out;
    bf16* WT1 = (bf16*)(ws + WS_WT1); bf16* WD1 = (bf16*)(ws + WS_WD1); bf16* WT2 = (bf16*)(ws + WS_WT2); bf16* WD2 = (bf16*)(ws + WS_WD2);
    bf16* WIN = (bf16*)(ws + WS_WIN); bf16* WOUT = (bf16*)(ws + WS_WOUT); bf16* WGLU = (bf16*)(ws + WS_WGLU);
    bf16* XA = (bf16*)(ws + WS_XA); bf16* HB = (bf16*)(ws + WS_H); bf16* QKV = (bf16*)(ws + WS_QKV); bf16* YG = (bf16*)(ws + WS_YG);
    float* SS0 = (float*)(ws + WS_SS0); float* SS1 = (float*)(ws + WS_SS1); float* SS2 = (float*)(ws + WS_SS2); float* SSA = (float*)(ws + WS_SSA); float* SSS = (float*)(ws + WS_SSS); bf16* MIX = (bf16*)(ws + WS_MIX); bf16* MATS = (bf16*)(ws + WS_MATS); bf16* MATY = (bf16*)(ws + WS_MATY); bf16* UA = (bf16*)(ws + WS_UA); float* SST = (float*)(ws + WS_SST);
    const SsmP SP{args.in[8], args.in[9], args.in[10], args.in[11], args.in[12], args.in[13], args.in[14], args.in[15]};
    const int lo = args.ph_lo, hi = args.ph_hi;
    volatile LAS unsigned* MISC = (volatile LAS unsigned*)(lds + MISC_OFF);
    if (tid < 32) MISC[tid] = 0u;
    __syncthreads();
    XcdBarrier bar = xcd_barrier_post((unsigned*)ws, MISC + 8);
    if (lo < 0) grid.sync();
#define IN(k) (lo <= (k) && (k) < hi)
#define SEAM(k) do { if (IN(k) && IN((k) + 1)) xcd_barrier(bar); } while (0)

    if (IN(0)) {
        LAS float* scr = (LAS float*)(lds + wave * 17024);
        constexpr int I_UP = (DM / 64) * (FF / 32), I_DN = (FF / 64) * (DM / 32), I_IN = (DM / 64) * (INW / 32), I_GLU = (SWD / 64) * (SWD / 32), I_OUT = (DM / 64) * (DM / 32);
        constexpr int NITEMS = 3 * I_UP + I_IN + I_GLU + I_OUT;
        for (int it = gw; it < NITEMS; it += NGW) {
            int r = it;
            if (r < I_UP) { p0_transpose_item<1>(args.in[2], args.in[1], DM, FF, WT1, scr, r, lane); continue; } r -= I_UP;
            if (r < I_UP) { p0_transpose_item<2>(args.in[3], args.in[1], DM, FF, WT1, scr, r, lane); continue; } r -= I_UP;
            if (r < I_DN) { p0_transpose_item<0>(args.in[4], nullptr, FF, DM, WD1, scr, r, lane); continue; } r -= I_DN;
            if (r < I_IN) { p0_transpose_item<0>(args.in[6], args.in[5], DM, INW, WIN, scr, r, lane); continue; } r -= I_IN;
            if (r < I_GLU) { p0_transpose_item<0>(args.in[16], nullptr, SWD, SWD, WGLU, scr, r, lane); continue; } r -= I_GLU;
            p0_transpose_item<0>(args.in[20], nullptr, DM, DM, WOUT, scr, r, lane);
        }
        for (int it = gw; it < 32 * 63; it += NGW) gen_toep_item(SP, MATY, scr, it, lane);
        for (int it = gw; it < 32 * 2 * 64; it += NGW) gen_states_item(SP, MATS, it, lane);
        for (int it = gw; it < 32 * 2 * 32; it += NGW) gen_carry_item(SP, MATY, it, lane);
        for (int m = gw; m < M; m += NGW) row_to_bf16_ss(x + (size_t)m * DM, XA + (size_t)m * DM, SS0 + (size_t)m * 16, lane);
    }
    SEAM(0);
    if (IN(1)) { pg8::Gemm g{XA, WT1, M, 2 * FF, DM, DM, DM}; pg8::StaticOrder S; S.init(M, 2 * FF, G, bid); pg8::EpiSwiglu<true> E{HB, FF, SS0};
        pg8::gemm_phase<pg8::EpiSwiglu<true>, pg8::StaticOrder, true, true>(lds, g, S, E); }
    SEAM(1);
    if (IN(2)) { pg8::Gemm g{HB, WD1, M, DM, FF, FF, FF}; pg8::StaticOrder S; S.init(M, DM, G, bid); pg8::EpiResidB<false, false> E{x, XA, 0.5f, SS1, nullptr};
        pg8::gemm_phase<pg8::EpiResidB<false, false>, pg8::StaticOrder, true, true>(lds, g, S, E); }
    SEAM(2);
    if (IN(3)) { pg8::Gemm g{XA, WIN, M, INW, DM, DM, DM}; pg8::StaticOrder S; S.init(M, INW, G, bid); pg8::EpiWin E{QKV, UA, SS1};
        pg8::gemm_phase<pg8::EpiWin, pg8::StaticOrder, true, true>(lds, g, S, E); }
    SEAM(3);
    if (IN(4)) {
        { pg8::Gemm g{UA, MATS, 32 * 512, 32 * 256, KS, KY, KS}; pg8::GroupOrder S; S.init(32, 2, 1, G, bid); pg8::EpiStates E{SST, UA, SP.lam_re, SP.lam_im, SP.log_dt};
          if (G >= 64) pg8::gemm_phase<pg8::EpiStates, pg8::GroupOrder, false, true>(lds, g, S, E); }
        if (bid >= 64) attn_mfma(lds, QKV, MIX, SSA, args.in[18], args.in[7], bid - 64, 192, 192);
    }
    SEAM(4);
    if (IN(5)) { pg8::Gemm g{UA, MATY, 32 * 512, 32 * 512, KY, KY, KY}; pg8::GroupOrder S; S.init(32, 2, 2, G, bid); pg8::EpiSsmOut E{YG};
        pg8::gemm_phase<pg8::EpiSsmOut, pg8::GroupOrder, true, true>(lds, g, S, E);
        if (bid >= 128 && bid < 192) attn_mfma(lds, QKV, MIX, SSA, args.in[18], args.in[7], 192 + (bid - 128), 256, 64);
        if (bid >= 192) { LAS float* scr = (LAS float*)(lds + wave * 17024);
            for (int it = (bid - 192) * 8 + wave; it < F2_SPLIT; it += 512) ffn2_item(args, WT2, WD2, scr, it, lane); } }
    SEAM(5);
    if (IN(6)) { pg8::Gemm g{YG, WGLU, M, SWD, SWD, SWD, SWD}; pg8::StaticOrder S; S.init(M, SWD, G, bid); pg8::EpiGlu E{YG, MIX, args.in[17], args.in[19], SSS};
        pg8::gemm_phase<pg8::EpiGlu, pg8::StaticOrder, true, true>(lds, g, S, E);
        if (bid >= 128) { LAS float* scr = (LAS float*)(lds + wave * 17024);
            for (int it = F2_SPLIT + (bid - 128) * 8 + wave; it < 3 * F2_ITEMS; it += 1024) ffn2_item(args, WT2, WD2, scr, it, lane); } }
    SEAM(6);
    if (IN(7)) { pg8::Gemm g{MIX, WOUT, M, DM, DM, DM, DM}; pg8::StaticOrder S; S.init(M, DM, G, bid);
        LAS float* TAB = (LAS float*)(lds + 131072);
        { pg8::Unit u0; if (S.next(0, u0) && tid < 256) { const int row = u0.pm * 256 + tid; const float ra = pg8::rstd8(SSA + (size_t)row * 8), rs = pg8::rstd8(SSS + (size_t)row * 8); TAB[tid * 2] = ra / rs; TAB[tid * 2 + 1] = rs; } }
        __syncthreads();
        pg8::EpiResidB<true, true> E{XA, XA, 1.0f, SS2, TAB};
        pg8::gemm_phase<pg8::EpiResidB<true, true>, pg8::StaticOrder, true, true>(lds, g, S, E); }
    SEAM(7);
    if (IN(8)) { pg8::Gemm g{XA, WT2, M, 2 * FF, DM, DM, DM}; pg8::StaticOrder S; S.init(M, 2 * FF, G, bid); pg8::EpiSwiglu<true> E{HB, FF, SS2};
        pg8::gemm_phase<pg8::EpiSwiglu<true>, pg8::StaticOrder, true, true>(lds, g, S, E); }
    SEAM(8);
    if (IN(9)) { pg8::Gemm g{HB, WD2, M, DM, FF, FF, FF}; pg8::StaticOrder S; S.init(M, DM, G, bid); pg8::EpiResidOut E{XA, X, 0.5f};
        pg8::gemm_phase<pg8::EpiResidOut, pg8::StaticOrder, true, true>(lds, g, S, E); }
    SEAM(9);
    if (IN(10)) { for (int m = gw; m < M; m += NGW) rms_row_f32(X + (size_t)m * DM, args.in[25], lane); }
#undef IN
#undef SEAM
}

extern "C" void kernel_launch(void* const* d_in, const int* in_sizes, int n_in, void* d_out, int out_size, void* d_ws, size_t ws_size, hipStream_t stream) {
    static int grid = 0;
    if (grid == 0) {
        if (n_in != 26 || in_sizes[0] != M * DM || out_size != M * DM || ws_size < WS_END) { fprintf(stderr, "kernel_launch: unexpected shapes n_in %d in0 %d out %d ws %zu\n", n_in, n_in > 0 ? in_sizes[0] : -1, out_size, ws_size); grid = -1; return; }
        int dev = 0, cus = 0, per_cu = 0;
        (void)hipGetDevice(&dev); (void)hipDeviceGetAttribute(&cus, hipDeviceAttributeMultiprocessorCount, dev);
        if (hipFuncSetAttribute((const void*)mk_fwd, hipFuncAttributeMaxDynamicSharedMemorySize, LDS_BYTES) != hipSuccess) { fprintf(stderr, "kernel_launch: hipFuncSetAttribute failed\n"); grid = -1; return; }
        if (hipOccupancyMaxActiveBlocksPerMultiprocessor(&per_cu, (const void*)mk_fwd, 512, LDS_BYTES) != hipSuccess || per_cu < 1) { fprintf(stderr, "kernel_launch: occupancy query says %d\n", per_cu); per_cu = 1; }
        (void)hipGetLastError();
        grid = cus * per_cu;
        if (grid != 256) { fprintf(stderr, "kernel_launch: this kernel is built for a 256-workgroup grid (one per CU of a 256-CU device), got %d; nothing launched\n", grid); grid = -1; return; }
        fprintf(stderr, "kernel_launch: grid %d (cus %d per_cu %d)\n", grid, cus, per_cu);
    }
    if (grid < 0) return;
    if (hipMemsetAsync(d_ws, 0, CTL_ZERO_BYTES, stream) != hipSuccess) { fprintf(stderr, "kernel_launch: hipMemsetAsync failed\n"); return; }
    Args a{};
    for (int i = 0; i < 26; ++i) a.in[i] = (const float*)d_in[i];
    a.out = (float*)d_out; a.ws = (unsigned char*)d_ws;
#if MK_MULTI
    for (int ph = 0; ph < N_PHASES; ++ph) { a.ph_lo = ph; a.ph_hi = ph + 1; hipLaunchKernelGGL(mk_fwd, dim3(grid), dim3(512), LDS_BYTES, stream, a); }
#else
    a.ph_lo = 0; a.ph_hi = N_PHASES;
    void* kargs[] = {&a};
    hipError_t e = hipLaunchCooperativeKernel((const void*)mk_fwd, dim3(grid), dim3(512), kargs, LDS_BYTES, stream);
    if (e != hipSuccess) fprintf(stderr, "cooperative launch failed: %s (grid %d)\n", hipGetErrorString(e), grid);
#endif
}
```
